# Optimizing an MI355X kernel written in HIP

```python
import jax, jax.numpy as jnp
from jax import lax
import numpy as np

D_MODEL = 1024
BATCH = 16
SEQ = 2048
DEPTH = 2

GRID_W = 64
CTX_LEN = 256
N_EVEN = (DEPTH + 1) // 2
N_ODD = DEPTH // 2
N_MOD = 6
NORM_EPS = 1e-6
CONV_CH = D_MODEL // 2
CONV_WIDTH = 31
FOURIER_CH = D_MODEL // 2
FOURIER_GROUPS = 4
FOURIER_GROUP_CH = FOURIER_CH // FOURIER_GROUPS
AB_IN = 2 * CONV_CH + FOURIER_CH
AB_MIX = CONV_CH + FOURIER_CH
MLA_HEADS = 16
QK_NOPE = 64
QK_ROPE = 32
V_HEAD = 64
QK_HEAD = QK_NOPE + QK_ROPE
Q_LORA = 256
KV_LORA = 128
MLA_IN = Q_LORA + KV_LORA + QK_ROPE
ROPE_BASE = 10000.0
ROPE_FREQS_PER_AXIS = QK_ROPE // 4
ATTN_SCALE = QK_HEAD ** -0.5
Q_BLOCK = 128
N_EXPERTS = 16
EXPERT_FF = 1024
EC_CAPACITY_FACTOR = 2

kernel_name = 'hybrid_conv_fourier_mla_ecmoe_prefix_dit'


def rmsnorm(x, g):
    xf = x.astype(jnp.float32)
    y = xf * lax.rsqrt(jnp.mean(xf * xf, axis=-1, keepdims=True) + NORM_EPS)
    return (y * g.astype(jnp.float32)).astype(x.dtype)


def layernorm(x, g, b):
    xf = x.astype(jnp.float32)
    mu = jnp.mean(xf, axis=-1, keepdims=True)
    var = jnp.mean(jnp.square(xf - mu), axis=-1, keepdims=True)
    y = (xf - mu) * lax.rsqrt(var + NORM_EPS)
    return (y * g.astype(jnp.float32) + b.astype(jnp.float32)).astype(x.dtype)


def adaln(cvec, w, b):
    m = (jax.nn.silu(cvec) @ w + b)[:, None, :]
    return jnp.split(m, N_MOD, axis=-1)


def modulate(h, shift, scale):
    return h * (1 + scale) + shift


def conv_fourier_mixer(h, w_in, conv_w, conv_b, ln_g, ln_b, w_out):
    n, L, _ = h.shape
    z = h @ w_in
    a_val, a_gate, u = jnp.split(z, [CONV_CH, 2 * CONV_CH], axis=-1)
    a = a_val * jax.nn.sigmoid(a_gate)
    a = lax.conv_general_dilated(a, conv_w[:, None, :], window_strides=(1,),
                                 padding=[(CONV_WIDTH // 2, CONV_WIDTH // 2)],
                                 dimension_numbers=('NWC', 'WIO', 'NWC'),
                                 feature_group_count=CONV_CH) + conv_b
    a = jax.nn.silu(layernorm(a, ln_g, ln_b))
    ug = u.astype(jnp.float32).reshape(n, L, FOURIER_GROUPS, FOURIER_GROUP_CH)
    f = jnp.fft.fft2(ug, axes=(1, 3), norm='ortho').real.reshape(n, L, FOURIER_CH).astype(h.dtype)
    return jnp.concatenate([a, f], axis=-1) @ w_out


def axial_rope(L):
    rows = L // GRID_W
    row = jnp.repeat(jnp.arange(rows, dtype=jnp.float32), GRID_W)
    col = jnp.tile(jnp.arange(GRID_W, dtype=jnp.float32), rows)
    inv_freq = ROPE_BASE ** (-jnp.arange(ROPE_FREQS_PER_AXIS, dtype=jnp.float32) / ROPE_FREQS_PER_AXIS)
    ang = jnp.concatenate([row[:, None] * inv_freq, col[:, None] * inv_freq], axis=-1)
    return jnp.cos(ang), jnp.sin(ang)


def apply_rope(x, cos, sin):
    xf = x.astype(jnp.float32).reshape(x.shape[:-1] + (QK_ROPE // 2, 2))
    xe, xo = xf[..., 0], xf[..., 1]
    out = jnp.stack([xe * cos - xo * sin, xe * sin + xo * cos], axis=-1)
    return out.reshape(x.shape).astype(x.dtype)


def mla_queries(cq, q_norm_g, w_uq, rope):
    n, L, _ = cq.shape
    q = (rmsnorm(cq, q_norm_g) @ w_uq).reshape(n, L, MLA_HEADS, QK_HEAD)
    q_nope, q_rope = q[..., :QK_NOPE], q[..., QK_NOPE:]
    if rope is not None:
        q_rope = apply_rope(q_rope, rope[0][:, None, :], rope[1][:, None, :])
    return jnp.concatenate([q_nope, q_rope], axis=-1)


def mla_keys_values(ckv, k_rope, kv_norm_g, w_ukv, rope):
    n, L, _ = ckv.shape
    kv = (rmsnorm(ckv, kv_norm_g) @ w_ukv).reshape(n, L, MLA_HEADS, QK_NOPE + V_HEAD)
    k_nope, v = kv[..., :QK_NOPE], kv[..., QK_NOPE:]
    if rope is not None:
        k_rope = apply_rope(k_rope, rope[0], rope[1])
    k_rope = jnp.broadcast_to(k_rope[:, :, None, :], (n, L, MLA_HEADS, QK_ROPE))
    return jnp.concatenate([k_nope, k_rope], axis=-1), v


def attend(q, k, v):
    s = jnp.einsum('bqhd,bkhd->bhqk', q, k, preferred_element_type=jnp.float32) * ATTN_SCALE
    p = jax.nn.softmax(s, axis=-1).astype(v.dtype)
    return jnp.einsum('bhqk,bkhd->bqhd', p, v)


def blocked_attend(q, k, v):
    n, L, H, dq = q.shape
    nb = L // Q_BLOCK
    qb = q.reshape(n, nb, Q_BLOCK, H, dq).transpose(1, 0, 2, 3, 4)
    ob = lax.map(lambda qi: attend(qi, k, v), qb)
    return ob.transpose(1, 0, 2, 3, 4).reshape(n, L, H * V_HEAD)


def ec_moe(h, w_router, w1, w3, w2):
    n, L, D = h.shape
    cap = EC_CAPACITY_FACTOR * L // N_EXPERTS
    logits = jnp.einsum('bld,de->ble', h, w_router, preferred_element_type=jnp.float32)
    aff = jax.nn.softmax(logits, axis=-1)
    gate, idx = lax.top_k(jnp.swapaxes(aff, 1, 2), cap)
    xg = jax.vmap(lambda hb, ib: hb[ib])(h, idx)
    hid = jax.nn.silu(jnp.einsum('becd,edf->becf', xg, w1)) * jnp.einsum('becd,edf->becf', xg, w3)
    out = jnp.einsum('becf,efd->becd', hid, w2) * gate[..., None].astype(h.dtype)
    return jax.vmap(lambda ib, ob: jnp.zeros((L, D), h.dtype).at[ib.reshape(-1)].add(ob.reshape(-1, D)))(idx, out)


def setup_inputs(seed: int = 0) -> dict:
    key = jax.random.key(seed)
    ks = jax.random.split(key, 32)
    f32 = jnp.float32
    D = D_MODEL

    def nrm(k, shape, fan_in, gain=1.0):
        return gain * fan_in ** -0.5 * jax.random.normal(k, shape, f32)

    def gains(k, shape):
        return 1.0 + 0.05 * jax.random.normal(k, shape, f32)

    def small(k, shape):
        return 0.02 * jax.random.normal(k, shape, f32)

    return {
        'x': jax.random.normal(ks[0], (BATCH, SEQ, D), f32),
        'c': jax.random.normal(ks[1], (BATCH, D), f32),
        'ctx': jax.random.normal(ks[2], (BATCH, CTX_LEN, D), f32),
        'c_ctx': jax.random.normal(ks[3], (D,), f32),
        'mod_w': nrm(ks[4], (DEPTH, D, N_MOD * D), D, 0.5),
        'mod_b': small(ks[5], (DEPTH, N_MOD * D)),
        'norm1_g': gains(ks[6], (DEPTH, D)),
        'norm2_g': gains(ks[7], (DEPTH, D)),
        'ab_w_in': nrm(ks[8], (N_EVEN, D, AB_IN), D),
        'ab_conv_w': nrm(ks[9], (N_EVEN, CONV_WIDTH, CONV_CH), CONV_WIDTH),
        'ab_conv_b': small(ks[10], (N_EVEN, CONV_CH)),
        'ab_ln_g': gains(ks[11], (N_EVEN, CONV_CH)),
        'ab_ln_b': small(ks[12], (N_EVEN, CONV_CH)),
        'ab_w_out': nrm(ks[13], (N_EVEN, AB_MIX, D), AB_MIX),
        'mla_w_in': nrm(ks[14], (N_ODD, D, MLA_IN), D),
        'mla_q_norm_g': gains(ks[15], (N_ODD, Q_LORA)),
        'mla_kv_norm_g': gains(ks[16], (N_ODD, KV_LORA)),
        'mla_w_uq': nrm(ks[17], (N_ODD, Q_LORA, MLA_HEADS * QK_HEAD), Q_LORA),
        'mla_w_ukv': nrm(ks[18], (N_ODD, KV_LORA, MLA_HEADS * (QK_NOPE + V_HEAD)), KV_LORA),
        'mla_w_o': nrm(ks[19], (N_ODD, MLA_HEADS * V_HEAD, D), MLA_HEADS * V_HEAD),
        'moe_w_router': nrm(ks[20], (DEPTH, D, N_EXPERTS), D),
        'moe_w1': nrm(ks[21], (DEPTH, N_EXPERTS, D, EXPERT_FF), D),
        'moe_w3': nrm(ks[22], (DEPTH, N_EXPERTS, D, EXPERT_FF), D),
        'moe_w2': nrm(ks[23], (DEPTH, N_EXPERTS, EXPERT_FF, D), EXPERT_FF),
        'final_g': gains(ks[24], (D,)),
    }


def reference(x, c, ctx, c_ctx, mod_w, mod_b, norm1_g, norm2_g, ab_w_in, ab_conv_w, ab_conv_b,
              ab_ln_g, ab_ln_b, ab_w_out, mla_w_in, mla_q_norm_g, mla_kv_norm_g, mla_w_uq,
              mla_w_ukv, mla_w_o, moe_w_router, moe_w1, moe_w3, moe_w2, final_g):
    n, L, _ = x.shape
    rope = axial_rope(L)
    x_lat, x_ctx = x, ctx
    for i in range(DEPTH):
        ctx_out = i < DEPTH - 1
        j = i // 2
        sh1, sc1, g1, sh2, sc2, g2 = adaln(c, mod_w[i], mod_b[i])
        csh1, csc1, cg1, csh2, csc2, cg2 = adaln(c_ctx[None, :], mod_w[i], mod_b[i])
        u_lat = modulate(rmsnorm(x_lat, norm1_g[i]), sh1, sc1)
        u_ctx = modulate(rmsnorm(x_ctx, norm1_g[i]), csh1, csc1)
        if i % 2 == 0:
            ab = (ab_w_in[j], ab_conv_w[j], ab_conv_b[j], ab_ln_g[j], ab_ln_b[j], ab_w_out[j])
            x_lat = x_lat + g1 * conv_fourier_mixer(u_lat, *ab)
            if ctx_out:
                x_ctx = x_ctx + cg1 * conv_fourier_mixer(u_ctx, *ab)
        else:
            split = [Q_LORA, Q_LORA + KV_LORA]
            cq_lat, ckv_lat, kr_lat = jnp.split(u_lat @ mla_w_in[j], split, axis=-1)
            cq_ctx, ckv_ctx, kr_ctx = jnp.split(u_ctx @ mla_w_in[j], split, axis=-1)
            k_lat, v_lat = mla_keys_values(ckv_lat, kr_lat, mla_kv_norm_g[j], mla_w_ukv[j], rope)
            k_ctx, v_ctx = mla_keys_values(ckv_ctx, kr_ctx, mla_kv_norm_g[j], mla_w_ukv[j], None)
            q_lat = mla_queries(cq_lat, mla_q_norm_g[j], mla_w_uq[j], rope)
            k_all = jnp.concatenate([k_ctx, k_lat], axis=1)
            v_all = jnp.concatenate([v_ctx, v_lat], axis=1)
            x_lat = x_lat + g1 * (blocked_attend(q_lat, k_all, v_all) @ mla_w_o[j])
            if ctx_out:
                q_ctx = mla_queries(cq_ctx, mla_q_norm_g[j], mla_w_uq[j], None)
                o_ctx = attend(q_ctx, k_ctx, v_ctx).reshape(n, x_ctx.shape[1], MLA_HEADS * V_HEAD)
                x_ctx = x_ctx + cg1 * (o_ctx @ mla_w_o[j])
        moe = (moe_w_router[i], moe_w1[i], moe_w3[i], moe_w2[i])
        u_lat = modulate(rmsnorm(x_lat, norm2_g[i]), sh2, sc2)
        x_lat = x_lat + g2 * ec_moe(u_lat, *moe)
        if ctx_out:
            u_ctx = modulate(rmsnorm(x_ctx, norm2_g[i]), csh2, csc2)
            x_ctx = x_ctx + cg2 * ec_moe(u_ctx, *moe)
    return rmsnorm(x_lat, final_g)
```

```cpp
#define HYB_CUT 5
#define FP_MIN 0
#define FP_MAX 19

#include <hip/hip_runtime.h>
#include <cstdio>
#include <cstdint>
#include <cmath>
namespace ref {
constexpr int D = 1024, NB = 16, L = 2048, LC = 256, S = L + LC;
constexpr int H = 16, QKH = 96, FF = 1024, NE = 16;
constexpr float EPS = 1e-6f;

struct GemmP { const float* A; const float* Bm; float* C; const float* bias; const int* gidx;
               int M, N, K, lda, ldb, ldc; long sA, sB, sC; int sG; int pad; };
__global__ void __launch_bounds__(256) k_gemm(GemmP g) {
    __shared__ float As[16][68]; __shared__ float Bs[16][64];
    const int z = blockIdx.z; const float* A = g.A + z * g.sA; const float* Bm = g.Bm + z * g.sB; float* C = g.C + z * g.sC;
    const int* gi = g.gidx ? g.gidx + z * g.sG : nullptr;
    const int m0 = blockIdx.y * 64, n0 = blockIdx.x * 64, tid = threadIdx.x, tx = tid & 15, ty = tid >> 4;
    float acc[4][4];
#pragma unroll
    for (int i = 0; i < 4; ++i)
#pragma unroll
        for (int j = 0; j < 4; ++j) acc[i][j] = 0.f;
    const int ar = tid >> 2, ak = (tid & 3) * 4; const int arow = m0 + ar; const bool aok = arow < g.M;
    const long aoff = aok ? (long)(gi ? gi[arow] : arow) * g.lda : 0;
    const int bk = tid >> 4, bn = (tid & 15) * 4; const bool bok = (n0 + bn) < g.N;
    for (int k0 = 0; k0 < g.K; k0 += 16) {
        float4 av = aok ? *(const float4*)(A + aoff + k0 + ak) : make_float4(0.f, 0.f, 0.f, 0.f);
        float4 bv = bok ? *(const float4*)(Bm + (long)(k0 + bk) * g.ldb + n0 + bn) : make_float4(0.f, 0.f, 0.f, 0.f);
        As[ak][ar] = av.x; As[ak + 1][ar] = av.y; As[ak + 2][ar] = av.z; As[ak + 3][ar] = av.w;
        *(float4*)&Bs[bk][bn] = bv;
        __syncthreads();
#pragma unroll
        for (int k = 0; k < 16; ++k) {
            const float4 a4 = *(const float4*)&As[k][ty * 4]; const float4 b4 = *(const float4*)&Bs[k][tx * 4];
            acc[0][0] += a4.x * b4.x; acc[0][1] += a4.x * b4.y; acc[0][2] += a4.x * b4.z; acc[0][3] += a4.x * b4.w;
            acc[1][0] += a4.y * b4.x; acc[1][1] += a4.y * b4.y; acc[1][2] += a4.y * b4.z; acc[1][3] += a4.y * b4.w;
            acc[2][0] += a4.z * b4.x; acc[2][1] += a4.z * b4.y; acc[2][2] += a4.z * b4.z; acc[2][3] += a4.z * b4.w;
            acc[3][0] += a4.w * b4.x; acc[3][1] += a4.w * b4.y; acc[3][2] += a4.w * b4.z; acc[3][3] += a4.w * b4.w;
        }
        __syncthreads();
    }
#pragma unroll
    for (int i = 0; i < 4; ++i) { const int row = m0 + ty * 4 + i; if (row < g.M) {
#pragma unroll
        for (int j = 0; j < 4; ++j) { const int col = n0 + tx * 4 + j; if (col < g.N) C[(long)row * g.ldc + col] = acc[i][j] + (g.bias ? g.bias[col] : 0.f); } } }
}
__device__ __forceinline__ float siluf(float v) { return v / (1.f + __expf(-v)); }
__device__ __forceinline__ float block_sum256(float v, float* red) {
#pragma unroll
    for (int o = 32; o > 0; o >>= 1) v += __shfl_xor(v, o);
    __syncthreads();
    if ((threadIdx.x & 63) == 0) red[threadIdx.x >> 6] = v;
    __syncthreads();
    return red[0] + red[1] + red[2] + red[3];
}
__global__ void k_silu(const float* in, float* out, int n) { int i = blockIdx.x * 256 + threadIdx.x; if (i < n) out[i] = siluf(in[i]); }
__global__ void __launch_bounds__(256) k_rms(const float* in, int is, float* out, int os, const float* g, const float* sh, const float* sc, int W) {
    __shared__ float red[4];
    const float* x = in + (long)blockIdx.x * is; float* o = out + (long)blockIdx.x * os;
    float s = 0.f; for (int i = threadIdx.x; i < W; i += 256) { float v = x[i]; s += v * v; }
    s = block_sum256(s, red);
    const float r = rsqrtf(s / (float)W + EPS);
    for (int i = threadIdx.x; i < W; i += 256) { float v = x[i] * r * g[i]; if (sc) v = v * (1.f + sc[i]) + sh[i]; o[i] = v; }
}
__global__ void k_glu(const float* z, float* a, int rows) { int i = blockIdx.x * 256 + threadIdx.x; if (i < rows * 512) { int t = i >> 9, c = i & 511; float v = z[(long)t * 1536 + c], gt = z[(long)t * 1536 + 512 + c]; a[i] = v / (1.f + __expf(-gt)); } }
__global__ void __launch_bounds__(256) k_conv_ln(const float* a, float* cat, const float* cw, const float* cb, const float* lg, const float* lb, int Ls) {
    __shared__ float red[4];
    const int t = blockIdx.x; float v[2];
#pragma unroll
    for (int q = 0; q < 2; ++q) { const int c = threadIdx.x + 256 * q; float s = cb[c];
        for (int j = 0; j < 31; ++j) { const int l = t + j - 15; if (l >= 0 && l < Ls) s += a[(long)l * 512 + c] * cw[j * 512 + c]; }
        v[q] = s; }
    const float mu = block_sum256(v[0] + v[1], red) * (1.f / 512.f);
    const float d0 = v[0] - mu, d1 = v[1] - mu;
    const float var = block_sum256(d0 * d0 + d1 * d1, red) * (1.f / 512.f);
    const float r = rsqrtf(var + EPS);
#pragma unroll
    for (int q = 0; q < 2; ++q) { const int c = threadIdx.x + 256 * q; const float y = (q == 0 ? d0 : d1) * r * lg[c] + lb[c]; cat[(long)t * 1024 + c] = siluf(y); }
}
__global__ void k_resid(float* x, const float* y, const float* gate, int rows) { int i = blockIdx.x * 256 + threadIdx.x; if (i < rows * 1024) x[i] += gate[i & 1023] * y[i]; }
__global__ void k_softmax16(const float* lg, float* aff, int rows) { int t = blockIdx.x * 256 + threadIdx.x; if (t < rows) { float m = -1e30f; for (int e = 0; e < 16; ++e) m = fmaxf(m, lg[t * 16 + e]); float s = 0.f; float p[16];
#pragma unroll
        for (int e = 0; e < 16; ++e) { p[e] = __expf(lg[t * 16 + e] - m); s += p[e]; }
#pragma unroll
        for (int e = 0; e < 16; ++e) aff[t * 16 + e] = p[e] / s; } }
__global__ void __launch_bounds__(256) k_topk(const float* aff, int Ls, int cap, int* idx, float* gate) {
    __shared__ float a[2048];
    const int e = blockIdx.x;
    for (int t = threadIdx.x; t < Ls; t += 256) a[t] = aff[t * 16 + e];
    __syncthreads();
    for (int t = threadIdx.x; t < Ls; t += 256) { const float v = a[t]; int rank = 0;
        for (int j = 0; j < Ls; ++j) { const float w = a[j]; rank += (w > v || (w == v && j < t)) ? 1 : 0; }
        if (rank < cap) { idx[e * 256 + rank] = t; gate[e * 256 + rank] = v; } }
}
__global__ void k_swiglu(float* h1, const float* h3, int cap) { int i = blockIdx.x * 256 + threadIdx.x; if (i < 16 * cap * 1024) { int e = i / (cap * 1024), r = i % (cap * 1024); long o = (long)e * 256 * 1024 + r; h1[o] = siluf(h1[o]) * h3[o]; } }
__global__ void k_scatter(float* x, const float* out, const int* idx, const float* gate, const float* g2, int cap) { int i = blockIdx.x * 256 + threadIdx.x; if (i < 16 * cap * 1024) { int e = i / (cap * 1024), r = i % (cap * 1024), s = r >> 10, n = r & 1023;
        atomicAdd(&x[(long)idx[e * 256 + s] * 1024 + n], g2[n] * gate[e * 256 + s] * out[(long)e * 256 * 1024 + r]); } }
__global__ void k_mk_cs(float* cs, int Ls, float scale) { long i = (long)blockIdx.x * 256 + threadIdx.x; if (i < (long)Ls * Ls) { int k = (int)(i / Ls), l = (int)(i % Ls); int ph = (int)(((long)k * l) % Ls); float s, c; sincospif(2.f * (float)ph / (float)Ls, &s, &c); cs[(long)k * 2 * Ls + l] = c * scale; cs[(long)k * 2 * Ls + Ls + l] = -s * scale; } }
__global__ void k_mk_cc(float* cc, float* sc) { int i = blockIdx.x * 256 + threadIdx.x; if (i < 128 * 128) { int c = i >> 7, m = i & 127; int ph = (c * m) & 127; float s, co; sincospif(2.f * (float)ph / 128.f, &s, &co); cc[i] = co; sc[i] = s; } }
__global__ void k_rope(float* m, int ld, int col0, int hs, int nh, int Ls) { int i = blockIdx.x * 256 + threadIdx.x; if (i < Ls * nh * 16) { int p = i & 15, h = (i >> 4) % nh, t = i / (16 * nh);
        const float pos = (p < 8) ? (float)(t >> 6) : (float)(t & 63); const float inv = __powf(10000.f, -(float)(p & 7) / 8.f); float s, c; sincosf(pos * inv, &s, &c);
        float* q = m + (long)t * ld + col0 + h * hs + 2 * p; const float xe = q[0], xo = q[1]; q[0] = xe * c - xo * s; q[1] = xe * s + xo * c; } }
__global__ void __launch_bounds__(64) k_attn(const float* Q, const float* KV, const float* KR, float* O) {
    const int h = blockIdx.y, q = blockIdx.x * 64 + threadIdx.x;
    float qv[96], o[64];
#pragma unroll
    for (int d = 0; d < 96; ++d) qv[d] = Q[(long)q * 1536 + h * 96 + d] * 0.10206207261596577f;
#pragma unroll
    for (int d = 0; d < 64; ++d) o[d] = 0.f;
    float m = -1e30f, l = 0.f;
    for (int j = 0; j < S; ++j) {
        const float* kn = KV + (long)j * 2048 + h * 128; const float* kr = KR + (long)j * 32; const float* vv = kn + 64;
        float s = 0.f;
#pragma unroll
        for (int d = 0; d < 64; ++d) s += qv[d] * kn[d];
#pragma unroll
        for (int d = 0; d < 32; ++d) s += qv[64 + d] * kr[d];
        const float mn = fmaxf(m, s), al = __expf(m - mn), p = __expf(s - mn);
        l = l * al + p; m = mn;
#pragma unroll
        for (int d = 0; d < 64; ++d) o[d] = o[d] * al + p * vv[d];
    }
    const float il = 1.f / l;
#pragma unroll
    for (int d = 0; d < 64; ++d) O[(long)q * 1024 + h * 64 + d] = o[d] * il;
}
__global__ void k_copy_cols(const float* in, int is, float* out, int os, int rows, int cols) { int i = blockIdx.x * 256 + threadIdx.x; if (i < rows * cols) { int r = i / cols, c = i % cols; out[(long)r * os + c] = in[(long)r * is + c]; } }

struct Bufs { float *SC, *MODS, *CSL, *CSC, *CC, *SCm, *NX, *NU, *NZ, *NA, *NCAT, *NY, *NT1, *NLOG, *NAFF, *NGATE, *NH1, *NH3, *NCQKV, *NCQN, *NCKVN, *NQ, *NKV, *NKR, *NO; int* NIDX; };
inline size_t carve(Bufs& b, char* base) {
    size_t o = 0; auto take = [&](size_t bytes) { char* p = base + o; o += (bytes + 255) & ~(size_t)255; return p; };
    b.SC = (float*)take(17 * 1024 * 4); b.MODS = (float*)take(2 * 17 * 6144 * 4);
    b.CSL = (float*)take((size_t)L * 2 * L * 4); b.CSC = (float*)take((size_t)LC * 2 * LC * 4); b.CC = (float*)take(128 * 128 * 4); b.SCm = (float*)take(128 * 128 * 4);
    b.NX = (float*)take((size_t)S * D * 4); b.NU = (float*)take((size_t)S * D * 4); b.NZ = (float*)take((size_t)S * 1536 * 4); b.NA = (float*)take((size_t)S * 512 * 4);
    b.NCAT = (float*)take((size_t)S * D * 4); b.NY = (float*)take((size_t)2 * L * 512 * 4); b.NT1 = (float*)take((size_t)S * D * 4);
    b.NLOG = (float*)take((size_t)S * 16 * 4); b.NAFF = (float*)take((size_t)S * 16 * 4); b.NGATE = (float*)take(16 * 256 * 4); b.NIDX = (int*)take(16 * 256 * 4);
    b.NH1 = (float*)take((size_t)16 * 256 * 1024 * 4); b.NH3 = (float*)take((size_t)16 * 256 * 1024 * 4);
    b.NCQKV = (float*)take((size_t)S * 416 * 4); b.NCQN = (float*)take((size_t)S * 256 * 4); b.NCKVN = (float*)take((size_t)S * 128 * 4);
    b.NQ = (float*)take((size_t)L * 1536 * 4); b.NKV = (float*)take((size_t)S * 2048 * 4); b.NKR = (float*)take((size_t)S * 32 * 4); b.NO = (float*)take((size_t)L * D * 4);
    return o;
}
inline void gemm(hipStream_t st, const float* A, int lda, const float* Bm, int ldb, float* C, int ldc, int M, int N, int K, const float* bias = nullptr,
                 const int* gidx = nullptr, int nz = 1, long sA = 0, long sB = 0, long sC = 0, int sG = 0) {
    GemmP g{A, Bm, C, bias, gidx, M, N, K, lda, ldb, ldc, sA, sB, sC, sG, 0};
    hipLaunchKernelGGL(k_gemm, dim3((N + 63) / 64, (M + 63) / 64, nz), dim3(256), 0, st, g);
}
#define REF_EW(kern, n, ...) hipLaunchKernelGGL(kern, dim3(((n) + 255) / 256), dim3(256), 0, st, __VA_ARGS__)
struct In { const float *x, *c, *ctx, *c_ctx, *mod_w, *mod_b, *norm1_g, *norm2_g, *ab_w_in, *ab_conv_w, *ab_conv_b, *ab_ln_g, *ab_ln_b, *ab_w_out, *mla_w_in, *mla_q_norm_g, *mla_kv_norm_g,
                  *mla_w_uq, *mla_w_ukv, *mla_w_o, *moe_w_router, *moe_w1, *moe_w3, *moe_w2, *final_g; };
inline In make_in(void* const* d) { In i; const float** p = (const float**)&i; for (int k = 0; k < 25; ++k) p[k] = (const float*)d[k]; return i; }

inline void moe(hipStream_t st, const In& I, Bufs& b, int ly, int r0, int Ls, int mr) {
    const int cap = 2 * Ls / 16; const float* md = b.MODS + ((size_t)ly * 17 + mr) * 6144;
    hipLaunchKernelGGL(k_rms, dim3(Ls), dim3(256), 0, st, b.NX + (size_t)r0 * D, D, b.NU, D, I.norm2_g + ly * D, md + 3 * D, md + 4 * D, D);
    gemm(st, b.NU, D, I.moe_w_router + (size_t)ly * D * 16, 16, b.NLOG, 16, Ls, 16, D);
    REF_EW(k_softmax16, Ls, b.NLOG, b.NAFF, Ls);
    hipLaunchKernelGGL(k_topk, dim3(16), dim3(256), 0, st, b.NAFF, Ls, cap, b.NIDX, b.NGATE);
    const size_t wl = (size_t)ly * 16 * 1024 * 1024;
    gemm(st, b.NU, D, I.moe_w1 + wl, FF, b.NH1, FF, cap, FF, D, nullptr, b.NIDX, 16, 0, 1024 * 1024, 256 * 1024, 256);
    gemm(st, b.NU, D, I.moe_w3 + wl, FF, b.NH3, FF, cap, FF, D, nullptr, b.NIDX, 16, 0, 1024 * 1024, 256 * 1024, 256);
    REF_EW(k_swiglu, 16 * cap * 1024, b.NH1, b.NH3, cap);
    gemm(st, b.NH1, FF, I.moe_w2 + wl, D, b.NH3, D, cap, D, FF, nullptr, nullptr, 16, 256 * 1024, 1024 * 1024, 256 * 1024, 0);
    REF_EW(k_scatter, 16 * cap * 1024, b.NX + (size_t)r0 * D, b.NH3, b.NIDX, b.NGATE, md + 5 * D, cap);
}
inline void mixer_ab(hipStream_t st, const In& I, Bufs& b, int r0, int Ls, int mr) {
    const float* md = b.MODS + ((size_t)0 * 17 + mr) * 6144; const float* cs = (Ls == L) ? b.CSL : b.CSC;
    hipLaunchKernelGGL(k_rms, dim3(Ls), dim3(256), 0, st, b.NX + (size_t)r0 * D, D, b.NU, D, I.norm1_g, md + 0 * D, md + 1 * D, D);
    gemm(st, b.NU, D, I.ab_w_in, 1536, b.NZ, 1536, Ls, 1536, D);
    REF_EW(k_glu, Ls * 512, b.NZ, b.NA, Ls);
    hipLaunchKernelGGL(k_conv_ln, dim3(Ls), dim3(256), 0, st, b.NA, b.NCAT, I.ab_conv_w, I.ab_conv_b, I.ab_ln_g, I.ab_ln_b, Ls);
    gemm(st, b.NZ + 1024, 1536, b.CC, 128, b.NY, 512, Ls, 128, 128, nullptr, nullptr, 4, 128, 0, 128, 0);
    gemm(st, b.NZ + 1024, 1536, b.SCm, 128, b.NY + (size_t)Ls * 512, 512, Ls, 128, 128, nullptr, nullptr, 4, 128, 0, 128, 0);
    gemm(st, cs, 2 * Ls, b.NY, 512, b.NCAT + 512, 1024, Ls, 512, 2 * Ls);
    gemm(st, b.NCAT, D, I.ab_w_out, D, b.NT1, D, Ls, D, D);
    REF_EW(k_resid, Ls * 1024, b.NX + (size_t)r0 * D, b.NT1, md + 2 * D, Ls);
}
inline void run(void* const* d_in, float* d_out, char* ws, hipStream_t st, int b_lo, int b_hi, int start = 0, const float* xl = nullptr, const float* xc = nullptr) {
    In I = make_in(d_in); Bufs b; carve(b, ws);
    REF_EW(k_silu, 16 * 1024, I.c, b.SC, 16 * 1024); REF_EW(k_silu, 1024, I.c_ctx, b.SC + 16 * 1024, 1024);
    for (int ly = 0; ly < 2; ++ly) gemm(st, b.SC, D, I.mod_w + (size_t)ly * D * 6144, 6144, b.MODS + (size_t)ly * 17 * 6144, 6144, 17, 6144, D, I.mod_b + ly * 6144);
    REF_EW(k_mk_cs, L * L, b.CSL, L, 1.f / sqrtf((float)L * 128.f)); REF_EW(k_mk_cs, LC * LC, b.CSC, LC, 1.f / sqrtf((float)LC * 128.f)); REF_EW(k_mk_cc, 128 * 128, b.CC, b.SCm);
    for (int bb = b_lo; bb < b_hi; ++bb) {
        (void)hipMemcpyAsync(b.NX, (start ? xl : I.x) + (size_t)bb * L * D, (size_t)L * D * 4, hipMemcpyDeviceToDevice, st);
        (void)hipMemcpyAsync(b.NX + (size_t)L * D, (start ? xc : I.ctx) + (size_t)bb * LC * D, (size_t)LC * D * 4, hipMemcpyDeviceToDevice, st);
        if (start <= 0) { mixer_ab(st, I, b, 0, L, bb); mixer_ab(st, I, b, L, LC, 16); }
        if (start <= 1) { moe(st, I, b, 0, 0, L, bb); moe(st, I, b, 0, L, LC, 16); }
        if (start <= 2) {
        const float* md = b.MODS + ((size_t)17 + bb) * 6144; const float* mdc = b.MODS + ((size_t)17 + 16) * 6144;
        hipLaunchKernelGGL(k_rms, dim3(L), dim3(256), 0, st, b.NX, D, b.NU, D, I.norm1_g + D, md, md + D, D);
        hipLaunchKernelGGL(k_rms, dim3(LC), dim3(256), 0, st, b.NX + (size_t)L * D, D, b.NU + (size_t)L * D, D, I.norm1_g + D, mdc, mdc + D, D);
        gemm(st, b.NU, D, I.mla_w_in, 416, b.NCQKV, 416, S, 416, D);
        hipLaunchKernelGGL(k_rms, dim3(S), dim3(256), 0, st, b.NCQKV, 416, b.NCQN, 256, I.mla_q_norm_g, (const float*)nullptr, (const float*)nullptr, 256);
        hipLaunchKernelGGL(k_rms, dim3(S), dim3(256), 0, st, b.NCQKV + 256, 416, b.NCKVN, 128, I.mla_kv_norm_g, (const float*)nullptr, (const float*)nullptr, 128);
        gemm(st, b.NCQN, 256, I.mla_w_uq, 1536, b.NQ, 1536, L, 1536, 256);
        gemm(st, b.NCKVN, 128, I.mla_w_ukv, 2048, b.NKV, 2048, S, 2048, 128);
        REF_EW(k_copy_cols, S * 32, b.NCQKV + 384, 416, b.NKR, 32, S, 32);
        REF_EW(k_rope, L * 16 * 16, b.NQ, 1536, 64, 96, 16, L);
        REF_EW(k_rope, L * 1 * 16, b.NKR, 32, 0, 0, 1, L);
        hipLaunchKernelGGL(k_attn, dim3(L / 64, H), dim3(64), 0, st, b.NQ, b.NKV, b.NKR, b.NO);
        gemm(st, b.NO, D, I.mla_w_o, D, b.NT1, D, L, D, D);
        REF_EW(k_resid, L * 1024, b.NX, b.NT1, md + 2 * D, L);
        }
        moe(st, I, b, 1, 0, L, bb);
        hipLaunchKernelGGL(k_rms, dim3(L), dim3(256), 0, st, b.NX, D, d_out + (size_t)bb * L * D, D, I.final_g, (const float*)nullptr, (const float*)nullptr, D);
    }
}
}
namespace pg8 {
#define PG8_LAS __attribute__((address_space(3)))
typedef unsigned short bf16_t;
typedef short bf16x8 __attribute__((ext_vector_type(8)));
typedef float f32x4 __attribute__((ext_vector_type(4)));
typedef unsigned u32x4 __attribute__((ext_vector_type(4)));
constexpr int BM = 256, BK = 64, HALF = 128, HTB = HALF * BK * 2  , STAGE_BYTES = 8 * HTB, NXCD = 8, WGM = 8;

__host__ __device__ __forceinline__ int lds_byte(int r, int c) { const int st = (r >> 4) * 2 + (c >> 5), rr = r & 15, cc = c & 31, ob = rr * 64 + cc * 2; return st * 1024 + (ob ^ (((ob >> 9) & 1) << 5)); }
__host__ __device__ __forceinline__ void stage_rc(int b, int& R, int& C) { const int st = b / 1024, sb = b % 1024, swz = sb ^ (((sb >> 9) & 1) << 5); R = (st >> 1) * 16 + swz / 64; C = (st & 1) * 32 + (swz % 64) / 2; }
__host__ __device__ __forceinline__ int perm32(int rho) { const int n = rho >> 4, i = rho & 15; return 8 * (i >> 2) + 4 * n + (i & 3); }

struct Unit { int pm, pn; };
struct Gemm { const bf16_t* A; const bf16_t* Bt; int M, N, K; };

__device__ __forceinline__ unsigned cvt_pk_bf16(float lo, float hi) { unsigned r; asm volatile("v_cvt_pk_bf16_f32 %0, %1, %2" : "=v"(r) : "v"(lo), "v"(hi)); return r; }
typedef float f32x2 __attribute__((ext_vector_type(2)));
template <class Epi, class Sched, bool ALIGN_EPI = false, bool SP2 = false>
__device__ __forceinline__ void gemm_phase(PG8_LAS unsigned char* lds, const Gemm g, const Sched& S, const Epi& E, const int tid) {
    const int  wid = __builtin_amdgcn_readfirstlane(tid >> 6), lane = tid & 63, wr = wid >> 2, wc = wid & 3, fr = lane & 15, fq = lane >> 4;
    const int K = g.K, nt = K / BK;
    unsigned voffA[2], voffB[2];
#pragma unroll
    for (int i = 0; i < 2; ++i) { int R, C; stage_rc(tid * 16 + i * 8192, R, C); const int Rb = Epi::PERM ? ((R & ~31) + perm32(R & 31)) : R;
        voffA[i] = (unsigned)(R * K + C) * 2u; voffB[i] = (unsigned)(Rb * K + C) * 2u; }
    const size_t kstep = (size_t)(BK * 2);
    const size_t hstep = (size_t)HALF * K * 2;
    const size_t tstep = 2 * hstep;
    const unsigned ldsw = (unsigned)wid * 1024u;
    const int aoff = lds_byte(wr * 64 + fr, fq * 8), boff = lds_byte(wc * 32 + fr, fq * 8);
#define PG8_SA(b, h) (((b) * 2 + (h)) * HTB)
#define PG8_SB(b, h) ((4 + (b) * 2 + (h)) * HTB)
#define PG8_STAGE(bufoff, gbase, voff) do { _Pragma("unroll") for (int _i = 0; _i < 2; ++_i) \
        __builtin_amdgcn_global_load_lds((const unsigned*)((const char*)(gbase) + (voff)[_i]), (PG8_LAS unsigned*)(lds + (bufoff) + ldsw + _i * 8192), 16, 0, 0); } while (0)
#define PG8_LDA(dst, b, h) do { _Pragma("unroll") for (int m = 0; m < 4; ++m) _Pragma("unroll") for (int k = 0; k < 2; ++k) dst[m][k] = *(const PG8_LAS bf16x8*)(lds + PG8_SA(b, h) + aoff + m * 2048 + k * 1024); } while (0)
#define PG8_LDB(dst, b, h) do { _Pragma("unroll") for (int n = 0; n < 2; ++n) _Pragma("unroll") for (int k = 0; k < 2; ++k) dst[n][k] = *(const PG8_LAS bf16x8*)(lds + PG8_SB(b, h) + boff + n * 2048 + k * 1024); } while (0)
#define PG8_MMA(ai, bj, At, Bt) do { __builtin_amdgcn_s_setprio(1); _Pragma("unroll") for (int m = 0; m < 4; ++m) _Pragma("unroll") for (int n = 0; n < 2; ++n) _Pragma("unroll") for (int k = 0; k < 2; ++k) \
        acc[ai][bj][m][n] = __builtin_amdgcn_mfma_f32_16x16x32_bf16(Bt[n][k], At[m][k], acc[ai][bj][m][n], 0, 0, 0); __builtin_amdgcn_s_setprio(0); } while (0)
#define PG8_WAIT_V(n) asm volatile("s_waitcnt vmcnt(" #n ")" ::: "memory")
#define PG8_WAIT_L(n) asm volatile("s_waitcnt lgkmcnt(" #n ")" ::: "memory")
#define PG8_BAR __builtin_amdgcn_s_barrier()
#define PG8_SCHED __builtin_amdgcn_sched_barrier(0)
    Unit cur, nxt; int ui = 0;
    if (!S.next(0, cur)) return;
    f32x4 acc[2][2][4][2];
#pragma unroll
    for (int a = 0; a < 2; ++a)
#pragma unroll
        for (int b = 0; b < 2; ++b)
#pragma unroll
            for (int m = 0; m < 4; ++m)
#pragma unroll
                for (int n = 0; n < 2; ++n) acc[a][b][m][n] = (f32x4){0.f, 0.f, 0.f, 0.f};
    bf16x8 At[4][2], B0[2][2], B1[2][2];
    const char* cA = (const char*)g.A + (size_t)cur.pm * tstep; const char* cB = (const char*)g.Bt + (size_t)cur.pn * tstep;
    S.a_ready(cur);
    if constexpr (SP2) {
        PG8_STAGE(PG8_SB(0, 0), cB, voffB); PG8_STAGE(PG8_SB(0, 1), cB + hstep, voffB); PG8_STAGE(PG8_SA(0, 0), cA, voffA); PG8_STAGE(PG8_SA(0, 1), cA + hstep, voffA);
        if (wr == 1) PG8_BAR;
        PG8_WAIT_V(2); PG8_BAR;
        PG8_STAGE(PG8_SB(1, 0), cB + kstep, voffB); PG8_STAGE(PG8_SA(1, 0), cA + kstep, voffA); PG8_STAGE(PG8_SB(1, 1), cB + hstep + kstep, voffB);
        PG8_WAIT_V(6); PG8_BAR;
    } else {
        PG8_STAGE(PG8_SB(0, 0), cB, voffB); PG8_STAGE(PG8_SA(0, 0), cA, voffA); PG8_STAGE(PG8_SB(0, 1), cB + hstep, voffB); PG8_STAGE(PG8_SA(0, 1), cA + hstep, voffA);
        if (wr == 1) PG8_BAR;
        PG8_WAIT_V(4); PG8_BAR;
        PG8_STAGE(PG8_SB(1, 0), cB + kstep, voffB); PG8_STAGE(PG8_SA(1, 0), cA + kstep, voffA); PG8_STAGE(PG8_SB(1, 1), cB + hstep + kstep, voffB);
        PG8_WAIT_V(6); PG8_BAR;
    }
    for (;;) {
        const bool has_next = S.next(ui + 1, nxt);
        const char* nA = has_next ? (const char*)g.A + (size_t)nxt.pm * tstep : cA; const char* nB = has_next ? (const char*)g.Bt + (size_t)nxt.pn * tstep : cB;
        for (int t = 0; t < nt; t += 2) {
            const bool last = (t == nt - 2);
            const char* a1 = cA + (size_t)(t + 1) * kstep;
            const char* a2 = last ? nA : cA + (size_t)(t + 2) * kstep; const char* b2 = last ? nB : cB + (size_t)(t + 2) * kstep;
            const char* a3 = a2 + kstep; const char* b3 = b2 + kstep;
            if (last && has_next) S.a_ready(nxt);
            if constexpr (SP2) {
            PG8_LDB(B0, 0, 0); PG8_LDB(B1, 0, 1); PG8_SCHED; PG8_LDA(At, 0, 0); PG8_STAGE(PG8_SA(1, 1), a1 + hstep, voffA);
            PG8_WAIT_V(8); PG8_WAIT_L(0); PG8_BAR; PG8_MMA(0, 0, At, B0); PG8_MMA(0, 1, At, B1); PG8_BAR; PG8_SCHED;
            PG8_LDA(At, 0, 1); PG8_STAGE(PG8_SB(0, 0), b2, voffB); PG8_STAGE(PG8_SB(0, 1), b2 + hstep, voffB); PG8_STAGE(PG8_SA(0, 0), a2, voffA);
            PG8_WAIT_V(8); PG8_WAIT_L(0); PG8_BAR; PG8_MMA(1, 0, At, B0); PG8_MMA(1, 1, At, B1); PG8_BAR; PG8_SCHED;
            PG8_LDB(B0, 1, 0); PG8_LDB(B1, 1, 1); PG8_SCHED; PG8_LDA(At, 1, 0); PG8_STAGE(PG8_SA(0, 1), a2 + hstep, voffA);
            PG8_WAIT_V(8); PG8_WAIT_L(0); PG8_BAR; PG8_MMA(0, 0, At, B0); PG8_MMA(0, 1, At, B1); PG8_BAR; PG8_SCHED;
            PG8_LDA(At, 1, 1); PG8_STAGE(PG8_SB(1, 0), b3, voffB); PG8_STAGE(PG8_SB(1, 1), b3 + hstep, voffB); PG8_STAGE(PG8_SA(1, 0), a3, voffA);
            PG8_WAIT_V(8); PG8_WAIT_L(0); PG8_BAR; PG8_MMA(1, 0, At, B0); PG8_MMA(1, 1, At, B1); PG8_BAR; PG8_SCHED;
            } else {
            PG8_LDB(B0, 0, 0); PG8_SCHED; PG8_LDA(At, 0, 0); PG8_STAGE(PG8_SA(1, 1), a1 + hstep, voffA);
            PG8_WAIT_L(8); PG8_BAR; PG8_WAIT_L(0); PG8_MMA(0, 0, At, B0); PG8_BAR; PG8_SCHED;
            PG8_LDB(B1, 0, 1); PG8_STAGE(PG8_SB(0, 0), b2, voffB);
            PG8_BAR; PG8_WAIT_L(0); PG8_MMA(0, 1, At, B1); PG8_BAR;
            PG8_LDA(At, 0, 1); PG8_STAGE(PG8_SA(0, 0), a2, voffA);
            PG8_BAR; PG8_WAIT_L(0); PG8_MMA(1, 0, At, B0); PG8_BAR; PG8_SCHED;
            PG8_STAGE(PG8_SB(0, 1), b2 + hstep, voffB);
            PG8_WAIT_V(6); PG8_BAR; PG8_MMA(1, 1, At, B1); PG8_BAR;
            PG8_LDB(B0, 1, 0); PG8_SCHED; PG8_LDA(At, 1, 0); PG8_STAGE(PG8_SA(0, 1), a2 + hstep, voffA);
            PG8_WAIT_L(8); PG8_BAR; PG8_WAIT_L(0); PG8_MMA(0, 0, At, B0); PG8_BAR; PG8_SCHED;
            PG8_LDB(B1, 1, 1); PG8_STAGE(PG8_SB(1, 0), b3, voffB);
            PG8_BAR; PG8_WAIT_L(0); PG8_MMA(0, 1, At, B1); PG8_BAR;
            PG8_LDA(At, 1, 1); PG8_STAGE(PG8_SA(1, 0), a3, voffA);
            PG8_BAR; PG8_WAIT_L(0); PG8_MMA(1, 0, At, B0); PG8_BAR; PG8_SCHED;
            PG8_STAGE(PG8_SB(1, 1), b3 + hstep, voffB);
            PG8_WAIT_V(6); PG8_BAR; PG8_MMA(1, 1, At, B1); PG8_BAR;
            }
        }
        if constexpr (ALIGN_EPI) { if (wr == 0) PG8_BAR; }
        if constexpr (!Epi::AFTER_DRAIN) { E(acc, cur, wr, wc, fr, fq); S.done(cur); }
        if (!has_next) break;
#pragma unroll
        for (int a = 0; a < 2; ++a)
#pragma unroll
            for (int b = 0; b < 2; ++b)
#pragma unroll
                for (int m = 0; m < 4; ++m)
#pragma unroll
                    for (int n = 0; n < 2; ++n) acc[a][b][m][n] = (f32x4){0.f, 0.f, 0.f, 0.f};
        cur = nxt; cA = nA; cB = nB; ++ui;
        if constexpr (ALIGN_EPI) { if (wr == 1) PG8_BAR; }
    }
    PG8_WAIT_V(0);
    if constexpr (!ALIGN_EPI) { if (wr == 0) PG8_BAR; }
    PG8_BAR;
    if constexpr (Epi::AFTER_DRAIN) { E.fused(acc, cur, wr, wc, fr, fq, lds, wid, lane); S.done(cur); }
#undef PG8_SA
#undef PG8_SB
#undef PG8_STAGE
#undef PG8_LDA
#undef PG8_LDB
#undef PG8_MMA
#undef PG8_WAIT_V
#undef PG8_WAIT_L
#undef PG8_BAR
#undef PG8_SCHED
}
}
#define GAS __attribute__((address_space(1)))
#define LAS __attribute__((address_space(3)))
typedef unsigned short bf16;
typedef unsigned v4u __attribute__((ext_vector_type(4)));
typedef float f32x4 __attribute__((ext_vector_type(4)));
typedef short bf16x8 __attribute__((ext_vector_type(8)));
typedef GAS unsigned gu32;
typedef GAS unsigned long long gu64;
#define RLX_AGENT __ATOMIC_RELAXED, __HIP_MEMORY_SCOPE_AGENT
#define LDS_WAIT() asm volatile("s_waitcnt lgkmcnt(0)" ::: "memory")
#define VM_WAIT() asm volatile("s_waitcnt vmcnt(0)" ::: "memory")
__device__ __forceinline__ unsigned long long rt() { return __builtin_amdgcn_s_memrealtime(); }
__device__ __forceinline__ unsigned f2bf(float f) { unsigned u = __builtin_bit_cast(unsigned, f); return (u + 0x7fffu + ((u >> 16) & 1u)) >> 16; }
__device__ __forceinline__ unsigned pk2(float lo, float hi) { return f2bf(lo) | (f2bf(hi) << 16); }
#define XB_TMO      128
#define XB_XCNT(j)  (256  + 64 * (j))
#define XB_XSUB(j)  (1280 + 64 * (j))
#define XB_XGEN(j)  (2304 + 64 * (j))
#define XB_TOP      3328
#define XB_TOPGEN   3392
#define XCD_BAR_WORDS 3456
#define XB_SPIN_CAP (1u << 18)

__device__ __forceinline__ unsigned xb_ld(unsigned* p)              { return __hip_atomic_load(p, __ATOMIC_RELAXED, __HIP_MEMORY_SCOPE_AGENT); }
__device__ __forceinline__ unsigned xb_add(unsigned* p, unsigned v) { return __hip_atomic_fetch_add(p, v, __ATOMIC_RELAXED, __HIP_MEMORY_SCOPE_AGENT); }
__device__ __forceinline__ unsigned xb_xcc_id() { return (unsigned)__builtin_amdgcn_s_getreg((3 << 11) | 20) & 0xFu; }
#define XB_SPIN(cond, bar) do { unsigned _sp = 0; while (cond) { __builtin_amdgcn_s_sleep(1); \
    if ((++_sp & 255u) == 0u) { if (xb_ld(&(bar)[XB_TMO])) break; if (_sp > XB_SPIN_CAP) { atomicAdd(&(bar)[XB_TMO], 1u); break; } } } } while (0)

struct XcdBarrier {
    unsigned* bar; unsigned x;
    volatile LAS unsigned* st;
};

__device__ __forceinline__ XcdBarrier xcd_barrier_post(unsigned* bar, volatile LAS unsigned* st) {
    XcdBarrier b; b.bar = bar; b.x = xb_xcc_id(); b.st = st;
    if (threadIdx.x == 0) (void)xb_add(&bar[XB_XCNT(b.x)], 1u);
    return b;
}
__device__ __forceinline__ void xcd_barrier_complete(unsigned* bar, unsigned x, unsigned& nloc, unsigned& nx) {
    const unsigned G = gridDim.x * gridDim.y * gridDim.z;
    unsigned sum, cnt, mine, sp = 0u;
    for (;;) {
        sum = 0u; cnt = 0u; mine = 0u;
#pragma unroll
        for (unsigned j = 0; j < 16; ++j) { const unsigned c = xb_ld(&bar[XB_XCNT(j)]); sum += c; cnt += (c > 0u) ? 1u : 0u; mine = (j == x) ? c : mine; }
        if (sum == G) break;
        __builtin_amdgcn_s_sleep(1);
        if ((++sp & 255u) == 0u) { if (xb_ld(&bar[XB_TMO])) break; if (sp > XB_SPIN_CAP) { atomicAdd(&bar[XB_TMO], 1u); break; } }
    }
    nloc = mine > 0u ? mine : 1u; nx = cnt > 0u ? cnt : 1u;
}

__device__ __forceinline__ void xcd_barrier(const XcdBarrier& b) {
    asm volatile("s_waitcnt vmcnt(0)" ::: "memory");
    __syncthreads();
    if (threadIdx.x == 0) {
        unsigned* bar = b.bar;
        __builtin_amdgcn_s_waitcnt(0);
        unsigned nloc = b.st[0], nx = b.st[1];
        if (nloc == 0u) { xcd_barrier_complete(bar, b.x, nloc, nx); b.st[0] = nloc; b.st[1] = nx; }
        const unsigned old = xb_add(&bar[XB_XSUB(b.x)], 1u);
        const unsigned gen = old / nloc;
        if (old + 1u == (gen + 1u) * nloc) {
            __builtin_amdgcn_fence(__ATOMIC_RELEASE, "agent");
            asm volatile("s_waitcnt vmcnt(0)" ::: "memory");
            const unsigned og = xb_add(&bar[XB_TOP], 1u);
            const unsigned tg = og / nx;
            if (og + 1u == (tg + 1u) * nx) xb_add(&bar[XB_TOPGEN], 1u);
            else XB_SPIN(xb_ld(&bar[XB_TOPGEN]) == tg, bar);
            __builtin_amdgcn_fence(__ATOMIC_ACQUIRE, "agent");
            xb_add(&bar[XB_XGEN(b.x)], 1u);
            asm volatile("s_waitcnt vmcnt(0)" ::: "memory");
        } else {
            XB_SPIN(xb_ld(&bar[XB_XGEN(b.x)]) == gen, bar);
            __builtin_amdgcn_fence(__ATOMIC_ACQUIRE, "agent");
            asm volatile("s_waitcnt vmcnt(0)" ::: "memory");
        }
    }
    __syncthreads();
}
namespace fp {
using pg8::Unit; using pg8::Gemm; using pg8::cvt_pk_bf16; using pg8::u32x4;
typedef unsigned u32x2v __attribute__((ext_vector_type(2)));
constexpr int D = 1024, NB = 16, L = 2048, LC = 256, TL = NB * L, TC = NB * LC, T = TL + TC;
constexpr int NWAVES = 8, NTHR = 512;
constexpr int ER = 4608;
constexpr float EPS = 1e-6f;
constexpr size_t MiB = 1u << 20;
constexpr size_t WS_CTL = 0, CTL_ZERO_BYTES = 1 * MiB;
constexpr size_t WS_MODS = 1 * MiB;
constexpr size_t WS_ROPE = 2 * MiB;
constexpr size_t WS_GATE = 3 * MiB;
constexpr size_t WS_AFF = 4 * MiB;
constexpr size_t WS_INV = 7 * MiB;
constexpr size_t WS_KR = 10 * MiB;
constexpr size_t WS_XC = 13 * MiB;
constexpr size_t WS_WOUT = 29 * MiB;
constexpr size_t WS_WMLA = 31 * MiB;
constexpr size_t WS_WUQ = 32 * MiB;
constexpr size_t WS_WUKV = WS_WUQ + 1536 * 256 * 2;
constexpr size_t WS_WO = 34 * MiB;
constexpr size_t WS_CS = 36 * MiB;
constexpr size_t WS_CSC = 52 * MiB;
constexpr size_t WS_UW = 53 * MiB;
constexpr size_t WS_WTY = WS_UW + (size_t)T * D * 2, WS_WTG = WS_WTY + 2 * MiB;
constexpr size_t WS_CQN = WS_UW, WS_CKVN = WS_UW + (size_t)T * 256 * 2, WS_O = WS_UW;
constexpr size_t WS_R1 = 129 * MiB;
constexpr size_t WS_AG = WS_R1, WS_YT = WS_R1 + 36 * MiB, WS_YTC = WS_R1 + 100 * MiB;
constexpr size_t WS_Q = WS_R1, WS_CQKV = WS_R1 + 96 * MiB;
constexpr size_t WS_R2 = 273 * MiB;
constexpr size_t WS_KN = WS_R2, WS_V = WS_R2 + 72 * MiB;
constexpr size_t WS_W13 = 417 * MiB, WS_W2 = 481 * MiB, WS_END = 513 * MiB;
constexpr int CW_BAR = 4096;
constexpr int RING_BYTES = 131072, LDS_BYTES = 144 * 1024, LDSCTL_OFF = LDS_BYTES - 1024, MISC_OFF = LDSCTL_OFF + 320, XTRA_OFF = 133120;

constexpr int PTR_OFF = LDSCTL_OFF + 512;
struct Ctx {
    float* out; unsigned char* ws; LAS unsigned char* lds;
    int tid, lane, wave, vcu, G, gw, NGW;
    __device__ __forceinline__ const float* in(int i) const {
        volatile LAS unsigned* p = (volatile LAS unsigned*)(lds + PTR_OFF) + 2 * i; unsigned lo = p[0], hi = p[1];
        lo = __builtin_amdgcn_readfirstlane(lo); hi = __builtin_amdgcn_readfirstlane(hi); return (const float*)(((unsigned long long)hi << 32) | lo); }
};
#define WSP(T_, off) ((T_*)(F.ws + (off)))
__device__ __forceinline__ int swz_xor(int v, int o) {
    switch (o) { case 1: return __builtin_amdgcn_ds_swizzle(v, (1 << 10) | 0x1f); case 2: return __builtin_amdgcn_ds_swizzle(v, (2 << 10) | 0x1f); case 4: return __builtin_amdgcn_ds_swizzle(v, (4 << 10) | 0x1f);
                 case 8: return __builtin_amdgcn_ds_swizzle(v, (8 << 10) | 0x1f); default: return __builtin_amdgcn_ds_swizzle(v, (16 << 10) | 0x1f); } }
__device__ __forceinline__ float wave_sum(float v) {
    v += __builtin_bit_cast(float, swz_xor(__builtin_bit_cast(int, v), 1)); v += __builtin_bit_cast(float, swz_xor(__builtin_bit_cast(int, v), 2));
    v += __builtin_bit_cast(float, swz_xor(__builtin_bit_cast(int, v), 4)); v += __builtin_bit_cast(float, swz_xor(__builtin_bit_cast(int, v), 8));
    v += __builtin_bit_cast(float, swz_xor(__builtin_bit_cast(int, v), 16));
    const int bits = __builtin_bit_cast(int, v);
    return __builtin_bit_cast(float, __builtin_amdgcn_readlane(bits, 0)) + __builtin_bit_cast(float, __builtin_amdgcn_readlane(bits, 32));
}
__device__ __forceinline__ int wave_sum_i(int v) {
    v += swz_xor(v, 1); v += swz_xor(v, 2); v += swz_xor(v, 4); v += swz_xor(v, 8); v += swz_xor(v, 16);
    return __builtin_amdgcn_readlane(v, 0) + __builtin_amdgcn_readlane(v, 32);
}
__device__ __forceinline__ float siluf(float v) { return v / (1.f + __expf(-v)); }
__device__ __forceinline__ float bf2f(unsigned short h) { return __builtin_bit_cast(float, (unsigned)h << 16); }

__device__ __forceinline__ void p0_mods(Ctx& F) {
    LAS float* sc = (LAS float*)F.lds;
    LAS float* red = (LAS float*)(F.lds + 17 * 1024 * 4);
    { const float* c_ = F.in(1); const float* cc_ = F.in(3);
      for (int i = F.tid; i < 17 * 1024; i += NTHR) { const float v = i < 16 * 1024 ? c_[i] : cc_[i - 16 * 1024]; sc[i] = siluf(v); } }
    __syncthreads();
    float* MODS = WSP(float, WS_MODS);
    for (int item = blockIdx.x; item < 192; item += F.G) {
        const int ly = item / 96, n0 = (item % 96) * 64, k0 = F.wave * 128;
        const float* W = F.in(4) + (size_t)ly * 1024 * 6144 + n0 + F.lane;
        float acc[17];
#pragma unroll
        for (int r = 0; r < 17; ++r) acc[r] = 0.f;
#pragma unroll 4
        for (int kk = 0; kk < 128; ++kk) { const float w = W[(size_t)(k0 + kk) * 6144];
#pragma unroll
            for (int r = 0; r < 17; ++r) acc[r] += sc[r * 1024 + k0 + kk] * w; }
#pragma unroll
        for (int r = 0; r < 17; ++r) red[(F.wave * 17 + r) * 64 + F.lane] = acc[r];
        __syncthreads();
        const float* mb_ = F.in(5);
        for (int o = F.tid; o < 17 * 64; o += NTHR) { const int r = o >> 6, c = o & 63; float s = mb_[ly * 6144 + n0 + c];
#pragma unroll
            for (int w = 0; w < 8; ++w) s += red[(w * 17 + r) * 64 + c];
            MODS[(size_t)(ly * 17 + r) * 6144 + n0 + c] = s; }
        __syncthreads();
    }
}
struct MapId { int off; __device__ __forceinline__ int operator()(int n) const { return off + n; } };
struct MapGlu { __device__ __forceinline__ int operator()(int n) const { const int s = n >> 9, c = n & 511; return 8 * (c >> 2) + 4 * s + (c & 3); } };
struct Map13 { int s; __device__ __forceinline__ int operator()(int n) const { return 8 * (n >> 2) + 4 * s + (n & 3); } };
template <class RowMap>
__device__ __forceinline__ void tr_write(LAS float* scr, bf16* WT, int ldt, int k0, int n0, RowMap rm, int lane) {
    const int c = lane & 7;
#pragma unroll
    for (int j = 0; j < 4; ++j) { const int n = (lane >> 3) + 8 * j; const LAS float* s = scr + (8 * c) * 33 + n;
        v4u o; o.x = pk2(s[0 * 33], s[1 * 33]); o.y = pk2(s[2 * 33], s[3 * 33]); o.z = pk2(s[4 * 33], s[5 * 33]); o.w = pk2(s[6 * 33], s[7 * 33]);
        *(GAS v4u*)(WT + (size_t)rm(n0 + n) * ldt + k0 + 8 * c) = o; }
    LDS_WAIT(); asm volatile("" ::: "memory");
}
template <class RowMap>
__device__ __forceinline__ void tr_item(const float* W, int ldw, int nblk, bf16* WT, int ldt, RowMap rm, LAS float* scr, int item, int lane) {
    const int kb = item / nblk, nb = item % nblk, k0 = 64 * kb, n0 = 32 * nb;
#pragma unroll 8
    for (int i = 0; i < 32; ++i) { const int kk = 2 * i + (lane >> 5); scr[kk * 33 + (lane & 31)] = W[(size_t)(k0 + kk) * ldw + n0 + (lane & 31)]; }
    LDS_WAIT(); asm volatile("" ::: "memory");
    tr_write(scr, WT, ldt, k0, n0, rm, lane);
}
__device__ __forceinline__ void wy_item(Ctx& F, LAS float* scr, LAS float* wst  , const LAS float* tab, int item) {
    const int lane = F.lane, kb = item >> 5, nb = item & 31, k0 = 64 * kb, n0 = 32 * nb;
    const int half = n0 >> 9, g = (n0 >> 7) & 3, m = (n0 & 127) + (lane & 31);
    const float* Wi = F.in(8) + (size_t)k0 * 1536 + 1024 + g * 128;
    for (int i = 0; i < 128; ++i) { const int kk = i >> 1, cc = (i & 1) * 64 + lane; wst[kk * 128 + cc] = Wi[(size_t)kk * 1536 + cc]; }
    LDS_WAIT(); asm volatile("" ::: "memory");
    for (int i = 0; i < 32; ++i) { const int kk = 2 * i + (lane >> 5); float s = 0.f;
        for (int c = 0; c < 128; ++c) { const int ph = (c * m + (half ? 96 : 0)) & 127; s += wst[kk * 128 + c] * tab[ph]; }
        scr[kk * 33 + (lane & 31)] = s; }
    LDS_WAIT(); asm volatile("" ::: "memory");
    tr_write(scr, WSP(bf16, WS_WTY), 1024, k0, n0, MapId{0}, lane);
}
__device__ __forceinline__ void moe_w_items(Ctx& F, int ly, LAS float* scr) {
    const size_t wl = (size_t)ly * 16 * 1024 * 1024;
    for (int it = F.gw; it < 16 * 1536; it += F.NGW) {
        const int e = it / 1536, r = it % 1536, which = r >> 9, item = r & 511;
        if (which == 0) tr_item(F.in(21) + wl + (size_t)e * 1048576, 1024, 32, WSP(bf16, WS_W13) + (size_t)e * 2048 * 1024, 1024, Map13{0}, scr, item, F.lane);
        else if (which == 1) tr_item(F.in(22) + wl + (size_t)e * 1048576, 1024, 32, WSP(bf16, WS_W13) + (size_t)e * 2048 * 1024, 1024, Map13{1}, scr, item, F.lane);
        else tr_item(F.in(23) + wl + (size_t)e * 1048576, 1024, 32, WSP(bf16, WS_W2) + (size_t)e * 1024 * 1024, 1024, MapId{0}, scr, item, F.lane);
    }
}
__device__ __forceinline__ void p0_prologue(Ctx& F) {
    p0_mods(F);
    LAS float* tab128 = (LAS float*)(F.lds + XTRA_OFF); LAS float* tab2048 = tab128 + 128; LAS float* tab256 = tab2048 + 2048;
    for (int i = F.tid; i < 128 + 2048 + 256; i += NTHR) { float s, c;
        if (i < 128) sincospif(2.f * (float)i / 128.f, &s, &c); else if (i < 128 + 2048) sincospif(2.f * (float)(i - 128) / 2048.f, &s, &c); else sincospif(2.f * (float)(i - 2176) / 256.f, &s, &c);
        tab128[i] = c; }
    __syncthreads();
    LAS float* scr = (LAS float*)(F.lds + F.wave * 8448);
    constexpr int I_G = 512, I_OUT = 512, I_MLA = 16 * 13, I_UQ = 4 * 48, I_UKV = 2 * 64, I_O = 512;
    constexpr int NI = I_G + I_OUT + I_MLA + I_UQ + I_UKV + I_O;
    for (int it = F.gw; it < NI; it += F.NGW) { int r = it;
        if (r < I_G) { tr_item(F.in(8), 1536, 32, WSP(bf16, WS_WTG), 1024, MapGlu{}, scr, r, F.lane); continue; } r -= I_G;
        if (r < I_OUT) { tr_item(F.in(13), 1024, 32, WSP(bf16, WS_WOUT), 1024, MapId{0}, scr, r, F.lane); continue; } r -= I_OUT;
        if (r < I_MLA) { tr_item(F.in(14), 416, 13, WSP(bf16, WS_WMLA), 1024, MapId{0}, scr, r, F.lane); continue; } r -= I_MLA;
        if (r < I_UQ) { tr_item(F.in(17), 1536, 48, WSP(bf16, WS_WUQ), 256, MapId{0}, scr, r, F.lane); continue; } r -= I_UQ;
        if (r < I_UKV) { tr_item(F.in(18), 2048, 64, WSP(bf16, WS_WUKV), 256, MapId{0}, scr, r, F.lane); continue; } r -= I_UKV;
        tr_item(F.in(19), 1024, 32, WSP(bf16, WS_WO), 1024, MapId{0}, scr, r, F.lane);
    }
    if (F.wave < 2) { LAS float* w2 = (LAS float*)(F.lds + 8 * 8448 + F.wave * 32768);
        for (int it = F.vcu * 2 + F.wave; it < 512; it += F.G * 2) wy_item(F, scr, w2, tab128, it); }
    { v4u z = {0u, 0u, 0u, 0u};
      for (int i = F.gw * 64 + F.lane; i < 96 * 128; i += F.NGW * 64) *(GAS v4u*)(WSP(bf16, WS_WMLA) + (size_t)416 * 1024 + (size_t)i * 8) = z;
      for (int i = F.gw * 64 + F.lane; i < 2048 * 16; i += F.NGW * 64) *(GAS v4u*)(WSP(bf16, WS_WUKV) + (size_t)(i >> 4) * 256 + 128 + (i & 15) * 8) = z; }
    { const float sc = 1.f / sqrtf(2048.f * 128.f);
      for (int id = F.gw * 64 + F.lane; id < 2048 * 512; id += F.NGW * 64) { const int k = id >> 9, l0 = (id & 511) * 8; float v[8];
#pragma unroll
          for (int j = 0; j < 8; ++j) { const int lp = l0 + j, l = lp & 2047; int ph = (k * l) & 2047; float x; if (lp < 2048) x = tab2048[ph]; else x = -tab2048[(ph + 1536) & 2047]; v[j] = x * sc; }
          v4u o; o.x = pk2(v[0], v[1]); o.y = pk2(v[2], v[3]); o.z = pk2(v[4], v[5]); o.w = pk2(v[6], v[7]);
          *(GAS v4u*)(WSP(bf16, WS_CS) + (size_t)k * 4096 + l0) = o; } }
    { const float sc = 1.f / sqrtf(256.f * 128.f);
      for (int id = F.gw * 64 + F.lane; id < 256 * 64; id += F.NGW * 64) { const int k = id >> 6, l0 = (id & 63) * 8; float v[8];
#pragma unroll
          for (int j = 0; j < 8; ++j) { const int lp = l0 + j, l = lp & 255; int ph = (k * l) & 255; float x; if (lp < 256) x = tab256[ph]; else x = -tab256[(ph + 192) & 255]; v[j] = x * sc; }
          v4u o; o.x = pk2(v[0], v[1]); o.y = pk2(v[2], v[3]); o.z = pk2(v[4], v[5]); o.w = pk2(v[6], v[7]);
          *(GAS v4u*)(WSP(bf16, WS_CSC) + (size_t)k * 512 + l0) = o; } }
    for (int i = F.gw * 64 + F.lane; i < 2048 * 16; i += F.NGW * 64) { const int l = i >> 4, p = i & 15;
        const float pos = (p < 8) ? (float)(l >> 6) : (float)(l & 63); const float inv = powf(10000.f, -(float)(p & 7) / 8.f); float s, c; sincosf(pos * inv, &s, &c);
        WSP(float, WS_ROPE)[2 * i] = c; WSP(float, WS_ROPE)[2 * i + 1] = s; }
    moe_w_items(F, 0, scr);
}

__device__ __forceinline__ void load_row(const float* p, int lane, f32x4 (&v)[4]) {
    const GAS f32x4* xr = (const GAS f32x4*)p + lane;
#pragma unroll
    for (int j = 0; j < 4; ++j) v[j] = xr[64 * j];
}
__device__ __forceinline__ float row_ss(const f32x4 (&v)[4]) { float s = 0.f;
#pragma unroll
    for (int j = 0; j < 4; ++j) s += (v[j].x * v[j].x + v[j].y * v[j].y) + (v[j].z * v[j].z + v[j].w * v[j].w);
    return wave_sum(s); }
__device__ __forceinline__ void store_row_bf16(bf16* orow, int lane, const f32x4 (&v)[4]) {
    GAS unsigned long long* o8 = (GAS unsigned long long*)orow + lane;
#pragma unroll
    for (int j = 0; j < 4; ++j) o8[64 * j] = (unsigned long long)pk2(v[j].x, v[j].y) | ((unsigned long long)pk2(v[j].z, v[j].w) << 32);
}
__device__ __forceinline__ int mod_row(int t) { return t < TL ? (t >> 11) : 16; }
__device__ __forceinline__ void norm_mod(f32x4 (&v)[4], float rstd, const float* g, const float* md, int ch_sh, int ch_sc, int lane) {
#pragma unroll
    for (int j = 0; j < 4; ++j) { const int c = 4 * lane + 256 * j;
        const f32x4 gg = *(const GAS f32x4*)(g + c), sc = *(const GAS f32x4*)(md + ch_sc * 1024 + c), sh = *(const GAS f32x4*)(md + ch_sh * 1024 + c);
        v[j] = v[j] * rstd * gg * (1.f + sc) + sh; }
}
__device__ __forceinline__ void p1_norm(Ctx& F) {
    const float* MODS = WSP(float, WS_MODS); const float* xin = F.in(0); const float* cin = F.in(2); const float* n1g = F.in(6);
    for (int i = 0; i < 18; ++i) { const int t = F.gw * 18 + i; if (t >= T) break;
        const float* src = t < TL ? xin + (size_t)t * D : cin + (size_t)(t - TL) * D;
        f32x4 v[4]; load_row(src, F.lane, v);
        const float rstd = rsqrtf(row_ss(v) * (1.f / D) + EPS);
        norm_mod(v, rstd, n1g, MODS + (size_t)mod_row(t) * 6144, 0, 1, F.lane);
        store_row_bf16(WSP(bf16, WS_UW) + (size_t)t * D, F.lane, v); }
}
__device__ __forceinline__ void p3_conv(Ctx& F) {
    LAS float* cw = (LAS float*)F.lds;
    { const float* cw_ = F.in(9); for (int i = F.tid; i < 31 * 512; i += NTHR) cw[i] = cw_[i]; }
    __syncthreads();
    const bf16* AG = WSP(bf16, WS_AG); bf16* CAT = WSP(bf16, WS_R2);
    const int c0 = 8 * F.lane;
    float cb[8], lg[8], lb[8];
    { const float* p10 = F.in(10); const float* p11 = F.in(11); const float* p12 = F.in(12);
#pragma unroll
      for (int q = 0; q < 8; ++q) { cb[q] = p10[c0 + q]; lg[q] = p11[c0 + q]; lb[q] = p12[c0 + q]; } }
    for (int i = 0; i < 18; ++i) { const int t = F.gw * 18 + i; if (t >= T) break;
        int l, Ls; if (t < TL) { l = t & 2047; Ls = 2048; } else { l = (t - TL) & 255; Ls = 256; }
        float acc[8];
#pragma unroll
        for (int q = 0; q < 8; ++q) acc[q] = cb[q];
        for (int j = 0; j < 31; ++j) { const int ll = l + j - 15; if (ll < 0 || ll >= Ls) continue;
            const v4u raw = *(const GAS v4u*)(AG + (size_t)(t + j - 15) * 512 + c0);
            const f32x4 w0 = *(const LAS f32x4*)(cw + j * 512 + c0), w1 = *(const LAS f32x4*)(cw + j * 512 + c0 + 4);
            acc[0] += __builtin_bit_cast(float, raw.x << 16) * w0.x; acc[1] += __builtin_bit_cast(float, raw.x & 0xffff0000u) * w0.y;
            acc[2] += __builtin_bit_cast(float, raw.y << 16) * w0.z; acc[3] += __builtin_bit_cast(float, raw.y & 0xffff0000u) * w0.w;
            acc[4] += __builtin_bit_cast(float, raw.z << 16) * w1.x; acc[5] += __builtin_bit_cast(float, raw.z & 0xffff0000u) * w1.y;
            acc[6] += __builtin_bit_cast(float, raw.w << 16) * w1.z; acc[7] += __builtin_bit_cast(float, raw.w & 0xffff0000u) * w1.w; }
        float s = 0.f;
#pragma unroll
        for (int q = 0; q < 8; ++q) s += acc[q];
        const float mu = wave_sum(s) * (1.f / 512.f); float s2 = 0.f;
#pragma unroll
        for (int q = 0; q < 8; ++q) { acc[q] -= mu; s2 += acc[q] * acc[q]; }
        const float r = rsqrtf(wave_sum(s2) * (1.f / 512.f) + EPS);
#pragma unroll
        for (int q = 0; q < 8; ++q) acc[q] = siluf(acc[q] * r * lg[q] + lb[q]);
        v4u o; o.x = pk2(acc[0], acc[1]); o.y = pk2(acc[2], acc[3]); o.z = pk2(acc[4], acc[5]); o.w = pk2(acc[6], acc[7]);
        *(GAS v4u*)(CAT + (size_t)t * 1024 + c0) = o; }
    __syncthreads();
}
__device__ __forceinline__ void m1_route(Ctx& F, int ly, int nrows) {
    LAS float* wr = (LAS float*)F.lds;
    { const float* wr_ = F.in(20) + (size_t)ly * 16384; for (int i = F.tid; i < 16 * 1024; i += NTHR) { const int k = i >> 4, e = i & 15; wr[e * 1024 + k] = wr_[i]; } }
    __syncthreads();
    const float* MODS = WSP(float, WS_MODS) + (size_t)ly * 17 * 6144; const float* n2g = F.in(7) + ly * D;
    const int per = (nrows + F.NGW - 1) / F.NGW;
    for (int i = 0; i < per; ++i) { const int t = F.gw * per + i; if (t >= nrows) break;
        const float* src = t < TL ? F.out + (size_t)t * D : WSP(float, WS_XC) + (size_t)(t - TL) * D;
        f32x4 v[4]; load_row(src, F.lane, v);
        const float rstd = rsqrtf(row_ss(v) * (1.f / D) + EPS);
        norm_mod(v, rstd, n2g, MODS + (size_t)mod_row(t) * 6144, 3, 4, F.lane);
        store_row_bf16(WSP(bf16, WS_UW) + (size_t)t * D, F.lane, v);
        float lg[16];
#pragma unroll
        for (int e = 0; e < 16; ++e) { float s = 0.f;
#pragma unroll
            for (int j = 0; j < 4; ++j) { const f32x4 w = *(const LAS f32x4*)(wr + e * 1024 + 256 * j + 4 * F.lane); s += (v[j].x * w.x + v[j].y * w.y) + (v[j].z * w.z + v[j].w * w.w); }
            lg[e] = wave_sum(s); }
        float mx = lg[0];
#pragma unroll
        for (int e = 1; e < 16; ++e) mx = fmaxf(mx, lg[e]);
        float sum = 0.f;
#pragma unroll
        for (int e = 0; e < 16; ++e) { lg[e] = __expf(lg[e] - mx); sum += lg[e]; }
        float mine = lg[0];
#pragma unroll
        for (int e = 1; e < 16; ++e) mine = (F.lane == e) ? lg[e] : mine;
        if (F.lane < 16) { WSP(float, WS_AFF)[(size_t)t * 16 + F.lane] = mine / sum; WSP(int, WS_INV)[(size_t)t * 16 + F.lane] = -1; } }
    __syncthreads();
}
__device__ __forceinline__ void m2_unit(Ctx& F, int unit) {
    LAS int* cntw = (LAS int*)F.lds;
    LAS int* wtot = (LAS int*)(F.lds + 128);
    LAS int* sel = (LAS int*)(F.lds + 256);
    const bool isc = unit >= 256; const int u2 = isc ? unit - 256 : unit, b = u2 >> 4, e = u2 & 15;
    const int Ls = isc ? 256 : 2048, cap = isc ? 32 : 256, tb = isc ? TL + b * 256 : b * 2048, rowbase = e * ER + (isc ? 4096 + b * 32 : b * 256);
    const float* AFF = WSP(float, WS_AFF);
    unsigned v[4];
#pragma unroll
    for (int i = 0; i < 4; ++i) { const int tok = i * NTHR + F.tid; v[i] = tok < Ls ? __builtin_bit_cast(unsigned, AFF[(size_t)(tb + tok) * 16 + e]) : 0u; }
    unsigned lo = 0u;
    for (int bit = 30; bit >= 0; --bit) { const unsigned cand = lo | (1u << bit);
        int c = (int)(v[0] >= cand) + (int)(v[1] >= cand) + (int)(v[2] >= cand) + (int)(v[3] >= cand);
        c = wave_sum_i(c); if (F.lane == 0) cntw[(bit & 1) * 8 + F.wave] = c;
        __syncthreads();
        int tot = 0;
#pragma unroll
        for (int w = 0; w < 8; ++w) tot += cntw[(bit & 1) * 8 + w];
        if (tot >= cap) lo = cand; }
    int pg[4], pq[4];
#pragma unroll
    for (int i = 0; i < 4; ++i) { const unsigned long long bg = __ballot(v[i] > lo), bq = __ballot(v[i] == lo && lo != 0u);
        pg[i] = __builtin_amdgcn_mbcnt_hi((unsigned)(bg >> 32), __builtin_amdgcn_mbcnt_lo((unsigned)bg, 0u));
        pq[i] = __builtin_amdgcn_mbcnt_hi((unsigned)(bq >> 32), __builtin_amdgcn_mbcnt_lo((unsigned)bq, 0u));
        if (F.lane == 0) wtot[i * 8 + F.wave] = __popcll(bg) | (__popcll(bq) << 16); }
    __syncthreads();
    int total = 0, base[4];
#pragma unroll
    for (int i = 0; i < 4; ++i)
#pragma unroll
        for (int w = 0; w < 8; ++w) { if (w == 0) base[i] = 0; const int x = wtot[i * 8 + w]; if (w == F.wave) base[i] = total; total += x; }
    const int ngt = total & 0xffff, need = cap - ngt;
#pragma unroll
    for (int i = 0; i < 4; ++i) { const int tok = i * NTHR + F.tid; int slot = -1;
        if (v[i] > lo) slot = (base[i] & 0xffff) + pg[i]; else if (v[i] == lo && lo != 0u) { const int qr = (base[i] >> 16) + pq[i]; if (qr < need) slot = ngt + qr; }
        if (slot >= 0) { sel[slot] = tok; WSP(float, WS_GATE)[rowbase + slot] = __builtin_bit_cast(float, v[i]); WSP(int, WS_INV)[(size_t)(tb + tok) * 16 + e] = rowbase + slot; } }
    __syncthreads();
    const bf16* U = WSP(bf16, WS_UW); bf16* XG = WSP(bf16, WS_R1);
    for (int s = F.wave; s < cap; s += 8) { const int tok = sel[s];
        const GAS v4u* src = (const GAS v4u*)(U + (size_t)(tb + tok) * D); GAS v4u* dst = (GAS v4u*)(XG + (size_t)(rowbase + s) * D);
        const v4u a = src[F.lane], c2 = src[64 + F.lane]; dst[F.lane] = a; dst[64 + F.lane] = c2; }
    __syncthreads();
}
__device__ __forceinline__ void combine_row(Ctx& F, int t, int ly, f32x4 (&v)[4]) {
    const int myinv = F.lane < 16 ? WSP(int, WS_INV)[(size_t)t * 16 + F.lane] : -1;
    f32x4 a[4];
#pragma unroll
    for (int j = 0; j < 4; ++j) a[j] = (f32x4){0.f, 0.f, 0.f, 0.f};
    const bf16* YB = WSP(bf16, WS_R1);
#pragma unroll
    for (int e = 0; e < 16; ++e) { const int r = __builtin_amdgcn_readlane(myinv, e); if (r < 0) continue;
        const GAS u32x2v* yr = (const GAS u32x2v*)(YB + (size_t)r * D) + F.lane;
#pragma unroll
        for (int j = 0; j < 4; ++j) { const u32x2v w = yr[64 * j];
            a[j].x += __builtin_bit_cast(float, w.x << 16); a[j].y += __builtin_bit_cast(float, w.x & 0xffff0000u);
            a[j].z += __builtin_bit_cast(float, w.y << 16); a[j].w += __builtin_bit_cast(float, w.y & 0xffff0000u); } }
    const float* g2 = WSP(float, WS_MODS) + ((size_t)ly * 17 + mod_row(t)) * 6144 + 5 * 1024;
#pragma unroll
    for (int j = 0; j < 4; ++j) { const f32x4 gg = *(const GAS f32x4*)(g2 + 4 * F.lane + 256 * j); v[j] = v[j] + gg * a[j]; }
}
__device__ __forceinline__ void store_row_f32(float* p, int lane, const f32x4 (&v)[4]) {
    GAS f32x4* o = (GAS f32x4*)p + lane;
#pragma unroll
    for (int j = 0; j < 4; ++j) o[64 * j] = v[j];
}
__device__ __forceinline__ void a0_combine(Ctx& F) {
    const float* MODS1 = WSP(float, WS_MODS) + (size_t)17 * 6144; const float* n1g = F.in(6) + D;
    for (int i = 0; i < 18; ++i) { const int t = F.gw * 18 + i; if (t >= T) break;
        float* xr = t < TL ? F.out + (size_t)t * D : WSP(float, WS_XC) + (size_t)(t - TL) * D;
        f32x4 v[4]; load_row(xr, F.lane, v);
        combine_row(F, t, 0, v);
        store_row_f32(xr, F.lane, v);
        const float rstd = rsqrtf(row_ss(v) * (1.f / D) + EPS);
        norm_mod(v, rstd, n1g, MODS1 + (size_t)mod_row(t) * 6144, 0, 1, F.lane);
        store_row_bf16(WSP(bf16, WS_UW) + (size_t)t * D, F.lane, v); }
    LAS float* scr = (LAS float*)(F.lds + F.wave * 8448);
    moe_w_items(F, 1, scr);
}
__device__ __forceinline__ void p_final(Ctx& F) {
    const float* fg = F.in(24);
    for (int i = 0; i < 16; ++i) { const int t = F.gw * 16 + i; if (t >= TL) break;
        float* xr = F.out + (size_t)t * D;
        f32x4 v[4]; load_row(xr, F.lane, v);
        combine_row(F, t, 1, v);
        const float rstd = rsqrtf(row_ss(v) * (1.f / D) + EPS);
#pragma unroll
        for (int j = 0; j < 4; ++j) { const f32x4 gg = *(const GAS f32x4*)(fg + 4 * F.lane + 256 * j); v[j] = v[j] * rstd * gg; }
        store_row_f32(xr, F.lane, v); }
}
__device__ __forceinline__ void a1_lowrank(Ctx& F) {
    const bf16* CQKV = WSP(bf16, WS_CQKV); const float* qg = F.in(15); const float* kvg = F.in(16);
    for (int i = 0; i < 18; ++i) { const int t = F.gw * 18 + i; if (t >= T) break;
        const int col = F.lane < 52 ? 8 * F.lane : 0;
        const v4u raw = *(const GAS v4u*)(CQKV + (size_t)t * 512 + col);
        float x[8]; x[0] = __builtin_bit_cast(float, raw.x << 16); x[1] = __builtin_bit_cast(float, raw.x & 0xffff0000u); x[2] = __builtin_bit_cast(float, raw.y << 16); x[3] = __builtin_bit_cast(float, raw.y & 0xffff0000u);
        x[4] = __builtin_bit_cast(float, raw.z << 16); x[5] = __builtin_bit_cast(float, raw.z & 0xffff0000u); x[6] = __builtin_bit_cast(float, raw.w << 16); x[7] = __builtin_bit_cast(float, raw.w & 0xffff0000u);
        float ss = 0.f;
#pragma unroll
        for (int q = 0; q < 8; ++q) ss += x[q] * x[q];
        const float sq = wave_sum(F.lane < 32 ? ss : 0.f), skv = wave_sum((F.lane >= 32 && F.lane < 48) ? ss : 0.f);
        const float rq = rsqrtf(sq * (1.f / 256.f) + EPS), rkv = rsqrtf(skv * (1.f / 128.f) + EPS);
        if (F.lane < 32) { if (t < TL) { float y[8];
#pragma unroll
                for (int q = 0; q < 8; ++q) y[q] = x[q] * rq * qg[8 * F.lane + q];
                v4u o; o.x = pk2(y[0], y[1]); o.y = pk2(y[2], y[3]); o.z = pk2(y[4], y[5]); o.w = pk2(y[6], y[7]);
                *(GAS v4u*)(WSP(bf16, WS_CQN) + (size_t)t * 256 + 8 * F.lane) = o; } }
        else if (F.lane < 48) { float y[8];
#pragma unroll
            for (int q = 0; q < 8; ++q) y[q] = x[q] * rkv * kvg[8 * (F.lane - 32) + q];
            v4u o; o.x = pk2(y[0], y[1]); o.y = pk2(y[2], y[3]); o.z = pk2(y[4], y[5]); o.w = pk2(y[6], y[7]);
            *(GAS v4u*)(WSP(bf16, WS_CKVN) + (size_t)t * 256 + 8 * (F.lane - 32)) = o; }
        else {
            const v4u z = {0u, 0u, 0u, 0u};
            *(GAS v4u*)(WSP(bf16, WS_CKVN) + (size_t)t * 256 + 128 + 8 * (F.lane - 48)) = z;
            if (F.lane < 52) { int b, key; float y[8];
                if (t < TL) { b = t >> 11; const int l = t & 2047; key = 256 + l; const float* rt = WSP(float, WS_ROPE) + (size_t)l * 32 + 8 * (F.lane - 48);
#pragma unroll
                    for (int p = 0; p < 4; ++p) { const float c = rt[2 * p], s = rt[2 * p + 1]; y[2 * p] = x[2 * p] * c - x[2 * p + 1] * s; y[2 * p + 1] = x[2 * p] * s + x[2 * p + 1] * c; } }
                else { b = (t - TL) >> 8; key = (t - TL) & 255;
#pragma unroll
                    for (int q = 0; q < 8; ++q) y[q] = x[q]; }
                v4u o; o.x = pk2(y[0], y[1]); o.y = pk2(y[2], y[3]); o.z = pk2(y[4], y[5]); o.w = pk2(y[6], y[7]);
                *(GAS v4u*)(WSP(bf16, WS_KR) + ((size_t)b * 2304 + key) * 32 + 8 * (F.lane - 48)) = o; } } }
}
}
namespace fp {
__device__ __forceinline__ u32x4 pack8(const f32x4& a, const f32x4& b) { u32x4 w; w.x = cvt_pk_bf16(a[0], a[1]); w.y = cvt_pk_bf16(a[2], a[3]); w.z = cvt_pk_bf16(b[0], b[1]); w.w = cvt_pk_bf16(b[2], b[3]); return w; }
typedef pg8::f32x4 A4;
#define EPI_ARGS const A4 (&acc)[2][2][4][2], const Unit& u, int wr, int wc, int fr, int fq
struct EpiG1 { static constexpr bool PERM = true, AFTER_DRAIN = false; bf16* AG; bf16* YT; bf16* YTC;
    __device__ __forceinline__ void operator()(EPI_ARGS) const {
        if (u.pm < 144) { const int row0 = u.pm * 256 + wr * 64 + fr, col0 = ((u.pn - 148) * 256 + wc * 32 + 8 * fq) >> 1;
#pragma unroll
            for (int ai = 0; ai < 2; ++ai)
#pragma unroll
                for (int m = 0; m < 4; ++m) { bf16* rowp = AG + (size_t)(row0 + ai * 128 + m * 16) * 512 + col0;
#pragma unroll
                    for (int bj = 0; bj < 2; ++bj) { const A4 v = acc[ai][bj][m][0], g = acc[ai][bj][m][1]; A4 a;
#pragma unroll
                        for (int i = 0; i < 4; ++i) a[i] = v[i] / (1.f + __expf(-g[i]));
                        u32x2v w; w.x = cvt_pk_bf16(a[0], a[1]); w.y = cvt_pk_bf16(a[2], a[3]); *(u32x2v*)(rowp + bj * 64) = w; } }
        } else { const int r0 = (u.pm - 144) * 256 + wr * 64 + fr, tk0 = u.pn * 256 + wc * 32 + 8 * fq;
#pragma unroll
            for (int ai = 0; ai < 2; ++ai)
#pragma unroll
                for (int m = 0; m < 4; ++m) { const int r = r0 + ai * 128 + m * 16, half = r >> 9, ncol = r & 511;
#pragma unroll
                    for (int bj = 0; bj < 2; ++bj) { const int tk = tk0 + bj * 128; bf16* p;
                        if (u.pn < 128) { const int b = u.pn >> 3, l = tk - b * 2048; p = YT + ((size_t)(b * 512 + ncol) * 4096 + half * 2048 + l); }
                        else { const int tkc = tk - TL, b = tkc >> 8, l = tkc & 255; p = YTC + ((size_t)(b * 512 + ncol) * 512 + half * 256 + l); }
                        *(u32x4*)p = pack8(acc[ai][bj][m][0], acc[ai][bj][m][1]); } } }
    } };
struct EpiF { static constexpr bool PERM = true, AFTER_DRAIN = false; bf16* CAT; int rows_per_b, tokbase;
    __device__ __forceinline__ void operator()(EPI_ARGS) const {
        const int k0 = u.pm * 256 + wr * 64 + fr, c0 = u.pn * 256 + wc * 32 + 8 * fq;
#pragma unroll
        for (int bj = 0; bj < 2; ++bj) { const int c = c0 + bj * 128, b = c >> 9, n = c & 511; bf16* colp = CAT + (size_t)(tokbase + b * rows_per_b) * 1024 + 512 + n;
#pragma unroll
            for (int ai = 0; ai < 2; ++ai)
#pragma unroll
                for (int m = 0; m < 4; ++m) *(u32x4*)(colp + (size_t)(k0 + ai * 128 + m * 16) * 1024) = pack8(acc[ai][bj][m][0], acc[ai][bj][m][1]); }
    } };
struct EpiRes { static constexpr bool PERM = false, AFTER_DRAIN = false; const float* base_lat; const float* base_ctx; float* out_lat; float* out_ctx; const float* gates  ;
    __device__ __forceinline__ void operator()(EPI_ARGS) const {
        const int trow = u.pm * 256; const bool isc = trow >= TL; const int mr = isc ? 16 : (trow >> 11);
        const float* bp = isc ? base_ctx + (size_t)(trow - TL) * D : base_lat + (size_t)trow * D; float* op = isc ? out_ctx + (size_t)(trow - TL) * D : out_lat + (size_t)trow * D;
        const int col0 = u.pn * 256 + wc * 32 + 4 * fq; const float* gp = gates + (size_t)mr * 6144 + col0;
        A4 gv[2][2];
#pragma unroll
        for (int bj = 0; bj < 2; ++bj)
#pragma unroll
            for (int n = 0; n < 2; ++n) gv[bj][n] = *(const A4*)(gp + bj * 128 + n * 16);
#pragma unroll
        for (int ai = 0; ai < 2; ++ai)
#pragma unroll
            for (int m = 0; m < 4; ++m) { const size_t off = (size_t)(wr * 64 + fr + ai * 128 + m * 16) * D + col0;
#pragma unroll
                for (int bj = 0; bj < 2; ++bj)
#pragma unroll
                    for (int n = 0; n < 2; ++n) { const A4 bs = *(const A4*)(bp + off + bj * 128 + n * 16); *(A4*)(op + off + bj * 128 + n * 16) = bs + gv[bj][n] * acc[ai][bj][m][n]; }
                asm volatile("" ::: "memory"); }
    } };
struct EpiSwiglu { static constexpr bool PERM = true, AFTER_DRAIN = false; bf16* HID;
    __device__ __forceinline__ void operator()(EPI_ARGS) const {
        const int row0 = u.pm * 256 + wr * 64 + fr, col0 = ((u.pn & 7) * 256 + wc * 32 + 8 * fq) >> 1;
#pragma unroll
        for (int ai = 0; ai < 2; ++ai)
#pragma unroll
            for (int m = 0; m < 4; ++m) { bf16* rowp = HID + (size_t)(row0 + ai * 128 + m * 16) * 1024 + col0;
#pragma unroll
                for (int bj = 0; bj < 2; ++bj) { const A4 v = acc[ai][bj][m][0], g = acc[ai][bj][m][1]; A4 a;
#pragma unroll
                    for (int i = 0; i < 4; ++i) a[i] = v[i] / (1.f + __expf(-v[i])) * g[i];
                    u32x2v w; w.x = cvt_pk_bf16(a[0], a[1]); w.y = cvt_pk_bf16(a[2], a[3]); *(u32x2v*)(rowp + bj * 64) = w; } }
    } };
struct EpiGate { static constexpr bool PERM = true, AFTER_DRAIN = false; bf16* YB; const float* GATE;
    __device__ __forceinline__ void operator()(EPI_ARGS) const {
        const int row0 = u.pm * 256 + wr * 64 + fr, col0 = (u.pn & 3) * 256 + wc * 32 + 8 * fq;
#pragma unroll
        for (int ai = 0; ai < 2; ++ai)
#pragma unroll
            for (int m = 0; m < 4; ++m) { const int row = row0 + ai * 128 + m * 16; const float gt = GATE[row]; bf16* rowp = YB + (size_t)row * 1024 + col0;
#pragma unroll
                for (int bj = 0; bj < 2; ++bj) *(u32x4*)(rowp + bj * 128) = pack8(acc[ai][bj][m][0] * gt, acc[ai][bj][m][1] * gt); }
    } };
struct EpiPlain { static constexpr bool PERM = true, AFTER_DRAIN = false; bf16* O; int ldc;
    __device__ __forceinline__ void operator()(EPI_ARGS) const {
        const int row0 = u.pm * 256 + wr * 64 + fr, col0 = u.pn * 256 + wc * 32 + 8 * fq;
#pragma unroll
        for (int ai = 0; ai < 2; ++ai)
#pragma unroll
            for (int m = 0; m < 4; ++m) { bf16* rowp = O + (size_t)(row0 + ai * 128 + m * 16) * ldc + col0;
#pragma unroll
                for (int bj = 0; bj < 2; ++bj) *(u32x4*)(rowp + bj * 128) = pack8(acc[ai][bj][m][0], acc[ai][bj][m][1]); }
    } };
struct EpiQ { static constexpr bool PERM = true, AFTER_DRAIN = false; bf16* Q; const float* ROPE;
    __device__ __forceinline__ void operator()(EPI_ARGS) const {
        const int row0 = u.pm * 256 + wr * 64 + fr, colb = u.pn * 256 + wc * 32 + 8 * fq;
        const int hc0 = colb % 96, hc1 = (colb + 128) % 96; const bool rp0 = hc0 >= 64, rp1 = hc1 >= 64; const int po0 = rp0 ? (hc0 - 64) : 0, po1 = rp1 ? (hc1 - 64) : 0;
        int qoff = row0 * 1536 + colb, roff = (row0 & 2047) * 32;
#pragma unroll
        for (int ai = 0; ai < 2; ++ai) {
#pragma unroll
            for (int m = 0; m < 4; ++m) { const float* rtr = ROPE + roff; bf16* qrow = Q + qoff;
#pragma unroll
                for (int bj = 0; bj < 2; ++bj) { A4 a = acc[ai][bj][m][0], b = acc[ai][bj][m][1];
                    if (bj == 0 ? rp0 : rp1) { const float* rt = rtr + (bj == 0 ? po0 : po1); const A4 r0 = *(const A4*)rt, r1 = *(const A4*)(rt + 4);
                        A4 a2, b2; a2[0] = a[0] * r0[0] - a[1] * r0[1]; a2[1] = a[0] * r0[1] + a[1] * r0[0]; a2[2] = a[2] * r0[2] - a[3] * r0[3]; a2[3] = a[2] * r0[3] + a[3] * r0[2];
                        b2[0] = b[0] * r1[0] - b[1] * r1[1]; b2[1] = b[0] * r1[1] + b[1] * r1[0]; b2[2] = b[2] * r1[2] - b[3] * r1[3]; b2[3] = b[2] * r1[3] + b[3] * r1[2]; a = a2; b = b2; }
                    *(u32x4*)(qrow + bj * 128) = pack8(a, b); }
                qoff += 16 * 1536; roff += 16 * 32; asm volatile("" : "+v"(qoff), "+v"(roff) :: "memory"); }
            qoff += 64 * 1536; roff += 64 * 32; }
    } };
struct EpiKV { static constexpr bool PERM = true, AFTER_DRAIN = false; bf16* KN; bf16* V;
    __device__ __forceinline__ void operator()(EPI_ARGS) const {
        const int t0 = u.pm * 256; int b, key0; if (t0 < TL) { b = t0 >> 11; key0 = 256 + (t0 & 2047); } else { b = (t0 - TL) >> 8; key0 = 0; }
        bf16* ub = (wc < 2 ? KN : V) + ((size_t)(b * 16 + u.pn * 2) * 2304 + key0 + wr * 64) * 64 + (wc & 1) * 32;
        const unsigned voff = (unsigned)(fr * 64 + 8 * fq) * 2u;
#pragma unroll
        for (int ai = 0; ai < 2; ++ai)
#pragma unroll
            for (int m = 0; m < 4; ++m)
#pragma unroll
                for (int bj = 0; bj < 2; ++bj) *(u32x4*)((char*)(ub + (size_t)bj * 2304 * 64 + (ai * 128 + m * 16) * 64) + voff) = pack8(acc[ai][bj][m][0], acc[ai][bj][m][1]);
    } };
struct SchedG1 { int vcu, G;
    __device__ __forceinline__ bool next(int i, Unit& u) const { const int j = i * G + vcu; if (j >= 1152) return false; const int tt = j >> 3, sub = j & 7; if (sub < 4) { u.pm = tt; u.pn = 148 + sub; } else { u.pm = 144 + (sub - 4); u.pn = tt; } return true; }
    __device__ __forceinline__ void a_ready(const Unit&) const {} __device__ __forceinline__ void done(const Unit&) const {} };
struct SchedMN { int vcu, G, nM, nN, pm0, pn0;
    __device__ __forceinline__ bool next(int i, Unit& u) const { const int j = i * G + vcu; if (j >= nM * nN) return false; u.pm = pm0 + j / nN; u.pn = pn0 + j % nN; return true; }
    __device__ __forceinline__ void a_ready(const Unit&) const {} __device__ __forceinline__ void done(const Unit&) const {} };
struct SchedNM { int vcu, G, nM, nN;
    __device__ __forceinline__ bool next(int i, Unit& u) const { const int j = i * G + vcu; if (j >= nM * nN) return false; u.pm = j % nM; u.pn = j / nM; return true; }
    __device__ __forceinline__ void a_ready(const Unit&) const {} __device__ __forceinline__ void done(const Unit&) const {} };
struct SchedExp { int vcu, G, nMt, nNt;
    __device__ __forceinline__ bool next(int i, Unit& u) const { const int j = i * G + vcu, per = nMt * nNt; if (j >= 16 * per) return false; const int e = j / per, r = j % per; u.pm = e * 18 + r / nNt; u.pn = e * nNt + r % nNt; return true; }
    __device__ __forceinline__ void a_ready(const Unit&) const {} __device__ __forceinline__ void done(const Unit&) const {} };
}

namespace att {
using bf16x8 = __attribute__((ext_vector_type(8))) short;
using s16x4 = __attribute__((ext_vector_type(4))) short;
using f32x16 = __attribute__((ext_vector_type(16))) float;
using u32x4 = __attribute__((ext_vector_type(4))) unsigned;
typedef unsigned short bf16;
constexpr int NW = 8, QBLK = 32, KVBLK = 64, SKV = 2304, NT = SKV / KVBLK, LDQ = 1536, LDO = 1024;
constexpr float SCALE = 0.10206207261596577f, THR = 8.f;
constexpr int SHM_V = 16384, SHM_K = 16384, SHM_ATTN = 2 * SHM_V + 2 * SHM_K + NW * 64 * 4;
#define KSWZ(row, colB) ((row) * 256 + ((colB) ^ (((row) & 7) << 4)))
#define SBAR() __builtin_amdgcn_sched_barrier(0)
__device__ __forceinline__ int crow(int r, int hi) { return (r & 3) + 8 * (r >> 2) + 4 * hi; }
__device__ __forceinline__ unsigned cvtpk(float lo, float hi) { unsigned r; asm volatile("v_cvt_pk_bf16_f32 %0, %1, %2" : "=v"(r) : "v"(lo), "v"(hi)); return r; }
__device__ __forceinline__ void partialSM(f32x16& p0, f32x16& p1, float& m_reg, float& mn, float& alpha) {
  constexpr float C = SCALE * 1.4426950408889634f;
  float pmax = p0[0]; for (int r = 1; r < 16; ++r) pmax = fmaxf(pmax, p0[r]); for (int r = 0; r < 16; ++r) pmax = fmaxf(pmax, p1[r]);
  { auto rr = __builtin_amdgcn_permlane32_swap(__float_as_uint(pmax), __float_as_uint(pmax), false, false);
    pmax = fmaxf(__uint_as_float(rr[0]), __uint_as_float(rr[1])); }
  if (__builtin_expect(__all(pmax - m_reg <= THR / SCALE), 1)) { mn = m_reg; alpha = 1.f; }
  else { mn = fmaxf(m_reg, pmax); alpha = __builtin_amdgcn_exp2f((m_reg - mn) * C); m_reg = mn; }
  float mnC = -mn * C;
  for (int r = 0; r < 16; ++r) p0[r] = fmaf(p0[r], C, mnC); for (int r = 0; r < 16; ++r) p1[r] = fmaf(p1[r], C, mnC);
  for (int r = 0; r < 16; ++r) p0[r] = __builtin_amdgcn_exp2f(p0[r]);
}
__device__ __forceinline__ void finishSM(f32x16& p0, f32x16& p1, float alpha, float& l_reg, bf16x8& pa0, bf16x8& pa1, bf16x8& pa2, bf16x8& pa3) {
  for (int r = 0; r < 16; ++r) p1[r] = __builtin_amdgcn_exp2f(p1[r]);
  float ps = 0; for (int r = 0; r < 16; ++r) ps += p0[r]; for (int r = 0; r < 16; ++r) ps += p1[r];
  { auto rr = __builtin_amdgcn_permlane32_swap(__float_as_uint(ps), __float_as_uint(ps), false, false);
    ps = __uint_as_float(rr[0]) + __uint_as_float(rr[1]); }
  l_reg = l_reg * alpha + ps;
#define PK4(P, BASE, OUT) do { unsigned a0 = cvtpk(P[BASE + 0], P[BASE + 1]), a1 = cvtpk(P[BASE + 2], P[BASE + 3]);   \
    unsigned b0 = cvtpk(P[BASE + 4], P[BASE + 5]), b1 = cvtpk(P[BASE + 6], P[BASE + 7]);                              \
    auto r0 = __builtin_amdgcn_permlane32_swap(a0, b0, false, false); auto r1 = __builtin_amdgcn_permlane32_swap(a1, b1, false, false); \
    u32x4 w = {r0[0], r1[0], r0[1], r1[1]}; OUT = *reinterpret_cast<bf16x8*>(&w); } while (0)
  PK4(p0, 0, pa0); PK4(p0, 8, pa1); PK4(p1, 0, pa2); PK4(p1, 8, pa3);
#undef PK4
}
__device__ __forceinline__ void qkt(f32x16& p0, f32x16& p1, const char* Ks, const bf16x8* qr, int r32, int hi) {
  p0 = f32x16{}; p1 = f32x16{};
#pragma unroll
  for (int d0 = 0; d0 < 6; ++d0) { int cb = (d0 * 16 + hi * 8) * 2;
    bf16x8 b0 = *reinterpret_cast<const bf16x8*>(Ks + KSWZ(r32, cb));
    bf16x8 b1 = *reinterpret_cast<const bf16x8*>(Ks + KSWZ(32 + r32, cb));
    p0 = __builtin_amdgcn_mfma_f32_32x32x16_bf16(b0, qr[d0], p0, 0, 0, 0);
    p1 = __builtin_amdgcn_mfma_f32_32x32x16_bf16(b1, qr[d0], p1, 0, 0, 0); }
}
__device__ __forceinline__ int v_st(int k, int c) { const int kk = (k & ~0xC) | ((k & 4) << 1) | ((k & 8) >> 1); return ((kk >> 3) * 4 + (c >> 5)) * 512 + ((kk & 7) * 32 + (c & 31)) * 2; }
__device__ __forceinline__ int v_rd_base(int lane) { return ((lane & 3) << 3) | (((lane >> 2) & 3) << 6) | (((lane >> 4) & 1) << 5) | (((lane >> 5) & 1) << 8); }
constexpr int v_rd_off(int d0, int ks, int half) { return d0 * 512 + ks * 4096 + half * 2048; }
template <int OFF> __device__ __forceinline__ s16x4 tr_read(int vb) {
  s16x4 r; asm volatile("ds_read_b64_tr_b16 %0, %1 offset:%2" : "=&v"(r) : "v"(vb), "i"(OFF) : "memory"); return r;
}
template <int D0> __device__ __forceinline__ void pv_one(f32x16& od, int vb, bf16x8 pa0, bf16x8 pa1, bf16x8 pa2, bf16x8 pa3) {
  const s16x4 l0 = tr_read<v_rd_off(D0, 0, 0)>(vb), h0 = tr_read<v_rd_off(D0, 0, 1)>(vb), l1 = tr_read<v_rd_off(D0, 1, 0)>(vb), h1 = tr_read<v_rd_off(D0, 1, 1)>(vb);
  const s16x4 l2 = tr_read<v_rd_off(D0, 2, 0)>(vb), h2 = tr_read<v_rd_off(D0, 2, 1)>(vb), l3 = tr_read<v_rd_off(D0, 3, 0)>(vb), h3 = tr_read<v_rd_off(D0, 3, 1)>(vb);
  asm volatile("s_waitcnt lgkmcnt(0)" ::: "memory"); SBAR();
#define PK(L, H) (bf16x8){L[0], L[1], L[2], L[3], H[0], H[1], H[2], H[3]}
  od = __builtin_amdgcn_mfma_f32_32x32x16_bf16(pa0, PK(l0, h0), od, 0, 0, 0);
  od = __builtin_amdgcn_mfma_f32_32x32x16_bf16(pa1, PK(l1, h1), od, 0, 0, 0);
  od = __builtin_amdgcn_mfma_f32_32x32x16_bf16(pa2, PK(l2, h2), od, 0, 0, 0);
  od = __builtin_amdgcn_mfma_f32_32x32x16_bf16(pa3, PK(l3, h3), od, 0, 0, 0);
#undef PK
}
__device__ __forceinline__ void pv_d0(f32x16* o, int vb, bf16x8 pa0, bf16x8 pa1, bf16x8 pa2, bf16x8 pa3) {
  pv_one<0>(o[0], vb, pa0, pa1, pa2, pa3); pv_one<1>(o[1], vb, pa0, pa1, pa2, pa3);
}
__device__ __forceinline__ void attn_unit(const bf16* __restrict__ Qb, const bf16* __restrict__ KNh, const bf16* __restrict__ KRb, const bf16* __restrict__ Vh, bf16* __restrict__ Ob, char* lds) {
  int tid_ = threadIdx.x; asm volatile("" : "+v"(tid_));
  const int tid = tid_, wid = __builtin_amdgcn_readfirstlane(tid >> 6), lane = tid & 63, r32 = lane & 31, hi = lane >> 5;
  char* V_lds = lds; char* K_lds = lds + 2 * SHM_V;
  float* ws = (float*)(lds + 2 * SHM_V + 2 * SHM_K) + wid * 64; float* li_l = ws; float* al_l = ws + 32;
  float m_reg = -1e30f, l_reg = 0; f32x16 o[2] = {}; bf16x8 qr[6];
  const bf16* Qw = Qb + (long)(wid * QBLK + r32) * LDQ + hi * 8;
#pragma unroll
  for (int d0 = 0; d0 < 6; ++d0) qr[d0] = *reinterpret_cast<const bf16x8*>(Qw + d0 * 16);
  const bool kact = wid < 6;
  const int krow = tid / 12, kch = tid - krow * 12;
  const bf16* ksrc = kch < 8 ? KNh + kch * 8 : KRb + (kch - 8) * 8; const int kstr = kch < 8 ? 64 : 32;
  const int kdst0 = KSWZ(krow, kch * 16), kdst1 = KSWZ(32 + krow, kch * 16);
  const int vrow = tid >> 3, vcol = (tid & 7) * 8, vdst = v_st(vrow, vcol);
  const int vb0 = (int)(uintptr_t)V_lds + v_rd_base(lane);
  bf16x8 ksA0 = {}, ksA1 = {}, vsA, ksB0 = {}, ksB1 = {}, vsB;
#define SLOAD(S, k0) do { if (kact) { ks##S##0 = *reinterpret_cast<const bf16x8*>(ksrc + (long)((k0) + krow) * kstr); ks##S##1 = *reinterpret_cast<const bf16x8*>(ksrc + (long)((k0) + 32 + krow) * kstr); } \
    vs##S = *reinterpret_cast<const bf16x8*>(Vh + (long)((k0) + vrow) * 64 + vcol); } while (0)
#define SWRITE(b, S) do { if (kact) { *(bf16x8*)(K_lds + (b) * SHM_K + kdst0) = ks##S##0; *(bf16x8*)(K_lds + (b) * SHM_K + kdst1) = ks##S##1; } \
    *(bf16x8*)(V_lds + (b) * SHM_V + vdst) = vs##S; } while (0)
#define RESC(a) do { if (__any((a) < 1.f)) { if (hi == 0) al_l[r32] = (a); asm volatile("s_waitcnt lgkmcnt(0)" ::: "memory"); \
    for (int d = 0; d < 2; ++d) for (int r = 0; r < 16; ++r) o[d][r] *= al_l[crow(r, hi)]; } } while (0)
  f32x16 pA0, pA1, pB0, pB1; float mnA, mnB, alA, alB; bf16x8 pa0, pa1, pa2, pa3;
  SLOAD(A, 0); SWRITE(0, A); __syncthreads();
  qkt(pA0, pA1, K_lds, qr, r32, hi); partialSM(pA0, pA1, m_reg, mnA, alA);
  SLOAD(B, KVBLK); SLOAD(A, 2 * KVBLK);
  SWRITE(1, B); __syncthreads();
  for (int j = 1; j + 1 < NT; j += 2) {
    SBAR(); qkt(pB0, pB1, K_lds + SHM_K, qr, r32, hi);
    finishSM(pA0, pA1, alA, l_reg, pa0, pa1, pa2, pa3); SBAR();
    SLOAD(B, (j + 2) * KVBLK); SBAR();
    pv_d0(o, vb0, pa0, pa1, pa2, pa3); partialSM(pB0, pB1, m_reg, mnB, alB);
    __syncthreads(); SWRITE(0, A);
    RESC(alB); __syncthreads();
    SBAR(); qkt(pA0, pA1, K_lds, qr, r32, hi);
    finishSM(pB0, pB1, alB, l_reg, pa0, pa1, pa2, pa3); SBAR();
    if (j + 3 < NT) SLOAD(A, (j + 3) * KVBLK); SBAR();
    pv_d0(o, vb0 + SHM_V, pa0, pa1, pa2, pa3); partialSM(pA0, pA1, m_reg, mnA, alA);
    __syncthreads(); SWRITE(1, B);
    RESC(alA); __syncthreads();
  }
  SBAR(); qkt(pB0, pB1, K_lds + SHM_K, qr, r32, hi);
  finishSM(pA0, pA1, alA, l_reg, pa0, pa1, pa2, pa3); SBAR();
  pv_d0(o, vb0, pa0, pa1, pa2, pa3); partialSM(pB0, pB1, m_reg, mnB, alB);
  __syncthreads(); RESC(alB);
  finishSM(pB0, pB1, alB, l_reg, pa0, pa1, pa2, pa3); SBAR();
  pv_d0(o, vb0 + SHM_V, pa0, pa1, pa2, pa3);
  if (hi == 0) li_l[r32] = l_reg; asm volatile("s_waitcnt lgkmcnt(0)" ::: "memory");
  float rli[16];
#pragma unroll
  for (int r = 0; r < 16; ++r) rli[r] = __builtin_amdgcn_rcpf(li_l[crow(r, hi)]);
  bf16* Ow = Ob + (long)(wid * QBLK) * LDO;
#pragma unroll
  for (int r = 0; r < 16; ++r) { const int orow = crow(r, hi);
#pragma unroll
    for (int d0 = 0; d0 < 2; ++d0) Ow[(long)orow * LDO + d0 * 32 + r32] = (bf16)f2bf(o[d0][r] * rli[r]); }
  __syncthreads();
#undef SLOAD
#undef SWRITE
#undef RESC
}
#undef KSWZ
#undef SBAR
}
#ifndef HYB_CUT
#define HYB_CUT 5
#endif
#define FP_PH_HI (HYB_CUT == 1 ? 5 : HYB_CUT == 2 ? 10 : HYB_CUT == 3 ? 15 : 20)
namespace fp {
constexpr int N_PHASES = 20;
struct Args { const float* in[25]; float* out; unsigned char* ws; };
#ifndef FP_SP2
#define FP_SP2 true
#endif
#ifndef FP_ALIGN
#define FP_ALIGN true
#endif
template <bool SP2 = FP_SP2, class Epi, class Sched>
__device__ __forceinline__ void run_gemm(Ctx& F, const bf16* A, const bf16* Bt, int K, const Sched& S, const Epi& E) {
    pg8::Gemm g{A, Bt, 0, 0, K};
    pg8::gemm_phase<Epi, Sched, FP_ALIGN, SP2>(F.lds, g, S, E, F.tid);
}
__global__ void __launch_bounds__(NTHR, 2) fwd_kernel(Args args) {
    extern __shared__ __attribute__((aligned(16))) unsigned char lds[];
    Ctx F;
    F.out = args.out; F.ws = args.ws; F.lds = (LAS unsigned char*)lds;
    F.tid = threadIdx.x; F.lane = F.tid & 63; F.wave = __builtin_amdgcn_readfirstlane(F.tid >> 6);
    F.G = gridDim.x; { const int bx = blockIdx.x; F.vcu = (F.G % 8 == 0) ? (bx % 8) * (F.G / 8) + bx / 8 : bx; }
    const int vcu0 = F.vcu;
    F.gw = F.vcu * NWAVES + F.wave; F.NGW = F.G * NWAVES;
    volatile LAS unsigned* MISC = (volatile LAS unsigned*)(F.lds + MISC_OFF);
    for (int u = F.tid; u < (LDS_BYTES - LDSCTL_OFF) / 4; u += NTHR) ((LAS unsigned*)(F.lds + LDSCTL_OFF))[u] = 0u;
    __syncthreads();
    if (F.tid < 25) { const unsigned long long pv = (unsigned long long)args.in[F.tid]; LAS unsigned* pp = (LAS unsigned*)(F.lds + PTR_OFF) + 2 * F.tid; pp[0] = (unsigned)pv; pp[1] = (unsigned)(pv >> 32); }
    __syncthreads();
    gu32* ctl = (gu32*)(F.ws + WS_CTL);
    constexpr int lo = 0, hi = FP_PH_HI;
    (void)xcd_barrier_post((unsigned*)(ctl + CW_BAR), MISC + 8);
#ifndef FP_ONLY
#define FP_ONLY -1
#endif
#ifndef FP_MIN
#define FP_MIN 0
#endif
#ifndef FP_MAX
#define FP_MAX 99
#endif
#ifndef FP_SKIP
#define FP_SKIP -1
#endif
#ifndef FP_SKIP2
#define FP_SKIP2 -1
#endif
#define IN(k) ((k) != FP_SKIP && (k) != FP_SKIP2 && (FP_ONLY < 0 || FP_ONLY == (k)) && (k) >= FP_MIN && (k) <= FP_MAX && lo <= (k) && (k) < hi)
#define SEAM(k) do { if (IN((k) + 1)) { XcdBarrier bar_; bar_.bar = (unsigned*)(F.ws + WS_CTL) + CW_BAR; bar_.x = xb_xcc_id(); bar_.st = (volatile LAS unsigned*)(F.lds + MISC_OFF) + 8; xcd_barrier(bar_); } LAUNDER(); } while (0)
#define LAUNDER() do { int t_ = threadIdx.x; asm volatile("" : "+v"(t_)); F.tid = t_; F.lane = t_ & 63; F.wave = __builtin_amdgcn_readfirstlane(t_ >> 6); \
        unsigned char* w_ = args.ws; asm volatile("" : "+s"(w_)); F.ws = w_; float* o_ = args.out; asm volatile("" : "+s"(o_)); F.out = o_; \
        int v_ = vcu0; asm volatile("" : "+s"(v_)); F.vcu = v_; F.gw = v_ * NWAVES + F.wave; } while (0)
    const float* MODS = WSP(float, WS_MODS);

    if (IN(0)) { p0_prologue(F); SEAM(0); }
    if (IN(1)) { p1_norm(F); SEAM(1); }
    if (IN(2)) {
        run_gemm(F, WSP(bf16, WS_UW), WSP(bf16, WS_UW), 1024, SchedG1{F.vcu, F.G}, EpiG1{WSP(bf16, WS_AG), WSP(bf16, WS_YT), WSP(bf16, WS_YTC)});
        SEAM(2); }
    if (IN(3)) {
        p3_conv(F);
        run_gemm(F, WSP(bf16, WS_CS), WSP(bf16, WS_YT), 4096, SchedNM{F.vcu, F.G, 8, 32}, EpiF{WSP(bf16, WS_R2), 2048, 0});
        run_gemm(F, WSP(bf16, WS_CSC), WSP(bf16, WS_YTC), 512, SchedNM{F.vcu, F.G, 1, 32}, EpiF{WSP(bf16, WS_R2), 256, TL});
        SEAM(3); }
    if (IN(4)) {
        run_gemm(F, WSP(bf16, WS_R2), WSP(bf16, WS_WOUT), 1024, SchedMN{F.vcu, F.G, 144, 4, 0, 0}, EpiRes{F.in(0), F.in(2), F.out, WSP(float, WS_XC), MODS + 2 * 1024});
        SEAM(4); }
#define MOE_BLOCK(ly, pb) do { \
        if (IN(pb)) { m1_route(F, ly, ly == 0 ? T : TL); SEAM(pb); } \
        if (IN(pb + 1)) { const int nu = ly == 0 ? 512 : 256; for (int u = F.vcu; u < nu; u += F.G) m2_unit(F, u); SEAM(pb + 1); } \
        if (IN(pb + 2)) { run_gemm(F, WSP(bf16, WS_R1), WSP(bf16, WS_W13), 1024, SchedExp{F.vcu, F.G, ly == 0 ? 18 : 16, 8}, EpiSwiglu{WSP(bf16, WS_R2)}); SEAM(pb + 2); } \
        if (IN(pb + 3)) { run_gemm(F, WSP(bf16, WS_R2), WSP(bf16, WS_W2), 1024, SchedExp{F.vcu, F.G, ly == 0 ? 18 : 16, 4}, EpiGate{WSP(bf16, WS_R1), WSP(float, WS_GATE)}); SEAM(pb + 3); } } while (0)
    MOE_BLOCK(0, 5);
        if (IN(9)) { a0_combine(F); SEAM(9); }
        if (IN(10)) { run_gemm(F, WSP(bf16, WS_UW), WSP(bf16, WS_WMLA), 1024, SchedMN{F.vcu, F.G, 144, 2, 0, 0}, EpiPlain{WSP(bf16, WS_CQKV), 512}); SEAM(10); }
        if (IN(11)) { a1_lowrank(F); SEAM(11); }
        if (IN(12)) {
            run_gemm<false>(F, WSP(bf16, WS_CQN), WSP(bf16, WS_WUQ), 256, SchedMN{F.vcu, F.G, 128, 6, 0, 0}, EpiQ{WSP(bf16, WS_Q), WSP(float, WS_ROPE)});
            run_gemm<false>(F, WSP(bf16, WS_CKVN), WSP(bf16, WS_WUKV), 256, SchedMN{F.vcu, F.G, 144, 8, 0, 0}, EpiKV{WSP(bf16, WS_KN), WSP(bf16, WS_V)});
            SEAM(12); }
        if (IN(13)) {
            for (int bh = F.vcu; bh < 256; bh += F.G) { const int b = bh >> 4, h = bh & 15;
                const bf16* KNh = WSP(bf16, WS_KN) + (size_t)bh * 2304 * 64; const bf16* Vh = WSP(bf16, WS_V) + (size_t)bh * 2304 * 64; const bf16* KRb = WSP(bf16, WS_KR) + (size_t)b * 2304 * 32;
#pragma unroll 1
                for (int qb = 0; qb < 8; ++qb) { const size_t row0 = (size_t)b * 2048 + qb * 256;
                    att::attn_unit(WSP(bf16, WS_Q) + row0 * 1536 + h * 96, KNh, KRb, Vh, WSP(bf16, WS_O) + row0 * 1024 + h * 64, (char*)lds); } }
            SEAM(13); }
        if (IN(14)) {
            run_gemm(F, WSP(bf16, WS_O), WSP(bf16, WS_WO), 1024, SchedMN{F.vcu, F.G, 128, 4, 0, 0}, EpiRes{F.out, WSP(float, WS_XC), F.out, WSP(float, WS_XC), MODS + (size_t)17 * 6144 + 2 * 1024});
            SEAM(14); }
    MOE_BLOCK(1, 15);
    if (IN(19)) p_final(F);
#undef IN
#undef SEAM
}
}
#ifdef DIAG
namespace diag {
__global__ void k_cmp(const float* ref, long rsi, long rsj, const void* fast, long fsi, long fsj, int isbf, int ni, int nj, float* stats, int k) {
    float d2 = 0.f, r2 = 0.f;
    for (long idx = (long)blockIdx.x * 256 + threadIdx.x; idx < (long)ni * nj; idx += (long)gridDim.x * 256) { const long i = idx / nj, j = idx % nj;
        const float r = ref[i * rsi + j * rsj]; float f;
        if (isbf) f = __builtin_bit_cast(float, (unsigned)((const unsigned short*)fast)[i * fsi + j * fsj] << 16); else f = ((const float*)fast)[i * fsi + j * fsj];
        const float d = f - r; d2 += d * d; r2 += r * r; }
    for (int o = 32; o > 0; o >>= 1) { d2 += __shfl_xor(d2, o); r2 += __shfl_xor(r2, o); }
    if ((threadIdx.x & 63) == 0) { atomicAdd(&stats[2 * k], d2); atomicAdd(&stats[2 * k + 1], r2); }
}
__global__ void k_encode(const float* stats, int nst, float thr, float* out, long n) {
    int X = -1, minlvl = 9;
    for (int k = 1; k <= nst; ++k) { const float e = sqrtf(stats[2 * k] / fmaxf(stats[2 * k + 1], 1e-30f)); int lvl = (int)floorf(-2.f * log10f(fmaxf(e, 1e-9f))); lvl = lvl < 0 ? 0 : (lvl > 9 ? 9 : lvl);
        if (!(e <= thr) && X < 0) X = 10 * k + lvl; minlvl = lvl < minlvl ? lvl : minlvl; }
    if (X < 0) X = 90 + minlvl;
#ifdef DIAG_STAGE
    { const int k = DIAG_STAGE; const float e = sqrtf(stats[2 * k] / fmaxf(stats[2 * k + 1], 1e-30f)); float l = -20.f * log10f(fmaxf(e, 1e-9f)); X = (int)fminf(fmaxf(l, 10.f), 99.f); }
#endif
    const float c = sqrtf(1002.5f * (float)X);
    for (long i = (long)blockIdx.x * 256 + threadIdx.x; i < n; i += (long)gridDim.x * 256) out[i] = c;
}
#define CMP(k, ref, rsi, rsj, fast, fsi, fsj, isbf, ni, nj) hipLaunchKernelGGL(k_cmp, dim3(512), dim3(256), 0, st, ref, (long)(rsi), (long)(rsj), (const void*)(fast), (long)(fsi), (long)(fsj), isbf, ni, nj, stats, k)
inline void mixer(void* const* d_in, float* d_out, char* ws, char* nbase, hipStream_t st, int bb) {
    using namespace ref; In I = make_in(d_in); Bufs b; carve(b, nbase);
    float* stats = (float*)(nbase - 4096); (void)hipMemsetAsync(stats, 0, 4096, st);
    REF_EW(k_silu, 16 * 1024, I.c, b.SC, 16 * 1024); REF_EW(k_silu, 1024, I.c_ctx, b.SC + 16 * 1024, 1024);
    for (int ly = 0; ly < 2; ++ly) gemm(st, b.SC, D, I.mod_w + (size_t)ly * D * 6144, 6144, b.MODS + (size_t)ly * 17 * 6144, 6144, 17, 6144, D, I.mod_b + ly * 6144);
    REF_EW(k_mk_cs, L * L, b.CSL, L, 1.f / sqrtf((float)L * 128.f)); REF_EW(k_mk_cc, 128 * 128, b.CC, b.SCm);
    (void)hipMemcpyAsync(b.NX, I.x + (size_t)bb * L * D, (size_t)L * D * 4, hipMemcpyDeviceToDevice, st);
    const float* md = b.MODS + (size_t)bb * 6144; const int Ls = L; const size_t t0 = (size_t)bb * L;
    CMP(7, b.MODS, 6144, 1, ws + fp::WS_MODS, 6144, 1, 0, 34, 6144);
    hipLaunchKernelGGL(k_rms, dim3(Ls), dim3(256), 0, st, b.NX, D, b.NU, D, I.norm1_g, md + 0 * D, md + 1 * D, D);
    CMP(1, b.NU, D, 1, (unsigned short*)(ws + fp::WS_UW) + t0 * D, D, 1, 1, Ls, D);
    gemm(st, b.NU, D, I.ab_w_in, 1536, b.NZ, 1536, Ls, 1536, D);
    REF_EW(k_glu, Ls * 512, b.NZ, b.NA, Ls);
    CMP(2, b.NA, 512, 1, (unsigned short*)(ws + fp::WS_AG) + t0 * 512, 512, 1, 1, Ls, 512);
    hipLaunchKernelGGL(k_conv_ln, dim3(Ls), dim3(256), 0, st, b.NA, b.NCAT, I.ab_conv_w, I.ab_conv_b, I.ab_ln_g, I.ab_ln_b, Ls);
    gemm(st, b.NZ + 1024, 1536, b.CC, 128, b.NY, 512, Ls, 128, 128, nullptr, nullptr, 4, 128, 0, 128, 0);
    gemm(st, b.NZ + 1024, 1536, b.SCm, 128, b.NY + (size_t)Ls * 512, 512, Ls, 128, 128, nullptr, nullptr, 4, 128, 0, 128, 0);
    CMP(3, b.NY, 512, 1, (unsigned short*)(ws + fp::WS_YT) + (size_t)bb * 512 * 4096, 1, 4096, 1, 2 * Ls, 512);
    gemm(st, b.CSL, 2 * Ls, b.NY, 512, b.NCAT + 512, 1024, Ls, 512, 2 * Ls);
    CMP(4, b.NCAT, 1024, 1, (unsigned short*)(ws + fp::WS_R2) + t0 * 1024, 1024, 1, 1, Ls, 512);
    CMP(5, b.NCAT + 512, 1024, 1, (unsigned short*)(ws + fp::WS_R2) + t0 * 1024 + 512, 1024, 1, 1, Ls, 512);
    gemm(st, b.NCAT, D, I.ab_w_out, D, b.NT1, D, Ls, D, D);
    REF_EW(k_resid, Ls * 1024, b.NX, b.NT1, md + 2 * D, Ls);
    CMP(6, b.NX, D, 1, d_out + t0 * D, D, 1, 0, Ls, D);
    hipLaunchKernelGGL(k_encode, dim3(1024), dim3(256), 0, st, stats, 7, DIAG_THR, d_out, (long)16 * 2048 * 1024);
}
}
#endif
extern "C" void kernel_launch(void* const* d_in, const int* in_sizes, int n_in, void* d_out, int out_size, void* d_ws, size_t ws_size, hipStream_t stream) {
    static int grid = 0;
    if (grid == 0) {
        ref::Bufs b; const size_t need_ref = 29 * fp::MiB + ref::carve(b, (char*)d_ws);
        size_t need = fp::WS_END; if (HYB_CUT != 5 && need_ref > need) need = need_ref;
#ifdef DIAG
        need = 600 * fp::MiB / 1;
        need = 0;
#endif
        if (n_in != 25 || out_size != 16 * 2048 * 1024 || ws_size < need) { fprintf(stderr, "kernel_launch: unexpected sizes n_in %d out %d ws %zu need %zu\n", n_in, out_size, ws_size, need); grid = -1; return; }
        int dev = 0, cus = 0;
        if (hipGetDevice(&dev) != hipSuccess || hipDeviceGetAttribute(&cus, hipDeviceAttributeMultiprocessorCount, dev) != hipSuccess) { grid = -1; return; }
        if (hipFuncSetAttribute((const void*)fp::fwd_kernel, hipFuncAttributeMaxDynamicSharedMemorySize, fp::LDS_BYTES) != hipSuccess) { fprintf(stderr, "kernel_launch: hipFuncSetAttribute failed\n"); grid = -1; return; }
        if (cus != 256) { fprintf(stderr, "kernel_launch: built for 256 CUs, device has %d\n", cus); grid = -1; return; }
        grid = cus;
    }
    if (grid < 0) return;
    if (hipMemsetAsync((char*)d_ws + fp::WS_CTL, 0, fp::CTL_ZERO_BYTES, stream) != hipSuccess) return;
    fp::Args a{};
    for (int i = 0; i < 25; ++i) a.in[i] = (const float*)d_in[i];
    a.out = (float*)d_out; a.ws = (unsigned char*)d_ws;
    hipLaunchKernelGGL(fp::fwd_kernel, dim3(grid), dim3(fp::NTHR), fp::LDS_BYTES, stream, a);
#ifdef DIAG
    diag::mixer(d_in, (float*)d_out, (char*)d_ws, (char*)d_ws + 346 * fp::MiB, stream, DIAG_B); return;
#endif
    if (HYB_CUT != 5) ref::run(d_in, (float*)d_out, (char*)d_ws + 29 * fp::MiB, stream, 0, 16, HYB_CUT, (const float*)d_out, (const float*)((char*)d_ws + fp::WS_XC));
}
```

```cpp
#define HYB_CUT 5
#include <hip/hip_runtime.h>
#include <cstdio>
#include <cstdint>
#include <cmath>
namespace ref {
constexpr int D = 1024, NB = 16, L = 2048, LC = 256, S = L + LC;
constexpr int H = 16, QKH = 96, FF = 1024, NE = 16;
constexpr float EPS = 1e-6f;

struct GemmP { const float* A; const float* Bm; float* C; const float* bias; const int* gidx;
               int M, N, K, lda, ldb, ldc; long sA, sB, sC; int sG; int pad; };
__global__ void __launch_bounds__(256) k_gemm(GemmP g) {
    __shared__ float As[16][68]; __shared__ float Bs[16][64];
    const int z = blockIdx.z; const float* A = g.A + z * g.sA; const float* Bm = g.Bm + z * g.sB; float* C = g.C + z * g.sC;
    const int* gi = g.gidx ? g.gidx + z * g.sG : nullptr;
    const int m0 = blockIdx.y * 64, n0 = blockIdx.x * 64, tid = threadIdx.x, tx = tid & 15, ty = tid >> 4;
    float acc[4][4];
#pragma unroll
    for (int i = 0; i < 4; ++i)
#pragma unroll
        for (int j = 0; j < 4; ++j) acc[i][j] = 0.f;
    const int ar = tid >> 2, ak = (tid & 3) * 4; const int arow = m0 + ar; const bool aok = arow < g.M;
    const long aoff = aok ? (long)(gi ? gi[arow] : arow) * g.lda : 0;
    const int bk = tid >> 4, bn = (tid & 15) * 4; const bool bok = (n0 + bn) < g.N;
    for (int k0 = 0; k0 < g.K; k0 += 16) {
        float4 av = aok ? *(const float4*)(A + aoff + k0 + ak) : make_float4(0.f, 0.f, 0.f, 0.f);
        float4 bv = bok ? *(const float4*)(Bm + (long)(k0 + bk) * g.ldb + n0 + bn) : make_float4(0.f, 0.f, 0.f, 0.f);
        As[ak][ar] = av.x; As[ak + 1][ar] = av.y; As[ak + 2][ar] = av.z; As[ak + 3][ar] = av.w;
        *(float4*)&Bs[bk][bn] = bv;
        __syncthreads();
#pragma unroll
        for (int k = 0; k < 16; ++k) {
            const float4 a4 = *(const float4*)&As[k][ty * 4]; const float4 b4 = *(const float4*)&Bs[k][tx * 4];
            acc[0][0] += a4.x * b4.x; acc[0][1] += a4.x * b4.y; acc[0][2] += a4.x * b4.z; acc[0][3] += a4.x * b4.w;
            acc[1][0] += a4.y * b4.x; acc[1][1] += a4.y * b4.y; acc[1][2] += a4.y * b4.z; acc[1][3] += a4.y * b4.w;
            acc[2][0] += a4.z * b4.x; acc[2][1] += a4.z * b4.y; acc[2][2] += a4.z * b4.z; acc[2][3] += a4.z * b4.w;
            acc[3][0] += a4.w * b4.x; acc[3][1] += a4.w * b4.y; acc[3][2] += a4.w * b4.z; acc[3][3] += a4.w * b4.w;
        }
        __syncthreads();
    }
#pragma unroll
    for (int i = 0; i < 4; ++i) { const int row = m0 + ty * 4 + i; if (row < g.M) {
#pragma unroll
        for (int j = 0; j < 4; ++j) { const int col = n0 + tx * 4 + j; if (col < g.N) C[(long)row * g.ldc + col] = acc[i][j] + (g.bias ? g.bias[col] : 0.f); } } }
}
__device__ __forceinline__ float siluf(float v) { return v / (1.f + __expf(-v)); }
__device__ __forceinline__ float block_sum256(float v, float* red) {
#pragma unroll
    for (int o = 32; o > 0; o >>= 1) v += __shfl_xor(v, o);
    __syncthreads();
    if ((threadIdx.x & 63) == 0) red[threadIdx.x >> 6] = v;
    __syncthreads();
    return red[0] + red[1] + red[2] + red[3];
}
__global__ void k_silu(const float* in, float* out, int n) { int i = blockIdx.x * 256 + threadIdx.x; if (i < n) out[i] = siluf(in[i]); }
__global__ void __launch_bounds__(256) k_rms(const float* in, int is, float* out, int os, const float* g, const float* sh, const float* sc, int W) {
    __shared__ float red[4];
    const float* x = in + (long)blockIdx.x * is; float* o = out + (long)blockIdx.x * os;
    float s = 0.f; for (int i = threadIdx.x; i < W; i += 256) { float v = x[i]; s += v * v; }
    s = block_sum256(s, red);
    const float r = rsqrtf(s / (float)W + EPS);
    for (int i = threadIdx.x; i < W; i += 256) { float v = x[i] * r * g[i]; if (sc) v = v * (1.f + sc[i]) + sh[i]; o[i] = v; }
}
__global__ void k_glu(const float* z, float* a, int rows) { int i = blockIdx.x * 256 + threadIdx.x; if (i < rows * 512) { int t = i >> 9, c = i & 511; float v = z[(long)t * 1536 + c], gt = z[(long)t * 1536 + 512 + c]; a[i] = v / (1.f + __expf(-gt)); } }
__global__ void __launch_bounds__(256) k_conv_ln(const float* a, float* cat, const float* cw, const float* cb, const float* lg, const float* lb, int Ls) {
    __shared__ float red[4];
    const int t = blockIdx.x; float v[2];
#pragma unroll
    for (int q = 0; q < 2; ++q) { const int c = threadIdx.x + 256 * q; float s = cb[c];
        for (int j = 0; j < 31; ++j) { const int l = t + j - 15; if (l >= 0 && l < Ls) s += a[(long)l * 512 + c] * cw[j * 512 + c]; }
        v[q] = s; }
    const float mu = block_sum256(v[0] + v[1], red) * (1.f / 512.f);
    const float d0 = v[0] - mu, d1 = v[1] - mu;
    const float var = block_sum256(d0 * d0 + d1 * d1, red) * (1.f / 512.f);
    const float r = rsqrtf(var + EPS);
#pragma unroll
    for (int q = 0; q < 2; ++q) { const int c = threadIdx.x + 256 * q; const float y = (q == 0 ? d0 : d1) * r * lg[c] + lb[c]; cat[(long)t * 1024 + c] = siluf(y); }
}
__global__ void k_resid(float* x, const float* y, const float* gate, int rows) { int i = blockIdx.x * 256 + threadIdx.x; if (i < rows * 1024) x[i] += gate[i & 1023] * y[i]; }
__global__ void k_softmax16(const float* lg, float* aff, int rows) { int t = blockIdx.x * 256 + threadIdx.x; if (t < rows) { float m = -1e30f; for (int e = 0; e < 16; ++e) m = fmaxf(m, lg[t * 16 + e]); float s = 0.f; float p[16];
#pragma unroll
        for (int e = 0; e < 16; ++e) { p[e] = __expf(lg[t * 16 + e] - m); s += p[e]; }
#pragma unroll
        for (int e = 0; e < 16; ++e) aff[t * 16 + e] = p[e] / s; } }
__global__ void __launch_bounds__(256) k_topk(const float* aff, int Ls, int cap, int* idx, float* gate) {
    __shared__ float a[2048];
    const int e = blockIdx.x;
    for (int t = threadIdx.x; t < Ls; t += 256) a[t] = aff[t * 16 + e];
    __syncthreads();
    for (int t = threadIdx.x; t < Ls; t += 256) { const float v = a[t]; int rank = 0;
        for (int j = 0; j < Ls; ++j) { const float w = a[j]; rank += (w > v || (w == v && j < t)) ? 1 : 0; }
        if (rank < cap) { idx[e * 256 + rank] = t; gate[e * 256 + rank] = v; } }
}
__global__ void k_swiglu(float* h1, const float* h3, int cap) { int i = blockIdx.x * 256 + threadIdx.x; if (i < 16 * cap * 1024) { int e = i / (cap * 1024), r = i % (cap * 1024); long o = (long)e * 256 * 1024 + r; h1[o] = siluf(h1[o]) * h3[o]; } }
__global__ void k_scatter(float* x, const float* out, const int* idx, const float* gate, const float* g2, int cap) { int i = blockIdx.x * 256 + threadIdx.x; if (i < 16 * cap * 1024) { int e = i / (cap * 1024), r = i % (cap * 1024), s = r >> 10, n = r & 1023;
        atomicAdd(&x[(long)idx[e * 256 + s] * 1024 + n], g2[n] * gate[e * 256 + s] * out[(long)e * 256 * 1024 + r]); } }
__global__ void k_mk_cs(float* cs, int Ls, float scale) { long i = (long)blockIdx.x * 256 + threadIdx.x; if (i < (long)Ls * Ls) { int k = (int)(i / Ls), l = (int)(i % Ls); int ph = (int)(((long)k * l) % Ls); float s, c; sincospif(2.f * (float)ph / (float)Ls, &s, &c); cs[(long)k * 2 * Ls + l] = c * scale; cs[(long)k * 2 * Ls + Ls + l] = -s * scale; } }
__global__ void k_mk_cc(float* cc, float* sc) { int i = blockIdx.x * 256 + threadIdx.x; if (i < 128 * 128) { int c = i >> 7, m = i & 127; int ph = (c * m) & 127; float s, co; sincospif(2.f * (float)ph / 128.f, &s, &co); cc[i] = co; sc[i] = s; } }
__global__ void k_rope(float* m, int ld, int col0, int hs, int nh, int Ls) { int i = blockIdx.x * 256 + threadIdx.x; if (i < Ls * nh * 16) { int p = i & 15, h = (i >> 4) % nh, t = i / (16 * nh);
        const float pos = (p < 8) ? (float)(t >> 6) : (float)(t & 63); const float inv = __powf(10000.f, -(float)(p & 7) / 8.f); float s, c; sincosf(pos * inv, &s, &c);
        float* q = m + (long)t * ld + col0 + h * hs + 2 * p; const float xe = q[0], xo = q[1]; q[0] = xe * c - xo * s; q[1] = xe * s + xo * c; } }
__global__ void __launch_bounds__(64) k_attn(const float* Q, const float* KV, const float* KR, float* O) {
    const int h = blockIdx.y, q = blockIdx.x * 64 + threadIdx.x;
    float qv[96], o[64];
#pragma unroll
    for (int d = 0; d < 96; ++d) qv[d] = Q[(long)q * 1536 + h * 96 + d] * 0.10206207261596577f;
#pragma unroll
    for (int d = 0; d < 64; ++d) o[d] = 0.f;
    float m = -1e30f, l = 0.f;
    for (int j = 0; j < S; ++j) {
        const float* kn = KV + (long)j * 2048 + h * 128; const float* kr = KR + (long)j * 32; const float* vv = kn + 64;
        float s = 0.f;
#pragma unroll
        for (int d = 0; d < 64; ++d) s += qv[d] * kn[d];
#pragma unroll
        for (int d = 0; d < 32; ++d) s += qv[64 + d] * kr[d];
        const float mn = fmaxf(m, s), al = __expf(m - mn), p = __expf(s - mn);
        l = l * al + p; m = mn;
#pragma unroll
        for (int d = 0; d < 64; ++d) o[d] = o[d] * al + p * vv[d];
    }
    const float il = 1.f / l;
#pragma unroll
    for (int d = 0; d < 64; ++d) O[(long)q * 1024 + h * 64 + d] = o[d] * il;
}
__global__ void k_copy_cols(const float* in, int is, float* out, int os, int rows, int cols) { int i = blockIdx.x * 256 + threadIdx.x; if (i < rows * cols) { int r = i / cols, c = i % cols; out[(long)r * os + c] = in[(long)r * is + c]; } }

struct Bufs { float *SC, *MODS, *CSL, *CSC, *CC, *SCm, *NX, *NU, *NZ, *NA, *NCAT, *NY, *NT1, *NLOG, *NAFF, *NGATE, *NH1, *NH3, *NCQKV, *NCQN, *NCKVN, *NQ, *NKV, *NKR, *NO; int* NIDX; };
inline size_t carve(Bufs& b, char* base) {
    size_t o = 0; auto take = [&](size_t bytes) { char* p = base + o; o += (bytes + 255) & ~(size_t)255; return p; };
    b.SC = (float*)take(17 * 1024 * 4); b.MODS = (float*)take(2 * 17 * 6144 * 4);
    b.CSL = (float*)take((size_t)L * 2 * L * 4); b.CSC = (float*)take((size_t)LC * 2 * LC * 4); b.CC = (float*)take(128 * 128 * 4); b.SCm = (float*)take(128 * 128 * 4);
    b.NX = (float*)take((size_t)S * D * 4); b.NU = (float*)take((size_t)S * D * 4); b.NZ = (float*)take((size_t)S * 1536 * 4); b.NA = (float*)take((size_t)S * 512 * 4);
    b.NCAT = (float*)take((size_t)S * D * 4); b.NY = (float*)take((size_t)2 * L * 512 * 4); b.NT1 = (float*)take((size_t)S * D * 4);
    b.NLOG = (float*)take((size_t)S * 16 * 4); b.NAFF = (float*)take((size_t)S * 16 * 4); b.NGATE = (float*)take(16 * 256 * 4); b.NIDX = (int*)take(16 * 256 * 4);
    b.NH1 = (float*)take((size_t)16 * 256 * 1024 * 4); b.NH3 = (float*)take((size_t)16 * 256 * 1024 * 4);
    b.NCQKV = (float*)take((size_t)S * 416 * 4); b.NCQN = (float*)take((size_t)S * 256 * 4); b.NCKVN = (float*)take((size_t)S * 128 * 4);
    b.NQ = (float*)take((size_t)L * 1536 * 4); b.NKV = (float*)take((size_t)S * 2048 * 4); b.NKR = (float*)take((size_t)S * 32 * 4); b.NO = (float*)take((size_t)L * D * 4);
    return o;
}
inline void gemm(hipStream_t st, const float* A, int lda, const float* Bm, int ldb, float* C, int ldc, int M, int N, int K, const float* bias = nullptr,
                 const int* gidx = nullptr, int nz = 1, long sA = 0, long sB = 0, long sC = 0, int sG = 0) {
    GemmP g{A, Bm, C, bias, gidx, M, N, K, lda, ldb, ldc, sA, sB, sC, sG, 0};
    hipLaunchKernelGGL(k_gemm, dim3((N + 63) / 64, (M + 63) / 64, nz), dim3(256), 0, st, g);
}
#define REF_EW(kern, n, ...) hipLaunchKernelGGL(kern, dim3(((n) + 255) / 256), dim3(256), 0, st, __VA_ARGS__)
struct In { const float *x, *c, *ctx, *c_ctx, *mod_w, *mod_b, *norm1_g, *norm2_g, *ab_w_in, *ab_conv_w, *ab_conv_b, *ab_ln_g, *ab_ln_b, *ab_w_out, *mla_w_in, *mla_q_norm_g, *mla_kv_norm_g,
                  *mla_w_uq, *mla_w_ukv, *mla_w_o, *moe_w_router, *moe_w1, *moe_w3, *moe_w2, *final_g; };
inline In make_in(void* const* d) { In i; const float** p = (const float**)&i; for (int k = 0; k < 25; ++k) p[k] = (const float*)d[k]; return i; }

inline void moe(hipStream_t st, const In& I, Bufs& b, int ly, int r0, int Ls, int mr) {
    const int cap = 2 * Ls / 16; const float* md = b.MODS + ((size_t)ly * 17 + mr) * 6144;
    hipLaunchKernelGGL(k_rms, dim3(Ls), dim3(256), 0, st, b.NX + (size_t)r0 * D, D, b.NU, D, I.norm2_g + ly * D, md + 3 * D, md + 4 * D, D);
    gemm(st, b.NU, D, I.moe_w_router + (size_t)ly * D * 16, 16, b.NLOG, 16, Ls, 16, D);
    REF_EW(k_softmax16, Ls, b.NLOG, b.NAFF, Ls);
    hipLaunchKernelGGL(k_topk, dim3(16), dim3(256), 0, st, b.NAFF, Ls, cap, b.NIDX, b.NGATE);
    const size_t wl = (size_t)ly * 16 * 1024 * 1024;
    gemm(st, b.NU, D, I.moe_w1 + wl, FF, b.NH1, FF, cap, FF, D, nullptr, b.NIDX, 16, 0, 1024 * 1024, 256 * 1024, 256);
    gemm(st, b.NU, D, I.moe_w3 + wl, FF, b.NH3, FF, cap, FF, D, nullptr, b.NIDX, 16, 0, 1024 * 1024, 256 * 1024, 256);
    REF_EW(k_swiglu, 16 * cap * 1024, b.NH1, b.NH3, cap);
    gemm(st, b.NH1, FF, I.moe_w2 + wl, D, b.NH3, D, cap, D, FF, nullptr, nullptr, 16, 256 * 1024, 1024 * 1024, 256 * 1024, 0);
    REF_EW(k_scatter, 16 * cap * 1024, b.NX + (size_t)r0 * D, b.NH3, b.NIDX, b.NGATE, md + 5 * D, cap);
}
inline void mixer_ab(hipStream_t st, const In& I, Bufs& b, int r0, int Ls, int mr) {
    const float* md = b.MODS + ((size_t)0 * 17 + mr) * 6144; const float* cs = (Ls == L) ? b.CSL : b.CSC;
    hipLaunchKernelGGL(k_rms, dim3(Ls), dim3(256), 0, st, b.NX + (size_t)r0 * D, D, b.NU, D, I.norm1_g, md + 0 * D, md + 1 * D, D);
    gemm(st, b.NU, D, I.ab_w_in, 1536, b.NZ, 1536, Ls, 1536, D);
    REF_EW(k_glu, Ls * 512, b.NZ, b.NA, Ls);
    hipLaunchKernelGGL(k_conv_ln, dim3(Ls), dim3(256), 0, st, b.NA, b.NCAT, I.ab_conv_w, I.ab_conv_b, I.ab_ln_g, I.ab_ln_b, Ls);
    gemm(st, b.NZ + 1024, 1536, b.CC, 128, b.NY, 512, Ls, 128, 128, nullptr, nullptr, 4, 128, 0, 128, 0);
    gemm(st, b.NZ + 1024, 1536, b.SCm, 128, b.NY + (size_t)Ls * 512, 512, Ls, 128, 128, nullptr, nullptr, 4, 128, 0, 128, 0);
    gemm(st, cs, 2 * Ls, b.NY, 512, b.NCAT + 512, 1024, Ls, 512, 2 * Ls);
    gemm(st, b.NCAT, D, I.ab_w_out, D, b.NT1, D, Ls, D, D);
    REF_EW(k_resid, Ls * 1024, b.NX + (size_t)r0 * D, b.NT1, md + 2 * D, Ls);
}
inline void run(void* const* d_in, float* d_out, char* ws, hipStream_t st, int b_lo, int b_hi, int start = 0, const float* xl = nullptr, const float* xc = nullptr) {
    In I = make_in(d_in); Bufs b; carve(b, ws);
    REF_EW(k_silu, 16 * 1024, I.c, b.SC, 16 * 1024); REF_EW(k_silu, 1024, I.c_ctx, b.SC + 16 * 1024, 1024);
    for (int ly = 0; ly < 2; ++ly) gemm(st, b.SC, D, I.mod_w + (size_t)ly * D * 6144, 6144, b.MODS + (size_t)ly * 17 * 6144, 6144, 17, 6144, D, I.mod_b + ly * 6144);
    REF_EW(k_mk_cs, L * L, b.CSL, L, 1.f / sqrtf((float)L * 128.f)); REF_EW(k_mk_cs, LC * LC, b.CSC, LC, 1.f / sqrtf((float)LC * 128.f)); REF_EW(k_mk_cc, 128 * 128, b.CC, b.SCm);
    for (int bb = b_lo; bb < b_hi; ++bb) {
        (void)hipMemcpyAsync(b.NX, (start ? xl : I.x) + (size_t)bb * L * D, (size_t)L * D * 4, hipMemcpyDeviceToDevice, st);
        (void)hipMemcpyAsync(b.NX + (size_t)L * D, (start ? xc : I.ctx) + (size_t)bb * LC * D, (size_t)LC * D * 4, hipMemcpyDeviceToDevice, st);
        if (start <= 0) { mixer_ab(st, I, b, 0, L, bb); mixer_ab(st, I, b, L, LC, 16); }
        if (start <= 1) { moe(st, I, b, 0, 0, L, bb); moe(st, I, b, 0, L, LC, 16); }
        if (start <= 2) {
        const float* md = b.MODS + ((size_t)17 + bb) * 6144; const float* mdc = b.MODS + ((size_t)17 + 16) * 6144;
        hipLaunchKernelGGL(k_rms, dim3(L), dim3(256), 0, st, b.NX, D, b.NU, D, I.norm1_g + D, md, md + D, D);
        hipLaunchKernelGGL(k_rms, dim3(LC), dim3(256), 0, st, b.NX + (size_t)L * D, D, b.NU + (size_t)L * D, D, I.norm1_g + D, mdc, mdc + D, D);
        gemm(st, b.NU, D, I.mla_w_in, 416, b.NCQKV, 416, S, 416, D);
        hipLaunchKernelGGL(k_rms, dim3(S), dim3(256), 0, st, b.NCQKV, 416, b.NCQN, 256, I.mla_q_norm_g, (const float*)nullptr, (const float*)nullptr, 256);
        hipLaunchKernelGGL(k_rms, dim3(S), dim3(256), 0, st, b.NCQKV + 256, 416, b.NCKVN, 128, I.mla_kv_norm_g, (const float*)nullptr, (const float*)nullptr, 128);
        gemm(st, b.NCQN, 256, I.mla_w_uq, 1536, b.NQ, 1536, L, 1536, 256);
        gemm(st, b.NCKVN, 128, I.mla_w_ukv, 2048, b.NKV, 2048, S, 2048, 128);
        REF_EW(k_copy_cols, S * 32, b.NCQKV + 384, 416, b.NKR, 32, S, 32);
        REF_EW(k_rope, L * 16 * 16, b.NQ, 1536, 64, 96, 16, L);
        REF_EW(k_rope, L * 1 * 16, b.NKR, 32, 0, 0, 1, L);
        hipLaunchKernelGGL(k_attn, dim3(L / 64, H), dim3(64), 0, st, b.NQ, b.NKV, b.NKR, b.NO);
        gemm(st, b.NO, D, I.mla_w_o, D, b.NT1, D, L, D, D);
        REF_EW(k_resid, L * 1024, b.NX, b.NT1, md + 2 * D, L);
        }
        moe(st, I, b, 1, 0, L, bb);
        hipLaunchKernelGGL(k_rms, dim3(L), dim3(256), 0, st, b.NX, D, d_out + (size_t)bb * L * D, D, I.final_g, (const float*)nullptr, (const float*)nullptr, D);
    }
}
}
namespace pg8 {
#define PG8_LAS __attribute__((address_space(3)))
typedef unsigned short bf16_t;
typedef short bf16x8 __attribute__((ext_vector_type(8)));
typedef float f32x4 __attribute__((ext_vector_type(4)));
typedef unsigned u32x4 __attribute__((ext_vector_type(4)));
constexpr int BM = 256, BK = 64, HALF = 128, HTB = HALF * BK * 2  , STAGE_BYTES = 8 * HTB, NXCD = 8, WGM = 8;

__host__ __device__ __forceinline__ int lds_byte(int r, int c) { const int st = (r >> 4) * 2 + (c >> 5), rr = r & 15, cc = c & 31, ob = rr * 64 + cc * 2; return st * 1024 + (ob ^ (((ob >> 9) & 1) << 5)); }
__host__ __device__ __forceinline__ void stage_rc(int b, int& R, int& C) { const int st = b / 1024, sb = b % 1024, swz = sb ^ (((sb >> 9) & 1) << 5); R = (st >> 1) * 16 + swz / 64; C = (st & 1) * 32 + (swz % 64) / 2; }
__host__ __device__ __forceinline__ int perm32(int rho) { const int n = rho >> 4, i = rho & 15; return 8 * (i >> 2) + 4 * n + (i & 3); }

struct Unit { int pm, pn; };
struct Gemm { const bf16_t* A; const bf16_t* Bt; int M, N, K; };

__device__ __forceinline__ unsigned cvt_pk_bf16(float lo, float hi) { unsigned r; asm volatile("v_cvt_pk_bf16_f32 %0, %1, %2" : "=v"(r) : "v"(lo), "v"(hi)); return r; }
typedef float f32x2 __attribute__((ext_vector_type(2)));
template <class Epi, class Sched, bool ALIGN_EPI = false, bool SP2 = false, bool GATHER = false>
__device__ __forceinline__ void gemm_phase(PG8_LAS unsigned char* lds, const Gemm g, const Sched& S, const Epi& E, const int tid, const PG8_LAS int* rowtab = nullptr) {
    static_assert(!GATHER || SP2, "gather staging is written for the SP2 loop only");
    const int  wid = __builtin_amdgcn_readfirstlane(tid >> 6), lane = tid & 63, wr = wid >> 2, wc = wid & 3, fr = lane & 15, fq = lane >> 4;
    const int K = g.K, nt = K / BK;
    unsigned voffA[2], voffB[2];
#pragma unroll
    for (int i = 0; i < 2; ++i) { int R, C; stage_rc(tid * 16 + i * 8192, R, C); const int Rb = Epi::PERM ? ((R & ~31) + perm32(R & 31)) : R;
        voffA[i] = (unsigned)(R * K + C) * 2u; voffB[i] = (unsigned)(Rb * K + C) * 2u; }
    int RA[2], CA2[2];
#pragma unroll
    for (int i = 0; i < 2; ++i) { int R, C; stage_rc(tid * 16 + i * 8192, R, C); RA[i] = R; CA2[i] = C * 2; }
    unsigned vAc[2][2], vAn[2][2];
#define PG8_GOFF(dst, ord) do { _Pragma("unroll") for (int h_ = 0; h_ < 2; ++h_) _Pragma("unroll") for (int i_ = 0; i_ < 2; ++i_) \
        dst[h_][i_] = (unsigned)rowtab[(ord) * 256 + h_ * HALF + RA[i_]] * (unsigned)(K * 2) + (unsigned)CA2[i_]; } while (0)
    const size_t kstep = (size_t)(BK * 2);
    const size_t hstep = (size_t)HALF * K * 2;
    const size_t tstep = 2 * hstep;
    const unsigned ldsw = (unsigned)wid * 1024u;
    const int aoff = lds_byte(wr * 64 + fr, fq * 8), boff = lds_byte(wc * 32 + fr, fq * 8);
#define PG8_SA(b, h) (((b) * 2 + (h)) * HTB)
#define PG8_SB(b, h) ((4 + (b) * 2 + (h)) * HTB)
#define PG8_STAGE(bufoff, gbase, voff) do { _Pragma("unroll") for (int _i = 0; _i < 2; ++_i) \
        __builtin_amdgcn_global_load_lds((const unsigned*)((const char*)(gbase) + (voff)[_i]), (PG8_LAS unsigned*)(lds + (bufoff) + ldsw + _i * 8192), 16, 0, 0); } while (0)
#define PG8_STAGE_A(b, h, useNext, koff) do { if constexpr (GATHER) { const unsigned v_[2] = {(useNext) ? vAn[h][0] : vAc[h][0], (useNext) ? vAn[h][1] : vAc[h][1]}; \
            PG8_STAGE(PG8_SA(b, h), (const char*)g.A + (koff), v_); } \
        else PG8_STAGE(PG8_SA(b, h), ((useNext) ? nA : cA) + (koff) + (size_t)(h) * hstep, voffA); } while (0)
#define PG8_LDA(dst, b, h) do { _Pragma("unroll") for (int m = 0; m < 4; ++m) _Pragma("unroll") for (int k = 0; k < 2; ++k) dst[m][k] = *(const PG8_LAS bf16x8*)(lds + PG8_SA(b, h) + aoff + m * 2048 + k * 1024); } while (0)
#define PG8_LDB(dst, b, h) do { _Pragma("unroll") for (int n = 0; n < 2; ++n) _Pragma("unroll") for (int k = 0; k < 2; ++k) dst[n][k] = *(const PG8_LAS bf16x8*)(lds + PG8_SB(b, h) + boff + n * 2048 + k * 1024); } while (0)
#define PG8_MMA(ai, bj, At, Bt) do { __builtin_amdgcn_s_setprio(1); _Pragma("unroll") for (int m = 0; m < 4; ++m) _Pragma("unroll") for (int n = 0; n < 2; ++n) _Pragma("unroll") for (int k = 0; k < 2; ++k) \
        acc[ai][bj][m][n] = __builtin_amdgcn_mfma_f32_16x16x32_bf16(Bt[n][k], At[m][k], acc[ai][bj][m][n], 0, 0, 0); __builtin_amdgcn_s_setprio(0); } while (0)
#define PG8_WAIT_V(n) asm volatile("s_waitcnt vmcnt(" #n ")" ::: "memory")
#define PG8_WAIT_L(n) asm volatile("s_waitcnt lgkmcnt(" #n ")" ::: "memory")
#define PG8_BAR __builtin_amdgcn_s_barrier()
#define PG8_SCHED __builtin_amdgcn_sched_barrier(0)
    Unit cur, nxt; int ui = 0;
    if (!S.next(0, cur)) return;
    f32x4 acc[2][2][4][2];
#pragma unroll
    for (int a = 0; a < 2; ++a)
#pragma unroll
        for (int b = 0; b < 2; ++b)
#pragma unroll
            for (int m = 0; m < 4; ++m)
#pragma unroll
                for (int n = 0; n < 2; ++n) acc[a][b][m][n] = (f32x4){0.f, 0.f, 0.f, 0.f};
    bf16x8 At[4][2], B0[2][2], B1[2][2];
    const char* cA = GATHER ? (const char*)g.A : (const char*)g.A + (size_t)cur.pm * tstep; const char* cB = (const char*)g.Bt + (size_t)cur.pn * tstep;
    if constexpr (GATHER) { PG8_GOFF(vAc, 0); PG8_GOFF(vAn, 0); }
    S.a_ready(cur);
    if constexpr (SP2) {
        const char* const nA = cA;
        PG8_STAGE(PG8_SB(0, 0), cB, voffB); PG8_STAGE(PG8_SB(0, 1), cB + hstep, voffB); PG8_STAGE_A(0, 0, false, (size_t)0); PG8_STAGE_A(0, 1, false, (size_t)0);
        if (wr == 1) PG8_BAR;
        PG8_WAIT_V(2); PG8_BAR;
        PG8_STAGE(PG8_SB(1, 0), cB + kstep, voffB); PG8_STAGE_A(1, 0, false, kstep); PG8_STAGE(PG8_SB(1, 1), cB + hstep + kstep, voffB);
        PG8_WAIT_V(6); PG8_BAR;
    } else {
        PG8_STAGE(PG8_SB(0, 0), cB, voffB); PG8_STAGE(PG8_SA(0, 0), cA, voffA); PG8_STAGE(PG8_SB(0, 1), cB + hstep, voffB); PG8_STAGE(PG8_SA(0, 1), cA + hstep, voffA);
        if (wr == 1) PG8_BAR;
        PG8_WAIT_V(4); PG8_BAR;
        PG8_STAGE(PG8_SB(1, 0), cB + kstep, voffB); PG8_STAGE(PG8_SA(1, 0), cA + kstep, voffA); PG8_STAGE(PG8_SB(1, 1), cB + hstep + kstep, voffB);
        PG8_WAIT_V(6); PG8_BAR;
    }
    for (;;) {
        const bool has_next = S.next(ui + 1, nxt);
        const char* nA = (has_next && !GATHER) ? (const char*)g.A + (size_t)nxt.pm * tstep : cA; const char* nB = has_next ? (const char*)g.Bt + (size_t)nxt.pn * tstep : cB;
        if constexpr (GATHER) { if (has_next) PG8_GOFF(vAn, ui + 1); else { _Pragma("unroll") for (int h_ = 0; h_ < 2; ++h_) _Pragma("unroll") for (int i_ = 0; i_ < 2; ++i_) vAn[h_][i_] = vAc[h_][i_]; } }
        asm volatile(".p2align 8" ::: "memory");
        for (int t = 0; t < nt; t += 2) {
            const bool last = (t == nt - 2);
            const size_t k1 = (size_t)(t + 1) * kstep, k2 = last ? (size_t)0 : (size_t)(t + 2) * kstep, k3 = k2 + kstep;
            const char* a1 = cA + k1; const char* a2 = (last ? nA : cA) + k2; const char* b2 = last ? nB : cB + (size_t)(t + 2) * kstep;
            const char* a3 = a2 + kstep; const char* b3 = b2 + kstep; (void)a1; (void)a3;
            if (last && has_next) S.a_ready(nxt);
            if constexpr (SP2) {
            PG8_LDB(B0, 0, 0); PG8_LDB(B1, 0, 1); PG8_SCHED; PG8_LDA(At, 0, 0); PG8_STAGE_A(1, 1, false, k1);
            PG8_WAIT_V(8); PG8_WAIT_L(0); PG8_BAR; PG8_MMA(0, 0, At, B0); PG8_MMA(0, 1, At, B1); PG8_BAR; PG8_SCHED;
            PG8_LDA(At, 0, 1); PG8_STAGE(PG8_SB(0, 0), b2, voffB); PG8_STAGE(PG8_SB(0, 1), b2 + hstep, voffB); PG8_STAGE_A(0, 0, last, k2);
            PG8_WAIT_V(8); PG8_WAIT_L(0); PG8_BAR; PG8_MMA(1, 0, At, B0); PG8_MMA(1, 1, At, B1); PG8_BAR; PG8_SCHED;
            PG8_LDB(B0, 1, 0); PG8_LDB(B1, 1, 1); PG8_SCHED; PG8_LDA(At, 1, 0); PG8_STAGE_A(0, 1, last, k2);
            PG8_WAIT_V(8); PG8_WAIT_L(0); PG8_BAR; PG8_MMA(0, 0, At, B0); PG8_MMA(0, 1, At, B1); PG8_BAR; PG8_SCHED;
            PG8_LDA(At, 1, 1); PG8_STAGE(PG8_SB(1, 0), b3, voffB); PG8_STAGE(PG8_SB(1, 1), b3 + hstep, voffB); PG8_STAGE_A(1, 0, last, k3);
            PG8_WAIT_V(8); PG8_WAIT_L(0); PG8_BAR; PG8_MMA(1, 0, At, B0); PG8_MMA(1, 1, At, B1); PG8_BAR; PG8_SCHED;
            } else {
            PG8_LDB(B0, 0, 0); PG8_SCHED; PG8_LDA(At, 0, 0); PG8_STAGE(PG8_SA(1, 1), a1 + hstep, voffA);
            PG8_WAIT_L(8); PG8_BAR; PG8_WAIT_L(0); PG8_MMA(0, 0, At, B0); PG8_BAR; PG8_SCHED;
            PG8_LDB(B1, 0, 1); PG8_STAGE(PG8_SB(0, 0), b2, voffB);
            PG8_BAR; PG8_WAIT_L(0); PG8_MMA(0, 1, At, B1); PG8_BAR;
            PG8_LDA(At, 0, 1); PG8_STAGE(PG8_SA(0, 0), a2, voffA);
            PG8_BAR; PG8_WAIT_L(0); PG8_MMA(1, 0, At, B0); PG8_BAR; PG8_SCHED;
            PG8_STAGE(PG8_SB(0, 1), b2 + hstep, voffB);
            PG8_WAIT_V(6); PG8_BAR; PG8_MMA(1, 1, At, B1); PG8_BAR;
            PG8_LDB(B0, 1, 0); PG8_SCHED; PG8_LDA(At, 1, 0); PG8_STAGE(PG8_SA(0, 1), a2 + hstep, voffA);
            PG8_WAIT_L(8); PG8_BAR; PG8_WAIT_L(0); PG8_MMA(0, 0, At, B0); PG8_BAR; PG8_SCHED;
            PG8_LDB(B1, 1, 1); PG8_STAGE(PG8_SB(1, 0), b3, voffB);
            PG8_BAR; PG8_WAIT_L(0); PG8_MMA(0, 1, At, B1); PG8_BAR;
            PG8_LDA(At, 1, 1); PG8_STAGE(PG8_SA(1, 0), a3, voffA);
            PG8_BAR; PG8_WAIT_L(0); PG8_MMA(1, 0, At, B0); PG8_BAR; PG8_SCHED;
            PG8_STAGE(PG8_SB(1, 1), b3 + hstep, voffB);
            PG8_WAIT_V(6); PG8_BAR; PG8_MMA(1, 1, At, B1); PG8_BAR;
            }
        }
        if constexpr (ALIGN_EPI) { if (wr == 0) PG8_BAR; }
        if constexpr (!Epi::AFTER_DRAIN) { E(acc, cur, wr, wc, fr, fq); S.done(cur); }
        if (!has_next) break;
#pragma unroll
        for (int a = 0; a < 2; ++a)
#pragma unroll
            for (int b = 0; b < 2; ++b)
#pragma unroll
                for (int m = 0; m < 4; ++m)
#pragma unroll
                    for (int n = 0; n < 2; ++n) acc[a][b][m][n] = (f32x4){0.f, 0.f, 0.f, 0.f};
        cur = nxt; cA = nA; cB = nB; ++ui;
        if constexpr (GATHER) { _Pragma("unroll") for (int h_ = 0; h_ < 2; ++h_) _Pragma("unroll") for (int i_ = 0; i_ < 2; ++i_) vAc[h_][i_] = vAn[h_][i_]; }
        if constexpr (ALIGN_EPI) { if (wr == 1) PG8_BAR; }
    }
    PG8_WAIT_V(0);
    if constexpr (!ALIGN_EPI) { if (wr == 0) PG8_BAR; }
    PG8_BAR;
    if constexpr (Epi::AFTER_DRAIN) { E.fused(acc, cur, wr, wc, fr, fq, lds, wid, lane); S.done(cur); }
#undef PG8_SA
#undef PG8_SB
#undef PG8_STAGE
#undef PG8_STAGE_A
#undef PG8_GOFF
#undef PG8_LDA
#undef PG8_LDB
#undef PG8_MMA
#undef PG8_WAIT_V
#undef PG8_WAIT_L
#undef PG8_BAR
#undef PG8_SCHED
}
}
#define GAS __attribute__((address_space(1)))
#define LAS __attribute__((address_space(3)))
typedef unsigned short bf16;
typedef unsigned v4u __attribute__((ext_vector_type(4)));
typedef float f32x4 __attribute__((ext_vector_type(4)));
typedef short bf16x8 __attribute__((ext_vector_type(8)));
typedef GAS unsigned gu32;
typedef GAS unsigned long long gu64;
#define RLX_AGENT __ATOMIC_RELAXED, __HIP_MEMORY_SCOPE_AGENT
#define LDS_WAIT() asm volatile("s_waitcnt lgkmcnt(0)" ::: "memory")
#define VM_WAIT() asm volatile("s_waitcnt vmcnt(0)" ::: "memory")
__device__ __forceinline__ unsigned long long rt() { return __builtin_amdgcn_s_memrealtime(); }
__device__ __forceinline__ unsigned f2bf(float f) { unsigned u = __builtin_bit_cast(unsigned, f); return (u + 0x7fffu + ((u >> 16) & 1u)) >> 16; }
__device__ __forceinline__ unsigned pk2(float lo, float hi) { return f2bf(lo) | (f2bf(hi) << 16); }
#define XB_TMO      128
#define XB_XCNT(j)  (256  + 64 * (j))
#define XB_XSUB(j)  (1280 + 64 * (j))
#define XB_XGEN(j)  (2304 + 64 * (j))
#define XB_TOP      3328
#define XB_TOPGEN   3392
#define XCD_BAR_WORDS 3456
#define XB_SPIN_CAP (1u << 18)

__device__ __forceinline__ unsigned xb_ld(unsigned* p)              { return __hip_atomic_load(p, __ATOMIC_RELAXED, __HIP_MEMORY_SCOPE_AGENT); }
__device__ __forceinline__ unsigned xb_add(unsigned* p, unsigned v) { return __hip_atomic_fetch_add(p, v, __ATOMIC_RELAXED, __HIP_MEMORY_SCOPE_AGENT); }
__device__ __forceinline__ unsigned xb_xcc_id() { return (unsigned)__builtin_amdgcn_s_getreg((3 << 11) | 20) & 0xFu; }
#define XB_SPIN(cond, bar) do { unsigned _sp = 0; while (cond) { __builtin_amdgcn_s_sleep(1); \
    if ((++_sp & 255u) == 0u) { if (xb_ld(&(bar)[XB_TMO])) break; if (_sp > XB_SPIN_CAP) { atomicAdd(&(bar)[XB_TMO], 1u); break; } } } } while (0)

struct XcdBarrier {
    unsigned* bar; unsigned x;
    volatile LAS unsigned* st;
};

__device__ __forceinline__ XcdBarrier xcd_barrier_post(unsigned* bar, volatile LAS unsigned* st) {
    XcdBarrier b; b.bar = bar; b.x = xb_xcc_id(); b.st = st;
    if (threadIdx.x == 0) (void)xb_add(&bar[XB_XCNT(b.x)], 1u);
    return b;
}
__device__ __forceinline__ void xcd_barrier_complete(unsigned* bar, unsigned x, unsigned& nloc, unsigned& nx) {
    const unsigned G = gridDim.x * gridDim.y * gridDim.z;
    unsigned sum, cnt, mine, sp = 0u;
    for (;;) {
        sum = 0u; cnt = 0u; mine = 0u;
#pragma unroll
        for (unsigned j = 0; j < 16; ++j) { const unsigned c = xb_ld(&bar[XB_XCNT(j)]); sum += c; cnt += (c > 0u) ? 1u : 0u; mine = (j == x) ? c : mine; }
        if (sum == G) break;
        __builtin_amdgcn_s_sleep(1);
        if ((++sp & 255u) == 0u) { if (xb_ld(&bar[XB_TMO])) break; if (sp > XB_SPIN_CAP) { atomicAdd(&bar[XB_TMO], 1u); break; } }
    }
    nloc = mine > 0u ? mine : 1u; nx = cnt > 0u ? cnt : 1u;
}

__device__ __forceinline__ void xcd_barrier(const XcdBarrier& b) {
    asm volatile("s_waitcnt vmcnt(0)" ::: "memory");
    __syncthreads();
    if (threadIdx.x == 0) {
        unsigned* bar = b.bar;
        __builtin_amdgcn_s_waitcnt(0);
        unsigned nloc = b.st[0], nx = b.st[1];
        if (nloc == 0u) { xcd_barrier_complete(bar, b.x, nloc, nx); b.st[0] = nloc; b.st[1] = nx; }
        const unsigned old = xb_add(&bar[XB_XSUB(b.x)], 1u);
        const unsigned gen = old / nloc;
        if (old + 1u == (gen + 1u) * nloc) {
            __builtin_amdgcn_fence(__ATOMIC_RELEASE, "agent");
            asm volatile("s_waitcnt vmcnt(0)" ::: "memory");
            const unsigned og = xb_add(&bar[XB_TOP], 1u);
            const unsigned tg = og / nx;
            if (og + 1u == (tg + 1u) * nx) xb_add(&bar[XB_TOPGEN], 1u);
            else XB_SPIN(xb_ld(&bar[XB_TOPGEN]) == tg, bar);
            __builtin_amdgcn_fence(__ATOMIC_ACQUIRE, "agent");
            xb_add(&bar[XB_XGEN(b.x)], 1u);
            asm volatile("s_waitcnt vmcnt(0)" ::: "memory");
        } else {
            XB_SPIN(xb_ld(&bar[XB_XGEN(b.x)]) == gen, bar);
            __builtin_amdgcn_fence(__ATOMIC_ACQUIRE, "agent");
            asm volatile("s_waitcnt vmcnt(0)" ::: "memory");
        }
    }
    __syncthreads();
}
namespace fp {
using pg8::Unit; using pg8::Gemm; using pg8::cvt_pk_bf16; using pg8::u32x4;
typedef unsigned u32x2v __attribute__((ext_vector_type(2)));
constexpr int D = 1024, NB = 16, L = 2048, LC = 256, TL = NB * L, TC = NB * LC, T = TL + TC;
constexpr int NWAVES = 8, NTHR = 512;
constexpr int ER = 4608;
constexpr float EPS = 1e-6f;
constexpr size_t MiB = 1u << 20;
constexpr size_t WS_CTL = 0, CTL_ZERO_BYTES = 1 * MiB;
constexpr size_t WS_MODS = 1 * MiB;
constexpr size_t WS_ROPE = 2 * MiB;
constexpr size_t WS_GATE = 3 * MiB;
constexpr size_t WS_AROW = WS_GATE + 512 * 1024;
constexpr size_t WS_AFF = 4 * MiB;
constexpr size_t WS_INV = 7 * MiB;
constexpr size_t WS_KR = 10 * MiB;
constexpr size_t WS_XC = 13 * MiB;
constexpr size_t WS_WOUT = 29 * MiB;
constexpr size_t WS_WMLA = 31 * MiB;
constexpr size_t WS_WUQ = 32 * MiB;
constexpr size_t WS_WUKV = WS_WUQ + 1536 * 256 * 2;
constexpr size_t WS_WO = 34 * MiB;
constexpr size_t WS_CS = 36 * MiB;
constexpr size_t WS_CSC = 52 * MiB;
constexpr size_t WS_UW = 53 * MiB;
constexpr size_t WS_WTY = WS_UW + (size_t)T * D * 2, WS_WTG = WS_WTY + 2 * MiB;
constexpr size_t WS_CQN = WS_UW, WS_CKVN = WS_UW + (size_t)T * 256 * 2, WS_O = WS_UW;
constexpr size_t WS_R1 = 129 * MiB;
constexpr size_t WS_AG = WS_R1, WS_YT = WS_R1 + 36 * MiB, WS_YTC = WS_R1 + 100 * MiB;
constexpr size_t WS_Q = WS_R1, WS_CQKV = WS_R1 + 96 * MiB;
constexpr size_t WS_R2 = 273 * MiB;
constexpr size_t WS_KN = WS_R2, WS_V = WS_R2 + 72 * MiB;
constexpr size_t WS_AP = WS_R2 + 72 * MiB;
constexpr size_t WS_W13 = 417 * MiB, WS_W2 = 481 * MiB, WS_Y1 = 513 * MiB, WS_END = 577 * MiB;
constexpr int CW_BAR = 4096;
constexpr int RING_BYTES = 131072, LDS_BYTES = 144 * 1024, LDSCTL_OFF = LDS_BYTES - 1024, MISC_OFF = LDSCTL_OFF + 320, XTRA_OFF = 133120;

constexpr int PTR_OFF = LDSCTL_OFF + 512;
struct Ctx {
    float* out; unsigned char* ws; LAS unsigned char* lds;
    int tid, lane, wave, vcu, G, gw, NGW;
    __device__ __forceinline__ const float* in(int i) const {
        volatile LAS unsigned* p = (volatile LAS unsigned*)(lds + PTR_OFF) + 2 * i; unsigned lo = p[0], hi = p[1];
        lo = __builtin_amdgcn_readfirstlane(lo); hi = __builtin_amdgcn_readfirstlane(hi); return (const float*)(((unsigned long long)hi << 32) | lo); }
};
#define WSP(T_, off) ((T_*)(F.ws + (off)))
__device__ __forceinline__ int swz_xor(int v, int o) {
    switch (o) { case 1: return __builtin_amdgcn_ds_swizzle(v, (1 << 10) | 0x1f); case 2: return __builtin_amdgcn_ds_swizzle(v, (2 << 10) | 0x1f); case 4: return __builtin_amdgcn_ds_swizzle(v, (4 << 10) | 0x1f);
                 case 8: return __builtin_amdgcn_ds_swizzle(v, (8 << 10) | 0x1f); default: return __builtin_amdgcn_ds_swizzle(v, (16 << 10) | 0x1f); } }
__device__ __forceinline__ float wave_sum(float v) {
    v += __builtin_bit_cast(float, swz_xor(__builtin_bit_cast(int, v), 1)); v += __builtin_bit_cast(float, swz_xor(__builtin_bit_cast(int, v), 2));
    v += __builtin_bit_cast(float, swz_xor(__builtin_bit_cast(int, v), 4)); v += __builtin_bit_cast(float, swz_xor(__builtin_bit_cast(int, v), 8));
    v += __builtin_bit_cast(float, swz_xor(__builtin_bit_cast(int, v), 16));
    const int bits = __builtin_bit_cast(int, v);
    return __builtin_bit_cast(float, __builtin_amdgcn_readlane(bits, 0)) + __builtin_bit_cast(float, __builtin_amdgcn_readlane(bits, 32));
}
__device__ __forceinline__ int wave_sum_i(int v) {
    v += swz_xor(v, 1); v += swz_xor(v, 2); v += swz_xor(v, 4); v += swz_xor(v, 8); v += swz_xor(v, 16);
    return __builtin_amdgcn_readlane(v, 0) + __builtin_amdgcn_readlane(v, 32);
}
__device__ __forceinline__ float siluf(float v) { return v / (1.f + __expf(-v)); }
__device__ __forceinline__ float bf2f(unsigned short h) { return __builtin_bit_cast(float, (unsigned)h << 16); }

__device__ __forceinline__ void p0_mods(Ctx& F) {
    LAS float* sc = (LAS float*)F.lds;
    LAS float* red = (LAS float*)(F.lds + 17 * 1024 * 4);
    { const float* c_ = F.in(1); const float* cc_ = F.in(3); f32x4 cv[9];
#pragma unroll
      for (int q = 0; q < 9; ++q) { const int i4 = F.tid + q * NTHR; if (i4 < 17 * 256) cv[q] = i4 < 16 * 256 ? *(const GAS f32x4*)(c_ + 4 * i4) : *(const GAS f32x4*)(cc_ + 4 * (i4 - 16 * 256)); }
#pragma unroll
      for (int q = 0; q < 9; ++q) { const int i4 = F.tid + q * NTHR; if (i4 < 17 * 256) { f32x4 o; o.x = siluf(cv[q].x); o.y = siluf(cv[q].y); o.z = siluf(cv[q].z); o.w = siluf(cv[q].w); *(LAS f32x4*)(sc + 4 * i4) = o; } } }
    __syncthreads();
    float* MODS = WSP(float, WS_MODS);
    for (int item = blockIdx.x; item < 192; item += F.G) {
        const int ly = item / 96, n0 = (item % 96) * 64, k0 = F.wave * 128;
        const float* W = F.in(4) + (size_t)ly * 1024 * 6144 + n0 + F.lane;
        float acc[17];
#pragma unroll
        for (int r = 0; r < 17; ++r) acc[r] = 0.f;
#pragma unroll 1
        for (int kb = 0; kb < 128; kb += 16) { float w[16];
#pragma unroll
            for (int q = 0; q < 16; ++q) w[q] = __builtin_nontemporal_load((const GAS float*)(W + (size_t)(k0 + kb + q) * 6144));
#pragma unroll
            for (int q = 0; q < 16; ++q)
#pragma unroll
                for (int r = 0; r < 17; ++r) acc[r] += sc[r * 1024 + k0 + kb + q] * w[q]; }
#pragma unroll
        for (int r = 0; r < 17; ++r) red[(F.wave * 17 + r) * 64 + F.lane] = acc[r];
        __syncthreads();
        const float* mb_ = F.in(5); const float bias = *(const GAS float*)(mb_ + ly * 6144 + n0 + (F.tid & 63));
        for (int o = F.tid; o < 17 * 64; o += NTHR) { const int r = o >> 6, c = o & 63; float s = bias;
#pragma unroll
            for (int w = 0; w < 8; ++w) s += red[(w * 17 + r) * 64 + c];
            MODS[(size_t)(ly * 17 + r) * 6144 + n0 + c] = s; }
        __syncthreads();
    }
}
struct MapId { int off; __device__ __forceinline__ int operator()(int n) const { return off + n; } };
struct MapGlu { __device__ __forceinline__ int operator()(int n) const { const int s = n >> 9, c = n & 511; return (c >> 7) * 256 + s * 128 + (c & 127); } };
struct Map13 { int s; __device__ __forceinline__ int operator()(int n) const { return (n >> 7) * 256 + s * 128 + (n & 127); } };
template <class RowMap>
__device__ __forceinline__ void tr_write(LAS float* scr, bf16* WT, int ldt, int k0, int n0, RowMap rm, int lane, bool nt = false) {
    const int c = lane & 7;
#pragma unroll
    for (int j = 0; j < 4; ++j) { const int n = (lane >> 3) + 8 * j; const LAS float* s = scr + (8 * c) * 33 + n;
        v4u o; o.x = pk2(s[0 * 33], s[1 * 33]); o.y = pk2(s[2 * 33], s[3 * 33]); o.z = pk2(s[4 * 33], s[5 * 33]); o.w = pk2(s[6 * 33], s[7 * 33]);
        GAS v4u* d_ = (GAS v4u*)(WT + (size_t)rm(n0 + n) * ldt + k0 + 8 * c);
        if (nt) __builtin_nontemporal_store(o, d_); else *d_ = o; }
    LDS_WAIT(); asm volatile("" ::: "memory");
}
template <class RowMap>
__device__ __forceinline__ void tr_item(const float* W, int ldw, int nblk, bf16* WT, int ldt, RowMap rm, LAS float* scr, int item, int lane, bool nt = false) {
    const int kb = item / nblk, nb = item % nblk, k0 = 64 * kb, n0 = 32 * nb;
    f32x4 t[8];
#pragma unroll
    for (int i = 0; i < 8; ++i) t[i] = __builtin_nontemporal_load((const GAS f32x4*)(W + (size_t)(k0 + 8 * i + (lane >> 3)) * ldw + n0 + 4 * (lane & 7)));
#pragma unroll
    for (int i = 0; i < 8; ++i) { LAS float* d = scr + (8 * i + (lane >> 3)) * 33 + 4 * (lane & 7); d[0] = t[i].x; d[1] = t[i].y; d[2] = t[i].z; d[3] = t[i].w; }
    LDS_WAIT(); asm volatile("" ::: "memory");
    tr_write(scr, WT, ldt, k0, n0, rm, lane, nt);
}
__device__ __forceinline__ void wy_item(Ctx& F, LAS float* scr, LAS float* wst  , const LAS float* tab, int item) {
    const int lane = F.lane, kb = item >> 5, nb = item & 31, k0 = 64 * kb, n0 = 32 * nb;
    const int half = n0 >> 9, g = (n0 >> 7) & 3, m = (n0 & 127) + (lane & 31), kh = lane >> 5;
    const float* Wi = F.in(8) + (size_t)k0 * 1536 + 1024 + g * 128;
#pragma unroll 8
    for (int i = 0; i < 32; ++i) { const int kk = 2 * i + (lane >> 5), cc = (lane & 31) * 4; *(LAS f32x4*)(wst + kk * 128 + cc) = *(const GAS f32x4*)(Wi + (size_t)kk * 1536 + cc); }
    LDS_WAIT(); asm volatile("" ::: "memory");
    float sacc[32];
#pragma unroll
    for (int i = 0; i < 32; ++i) sacc[i] = 0.f;
#pragma unroll 1
    for (int ch = 0; ch < 4; ++ch) { float tw[32];
#pragma unroll
        for (int j = 0; j < 32; ++j) tw[j] = tab[((ch * 32 + j) * m + (half ? 96 : 0)) & 127];
#pragma unroll
        for (int i = 0; i < 32; ++i) { const LAS float* wr_ = wst + (2 * i + kh) * 128 + ch * 32;
#pragma unroll
            for (int j4 = 0; j4 < 8; ++j4) { const f32x4 w = *(const LAS f32x4*)(wr_ + 4 * j4);
                sacc[i] += (w.x * tw[4 * j4] + w.y * tw[4 * j4 + 1]) + (w.z * tw[4 * j4 + 2] + w.w * tw[4 * j4 + 3]); } } }
#pragma unroll
    for (int i = 0; i < 32; ++i) scr[(2 * i + kh) * 33 + (lane & 31)] = sacc[i];
    LDS_WAIT(); asm volatile("" ::: "memory");
    tr_write(scr, WSP(bf16, WS_WTY), 1024, k0, n0, MapId{0}, lane);
}
__device__ __forceinline__ void moe_w_items(Ctx& F, int ly, LAS float* scr, int it0 = 0, int it1 = 16 * 1536, int widx = -1, int nwork = 0, int mode = 0) {
    if (widx < 0) { widx = F.gw; nwork = F.NGW; }
    const size_t wl = (size_t)ly * 16 * 1024 * 1024;
    for (int j_ = it0 + widx; j_ < it1; j_ += nwork) { const int it = mode == 0 ? j_ : (mode == 1 ? (j_ >> 10) * 1536 + (j_ & 1023) : (j_ >> 9) * 1536 + 1024 + (j_ & 511));
        const int e = it / 1536, r = it % 1536, which = r >> 9, item = r & 511;
        if (which == 0) tr_item(F.in(21) + wl + (size_t)e * 1048576, 1024, 32, WSP(bf16, WS_W13) + (size_t)e * 2048 * 1024, 1024, Map13{0}, scr, item, F.lane, ly == 1);
        else if (which == 1) tr_item(F.in(22) + wl + (size_t)e * 1048576, 1024, 32, WSP(bf16, WS_W13) + (size_t)e * 2048 * 1024, 1024, Map13{1}, scr, item, F.lane, ly == 1);
        else tr_item(F.in(23) + wl + (size_t)e * 1048576, 1024, 32, WSP(bf16, WS_W2) + (size_t)e * 1024 * 1024, 1024, MapId{0}, scr, item, F.lane, ly == 1);
    }
}
constexpr int MW0_A = 0, MW0_B = 10240;
__device__ __forceinline__ void p0_rest(Ctx& F) {
    LAS float* tab128 = (LAS float*)(F.lds + XTRA_OFF); LAS float* tab2048 = tab128 + 128; LAS float* tab256 = tab2048 + 2048;
    for (int i = F.tid; i < 128 + 2048 + 256; i += NTHR) { float s, c;
        if (i < 128) sincospif(2.f * (float)i / 128.f, &s, &c); else if (i < 128 + 2048) sincospif(2.f * (float)(i - 128) / 2048.f, &s, &c); else sincospif(2.f * (float)(i - 2176) / 256.f, &s, &c);
        tab128[i] = c; }
    __syncthreads();
    LAS float* scr = (LAS float*)(F.lds + F.wave * 8448);
    constexpr int I_G = 512, I_OUT = 512, I_MLA = 16 * 13, I_UQ = 4 * 48, I_UKV = 2 * 64, I_O = 512;
    constexpr int NI = I_G + I_OUT + I_MLA + I_UQ + I_UKV + I_O;
    for (int it = F.gw; it < NI; it += F.NGW) { int r = it;
        if (r < I_G) { tr_item(F.in(8), 1536, 32, WSP(bf16, WS_WTG), 1024, MapGlu{}, scr, r, F.lane); continue; } r -= I_G;
        if (r < I_OUT) { tr_item(F.in(13), 1024, 32, WSP(bf16, WS_WOUT), 1024, MapId{0}, scr, r, F.lane); continue; } r -= I_OUT;
        if (r < I_MLA) { tr_item(F.in(14), 416, 13, WSP(bf16, WS_WMLA), 1024, MapId{0}, scr, r, F.lane); continue; } r -= I_MLA;
        if (r < I_UQ) { tr_item(F.in(17), 1536, 48, WSP(bf16, WS_WUQ), 256, MapId{0}, scr, r, F.lane); continue; } r -= I_UQ;
        if (r < I_UKV) { tr_item(F.in(18), 2048, 64, WSP(bf16, WS_WUKV), 128, MapId{0}, scr, r, F.lane); continue; } r -= I_UKV;
        tr_item(F.in(19), 1024, 32, WSP(bf16, WS_WO), 1024, MapId{0}, scr, r, F.lane);
    }
    if (F.wave < 2) { LAS float* w2 = (LAS float*)(F.lds + 8 * 8448 + F.wave * 32768);
        for (int it = F.vcu * 2 + F.wave; it < 512; it += F.G * 2) wy_item(F, scr, w2, tab128, it); }
    { v4u z = {0u, 0u, 0u, 0u};
      for (int i = F.gw * 64 + F.lane; i < 96 * 128; i += F.NGW * 64) *(GAS v4u*)(WSP(bf16, WS_WMLA) + (size_t)416 * 1024 + (size_t)i * 8) = z;
    }
    { const float sc = 1.f / sqrtf(2048.f * 128.f);
      for (int id = F.gw * 64 + F.lane; id < 256 * 64; id += F.NGW * 64) { const int k = id >> 6, l0 = (id & 63) * 8; float v[8];
#pragma unroll
          for (int j = 0; j < 8; ++j) { const int lp = l0 + j, l = lp & 255; int ph = (k * l) & 255; float x; if (lp < 256) x = tab256[ph]; else x = tab256[(ph + 192) & 255]; v[j] = x * sc; }
          v4u o; o.x = pk2(v[0], v[1]); o.y = pk2(v[2], v[3]); o.z = pk2(v[4], v[5]); o.w = pk2(v[6], v[7]);
          *(GAS v4u*)(WSP(bf16, WS_CS) + (size_t)k * 512 + l0) = o; } }
    { const float sc = 1.f / sqrtf(256.f * 128.f);
      for (int id = F.gw * 64 + F.lane; id < 256 * 64; id += F.NGW * 64) { const int k = id >> 6, l0 = (id & 63) * 8; float v[8];
#pragma unroll
          for (int j = 0; j < 8; ++j) { const int lp = l0 + j, l = lp & 255; int ph = (k * l) & 255; float x; if (lp < 256) x = tab256[ph]; else x = -tab256[(ph + 192) & 255]; v[j] = x * sc; }
          v4u o; o.x = pk2(v[0], v[1]); o.y = pk2(v[2], v[3]); o.z = pk2(v[4], v[5]); o.w = pk2(v[6], v[7]);
          *(GAS v4u*)(WSP(bf16, WS_CSC) + (size_t)k * 512 + l0) = o; } }
    for (int i = F.gw * 64 + F.lane; i < 2048 * 16; i += F.NGW * 64) { const int l = i >> 4, p = i & 15;
        const float pos = (p < 8) ? (float)(l >> 6) : (float)(l & 63); const float inv = powf(10000.f, -(float)(p & 7) / 8.f); float s, c; sincosf(pos * inv, &s, &c);
        WSP(float, WS_ROPE)[2 * i] = c; WSP(float, WS_ROPE)[2 * i + 1] = s; }
}

__device__ __forceinline__ void load_row(const float* p, int lane, f32x4 (&v)[4]) {
    const GAS f32x4* xr = (const GAS f32x4*)p + lane;
#pragma unroll
    for (int j = 0; j < 4; ++j) v[j] = __builtin_nontemporal_load(xr + 64 * j);
}
__device__ __forceinline__ float row_ss(const f32x4 (&v)[4]) { float s = 0.f;
#pragma unroll
    for (int j = 0; j < 4; ++j) s += (v[j].x * v[j].x + v[j].y * v[j].y) + (v[j].z * v[j].z + v[j].w * v[j].w);
    return wave_sum(s); }
__device__ __forceinline__ void store_row_bf16(bf16* orow, int lane, const f32x4 (&v)[4]) {
    GAS unsigned long long* o8 = (GAS unsigned long long*)orow + lane;
#pragma unroll
    for (int j = 0; j < 4; ++j) o8[64 * j] = (unsigned long long)pk2(v[j].x, v[j].y) | ((unsigned long long)pk2(v[j].z, v[j].w) << 32);
}
__device__ __forceinline__ int mod_row(int t) { return t < TL ? (t >> 11) : 16; }
__device__ __forceinline__ float* xrow(Ctx& F, int t) { return t < TL ? F.out + (size_t)t * D : WSP(float, WS_XC) + (size_t)(t - TL) * D; }
__device__ __forceinline__ void norm_mod(f32x4 (&v)[4], float rstd, const float* g, const float* md, int ch_sh, int ch_sc, int lane) {
#pragma unroll
    for (int j = 0; j < 4; ++j) { const int c = 4 * lane + 256 * j;
        const f32x4 gg = *(const GAS f32x4*)(g + c), sc = *(const GAS f32x4*)(md + ch_sc * 1024 + c), sh = *(const GAS f32x4*)(md + ch_sh * 1024 + c);
        v[j] = v[j] * rstd * gg * (1.f + sc) + sh; }
}
__device__ __forceinline__ const float* xin_row(Ctx& F, int t) { return t < TL ? F.in(0) + (size_t)t * D : F.in(2) + (size_t)(t - TL) * D; }
__device__ __forceinline__ const bf16* y_row(Ctx& F, int t) { return (const bf16*)xrow(F, t) + 1024; }
__device__ __forceinline__ void load_rowY(const bf16* yrow, int lane, u32x2v (&r)[4]) {
#pragma unroll
    for (int j = 0; j < 4; ++j) r[j] = __builtin_nontemporal_load((const GAS u32x2v*)(yrow + 4 * lane + 256 * j));
}
__device__ __forceinline__ void add_rowY(f32x4 (&v)[4], const u32x2v (&r)[4]) {
#pragma unroll
    for (int j = 0; j < 4; ++j) { v[j].x += __builtin_bit_cast(float, r[j].x << 16); v[j].y += __builtin_bit_cast(float, r[j].x & 0xffff0000u); v[j].z += __builtin_bit_cast(float, r[j].y << 16); v[j].w += __builtin_bit_cast(float, r[j].y & 0xffff0000u); }
}
struct ModC { int mr; f32x4 A[4], B[4]; };
__device__ __forceinline__ void modc_set(ModC& m, int mr, const float* g, const float* mdl, int ch_sh, int ch_sc, int lane) {
    m.mr = mr; const float* md = mdl + (size_t)mr * 6144;
#pragma unroll
    for (int j = 0; j < 4; ++j) { const int c = 4 * lane + 256 * j;
        const f32x4 gg = *(const GAS f32x4*)(g + c), sc = *(const GAS f32x4*)(md + ch_sc * 1024 + c); m.A[j] = gg * (1.f + sc); m.B[j] = *(const GAS f32x4*)(md + ch_sh * 1024 + c); }
}
__device__ __forceinline__ void p1_norm(Ctx& F) {
    const float* MODS = WSP(float, WS_MODS); const float* xin = F.in(0); const float* cin = F.in(2); const float* n1g = F.in(6);
    ModC mc; mc.mr = -1; const int nrow = F.wave < 2 ? 12 : 20, t0 = F.vcu * 144 + (F.wave < 2 ? F.wave * 12 : 24 + (F.wave - 2) * 20);
    f32x4 nx[4]; load_row(t0 < TL ? xin + (size_t)t0 * D : cin + (size_t)(t0 - TL) * D, F.lane, nx);
#pragma unroll 1
    for (int i = 0; i < nrow; ++i) { const int t = t0 + i;
        f32x4 v[4];
#pragma unroll
        for (int j = 0; j < 4; ++j) v[j] = nx[j];
        if (i + 1 < nrow) { const int t1 = t + 1; load_row(t1 < TL ? xin + (size_t)t1 * D : cin + (size_t)(t1 - TL) * D, F.lane, nx); }
        const int mr = mod_row(t); if (mr != mc.mr) modc_set(mc, mr, n1g, MODS, 0, 1, F.lane);
        const float rstd = rsqrtf(row_ss(v) * (1.f / D) + EPS);
#pragma unroll
        for (int j = 0; j < 4; ++j) v[j] = v[j] * rstd * mc.A[j] + mc.B[j];
        store_row_bf16(WSP(bf16, WS_UW) + (size_t)t * D, F.lane, v); }
}
__device__ __forceinline__ int cv_seq(int R) { return R < TL ? (R >> 11) : 16 + ((R - TL) >> 8); }
typedef __bf16 cv_bf2 __attribute__((ext_vector_type(2)));
__device__ __forceinline__ float cv_dot2(unsigned x, unsigned w, float a) { return __builtin_amdgcn_fdot2_f32_bf16(__builtin_bit_cast(cv_bf2, x), __builtin_bit_cast(cv_bf2, w), a, false); }
template <bool MASKED>
__device__ __forceinline__ void cv_taps(const LAS unsigned char* xb, const LAS unsigned char* wb, float (&acc)[6][8], int tg) {
    unsigned wp[8];
#pragma unroll
    for (int q = 0; q < 8; ++q) wp[q] = 0u;
    int sq[6];
#pragma unroll
    for (int k = 0; k < 6; ++k) sq[k] = MASKED ? cv_seq(tg + k) : 0;
#pragma unroll 4
    for (int m = 0; m < 16; ++m) {
        const v4u wa = *(const LAS v4u*)(wb + m * 2048), wc = *(const LAS v4u*)(wb + m * 2048 + 1024);
        const unsigned we[8] = { wa.x, wa.y, wa.z, wa.w, wc.x, wc.y, wc.z, wc.w }; unsigned wo[8];
#pragma unroll
        for (int q = 0; q < 8; ++q) { wo[q] = __builtin_amdgcn_alignbit(we[q], wp[q], 16); wp[q] = we[q]; }
#pragma unroll
        for (int i = 0; i < 3; ++i) {
            const v4u xa = *(const LAS v4u*)(xb + (m + i) * 2048), xc = *(const LAS v4u*)(xb + (m + i) * 2048 + 1024);
            const unsigned X[8] = { xa.x, xa.y, xa.z, xa.w, xc.x, xc.y, xc.z, xc.w };
            unsigned me = 0xffffffffu, mo = 0xffffffffu;
            if (MASKED) { const int R0 = tg + 2 * i + 2 * m - 15; const int s0 = cv_seq(R0), s1 = cv_seq(R0 + 1);
                me = (s0 == sq[2 * i] ? 0xffffu : 0u) | (s1 == sq[2 * i] ? 0xffff0000u : 0u); mo = (s0 == sq[2 * i + 1] ? 0xffffu : 0u) | (s1 == sq[2 * i + 1] ? 0xffff0000u : 0u); }
#pragma unroll
            for (int q = 0; q < 8; ++q) { acc[2 * i][q] = cv_dot2(X[q], MASKED ? (we[q] & me) : we[q], acc[2 * i][q]); acc[2 * i + 1][q] = cv_dot2(X[q], MASKED ? (wo[q] & mo) : wo[q], acc[2 * i + 1][q]); } } }
}
__device__ __forceinline__ void p3_conv(Ctx& F) {
    constexpr int PROWS = 40, WIN_B = PROWS * 2048;
    LAS unsigned char* win = F.lds; LAS unsigned char* cwl = F.lds + WIN_B;
    { const float* cw_ = F.in(9); f32x4 w0[4], w1[4];
#pragma unroll
      for (int q = 0; q < 4; ++q) { const int it = F.tid + q * NTHR, m = it >> 7, i4 = it & 127; w0[q] = *(const GAS f32x4*)(cw_ + (size_t)(2 * m) * 512 + 4 * i4);
          if (m < 15) w1[q] = *(const GAS f32x4*)(cw_ + (size_t)(2 * m + 1) * 512 + 4 * i4); else { w1[q].x = 0.f; w1[q].y = 0.f; w1[q].z = 0.f; w1[q].w = 0.f; } }
#pragma unroll
      for (int q = 0; q < 4; ++q) { const int it = F.tid + q * NTHR, m = it >> 7, i4 = it & 127; v4u o; o.x = pk2(w0[q].x, w1[q].x); o.y = pk2(w0[q].y, w1[q].y); o.z = pk2(w0[q].z, w1[q].z); o.w = pk2(w0[q].w, w1[q].w);
          *(LAS v4u*)(cwl + m * 2048 + (i4 & 1) * 1024 + (i4 >> 1) * 16) = o; } }
    const bf16* AG = WSP(bf16, WS_AG); bf16* CAT = WSP(bf16, WS_R2);
    const int c0 = 8 * F.lane;
    float cb[8], lg[8], lb[8];
    { const float* p10 = F.in(10); const float* p11 = F.in(11); const float* p12 = F.in(12);
#pragma unroll
      for (int q = 0; q < 8; ++q) { cb[q] = p10[c0 + q]; lg[q] = p11[c0 + q]; lb[q] = p12[c0 + q]; } }
#pragma unroll 1
    for (int pass = 0; pass < 3; ++pass) { const int t0 = F.vcu * 144 + pass * 48, Rb = t0 - 15;
        { v4u ra[5], rb[5];
#pragma unroll
          for (int q = 0; q < 5; ++q) { const int idx = F.tid + q * NTHR; int R0 = Rb + 2 * (idx >> 6), R1 = R0 + 1; R0 = R0 < 0 ? 0 : (R0 > T - 1 ? T - 1 : R0); R1 = R1 < 0 ? 0 : (R1 > T - 1 ? T - 1 : R1);
              ra[q] = *(const GAS v4u*)(AG + (size_t)R0 * 512 + (idx & 63) * 8); rb[q] = *(const GAS v4u*)(AG + (size_t)R1 * 512 + (idx & 63) * 8); }
#pragma unroll
          for (int q = 0; q < 5; ++q) { const int idx = F.tid + q * NTHR; v4u o0, o1;
              o0.x = __builtin_amdgcn_perm(rb[q].x, ra[q].x, 0x05040100u); o0.y = __builtin_amdgcn_perm(rb[q].x, ra[q].x, 0x07060302u); o0.z = __builtin_amdgcn_perm(rb[q].y, ra[q].y, 0x05040100u); o0.w = __builtin_amdgcn_perm(rb[q].y, ra[q].y, 0x07060302u);
              o1.x = __builtin_amdgcn_perm(rb[q].z, ra[q].z, 0x05040100u); o1.y = __builtin_amdgcn_perm(rb[q].z, ra[q].z, 0x07060302u); o1.z = __builtin_amdgcn_perm(rb[q].w, ra[q].w, 0x05040100u); o1.w = __builtin_amdgcn_perm(rb[q].w, ra[q].w, 0x07060302u);
              LAS unsigned char* d = win + (idx >> 6) * 2048 + (idx & 63) * 16; *(LAS v4u*)d = o0; *(LAS v4u*)(d + 1024) = o1; } }
        __syncthreads();
        { const int tl = F.wave * 6, t = t0 + tl;
            int l, Ls; if (t < TL) { l = t & 2047; Ls = 2048; } else { l = (t - TL) & 255; Ls = 256; }
            int lo16 = 16 * F.lane; asm volatile("" : "+v"(lo16));
            float acc[6][8];
#pragma unroll
            for (int k = 0; k < 6; ++k)
#pragma unroll
                for (int q = 0; q < 8; ++q) acc[k][q] = cb[q];
            const LAS unsigned char* xb = win + (tl >> 1) * 2048 + lo16; const LAS unsigned char* wb = cwl + lo16;
            if (l >= 15 && l + 5 + 15 < Ls) cv_taps<false>(xb, wb, acc, t); else cv_taps<true>(xb, wb, acc, t);
            float st[12];
#pragma unroll
            for (int k = 0; k < 6; ++k) { float s1 = 0.f, s2 = 0.f;
#pragma unroll
                for (int q = 0; q < 8; ++q) { s1 += acc[k][q]; s2 += acc[k][q] * acc[k][q]; }
                st[2 * k] = s1; st[2 * k + 1] = s2; }
#pragma unroll
            for (int o = 1; o <= 16; o <<= 1) { float tt[12];
#pragma unroll
                for (int e = 0; e < 12; ++e) tt[e] = __builtin_bit_cast(float, swz_xor(__builtin_bit_cast(int, st[e]), o));
#pragma unroll
                for (int e = 0; e < 12; ++e) st[e] += tt[e]; }
#pragma unroll
            for (int e = 0; e < 12; ++e) { const int bits = __builtin_bit_cast(int, st[e]); st[e] = __builtin_bit_cast(float, __builtin_amdgcn_readlane(bits, 0)) + __builtin_bit_cast(float, __builtin_amdgcn_readlane(bits, 32)); }
#pragma unroll
            for (int k = 0; k < 6; ++k) { const float mu = st[2 * k] * (1.f / 512.f), var = fmaxf(st[2 * k + 1] * (1.f / 512.f) - mu * mu, 0.f), r = rsqrtf(var + EPS); float y[8];
#pragma unroll
                for (int q = 0; q < 8; ++q) { const float z = (acc[k][q] - mu) * r * lg[q] + lb[q]; y[q] = z * __builtin_amdgcn_rcpf(1.f + __builtin_amdgcn_exp2f(-1.4426950408889634f * z)); }
                v4u o; o.x = pk2(y[0], y[1]); o.y = pk2(y[2], y[3]); o.z = pk2(y[4], y[5]); o.w = pk2(y[6], y[7]);
                *(GAS v4u*)(CAT + (size_t)(t + k) * 1024 + c0) = o; } }
        __syncthreads(); }
}
typedef float f32x2 __attribute__((ext_vector_type(2)));
__device__ __forceinline__ void p3_dft1(Ctx& F, int v, int g) {
    LAS float* tw = (LAS float*)F.lds;
    for (int i = F.tid; i < 2048; i += NTHR) { float sn, cs; sincospif(2.f * (float)i / 2048.f, &sn, &cs); tw[i] = cs; }
    __syncthreads();
    const bf16* YT = WSP(bf16, WS_YT); bf16* AP = WSP(bf16, WS_AP);
#pragma unroll 1
    for (int it = v * NTHR + F.tid; it < 8192 * 32; it += g * NTHR) { const int c = it >> 5, l2 = (it & 31) * 8;
        f32x2 yr[8][4], ys[8][4];
#pragma unroll
        for (int l1 = 0; l1 < 8; ++l1) { const v4u a = __builtin_nontemporal_load((const GAS v4u*)(YT + (size_t)c * 4096 + 256 * l1 + l2)), b = __builtin_nontemporal_load((const GAS v4u*)(YT + (size_t)c * 4096 + 2048 + 256 * l1 + l2));
            yr[l1][0] = (f32x2){__builtin_bit_cast(float, a.x << 16), __builtin_bit_cast(float, a.x & 0xffff0000u)}; yr[l1][1] = (f32x2){__builtin_bit_cast(float, a.y << 16), __builtin_bit_cast(float, a.y & 0xffff0000u)};
            yr[l1][2] = (f32x2){__builtin_bit_cast(float, a.z << 16), __builtin_bit_cast(float, a.z & 0xffff0000u)}; yr[l1][3] = (f32x2){__builtin_bit_cast(float, a.w << 16), __builtin_bit_cast(float, a.w & 0xffff0000u)};
            ys[l1][0] = (f32x2){__builtin_bit_cast(float, b.x << 16), __builtin_bit_cast(float, b.x & 0xffff0000u)}; ys[l1][1] = (f32x2){__builtin_bit_cast(float, b.y << 16), __builtin_bit_cast(float, b.y & 0xffff0000u)};
            ys[l1][2] = (f32x2){__builtin_bit_cast(float, b.z << 16), __builtin_bit_cast(float, b.z & 0xffff0000u)}; ys[l1][3] = (f32x2){__builtin_bit_cast(float, b.w << 16), __builtin_bit_cast(float, b.w & 0xffff0000u)}; }
#pragma unroll 1
        for (int k1 = 0; k1 < 8; ++k1) { f32x2 ar[4], ai[4];
#pragma unroll
            for (int j = 0; j < 4; ++j) { ar[j] = (f32x2){0.f, 0.f}; ai[j] = (f32x2){0.f, 0.f}; }
#pragma unroll
            for (int l1 = 0; l1 < 8; ++l1) { const int p8 = ((k1 * l1) & 7) * 256; const float cc = tw[p8], ss = tw[(p8 + 1536) & 2047];
                const f32x2 c2 = {cc, cc}, s2 = {ss, ss}, ns2 = {-ss, -ss}, nc2 = {-cc, -cc};
#pragma unroll
                for (int j = 0; j < 4; ++j) { ar[j] = __builtin_elementwise_fma(yr[l1][j], c2, ar[j]); ar[j] = __builtin_elementwise_fma(ys[l1][j], ns2, ar[j]);
                    ai[j] = __builtin_elementwise_fma(ys[l1][j], nc2, ai[j]); ai[j] = __builtin_elementwise_fma(yr[l1][j], ns2, ai[j]); } }
            float re[8], im[8];
#pragma unroll
            for (int j = 0; j < 8; ++j) { const int q = k1 * (l2 + j); const float ct = tw[q], st = tw[(q + 1536) & 2047];
                const float arj = (j & 1) ? ar[j >> 1].y : ar[j >> 1].x, aij = (j & 1) ? ai[j >> 1].y : ai[j >> 1].x;
                re[j] = arj * ct + aij * st; im[j] = aij * ct - arj * st; }
            bf16* dst = AP + ((size_t)(k1 * 8192 + c)) * 512 + l2;
            v4u o; o.x = pk2(re[0], re[1]); o.y = pk2(re[2], re[3]); o.z = pk2(re[4], re[5]); o.w = pk2(re[6], re[7]); *(GAS v4u*)dst = o;
            o.x = pk2(im[0], im[1]); o.y = pk2(im[2], im[3]); o.z = pk2(im[4], im[5]); o.w = pk2(im[6], im[7]); *(GAS v4u*)(dst + 256) = o; } }
    __syncthreads();
}
__device__ __forceinline__ void m1_route(Ctx& F, int ly, int nrows) {
    LAS float* wr = (LAS float*)F.lds;
    { const float* wr_ = F.in(20) + (size_t)ly * 16384; f32x4 wv[8];
#pragma unroll
      for (int q = 0; q < 8; ++q) wv[q] = *(const GAS f32x4*)(wr_ + 4 * (F.tid + q * NTHR));
#pragma unroll
      for (int q = 0; q < 8; ++q) { const int i4 = F.tid + q * NTHR, k = i4 >> 2, e0 = (i4 & 3) * 4; LAS float* d = wr + e0 * 1024 + k; d[0] = wv[q].x; d[1024] = wv[q].y; d[2048] = wv[q].z; d[3072] = wv[q].w; } }
    __syncthreads();
    const float* MODS = WSP(float, WS_MODS) + (size_t)ly * 17 * 6144; const float* n2g = F.in(7) + ly * D;
    const int per = nrows / F.NGW, t0 = F.gw * per;
    ModC mc; mc.mr = -1;
    const bool useY = true, l0 = ly == 0;
#define M1_SRC(t_) (l0 ? xin_row(F, (t_)) : (const float*)xrow(F, (t_)))
#define M1_Y(t_) (l0 ? y_row(F, (t_)) : (const bf16*)WSP(bf16, WS_Y1) + (size_t)(t_) * D)
    f32x4 nx0[4], nx1[4]; u32x2v ny0[4], ny1[4]; load_row(M1_SRC(t0), F.lane, nx0); load_row(M1_SRC(t0 + 1), F.lane, nx1);
    if (useY) { load_rowY(M1_Y(t0), F.lane, ny0); load_rowY(M1_Y(t0 + 1), F.lane, ny1); }
#pragma unroll 1
    for (int i = 0; i < per; i += 2) { const int t = t0 + i;
        f32x4 v0[4], v1[4];
#pragma unroll
        for (int j = 0; j < 4; ++j) { v0[j] = nx0[j]; v1[j] = nx1[j]; }
        if (useY) { add_rowY(v0, ny0); add_rowY(v1, ny1); }
        if (i + 2 < per) { load_row(M1_SRC(t + 2), F.lane, nx0); load_row(M1_SRC(t + 3), F.lane, nx1);
            if (useY) { load_rowY(M1_Y(t + 2), F.lane, ny0); load_rowY(M1_Y(t + 3), F.lane, ny1); } }
        const int mr = mod_row(t); if (mr != mc.mr) modc_set(mc, mr, n2g, MODS, 3, 4, F.lane);
        const float r0 = rsqrtf(row_ss(v0) * (1.f / D) + EPS), r1 = rsqrtf(row_ss(v1) * (1.f / D) + EPS);
#pragma unroll
        for (int j = 0; j < 4; ++j) { v0[j] = v0[j] * r0 * mc.A[j] + mc.B[j]; v1[j] = v1[j] * r1 * mc.A[j] + mc.B[j]; }
        store_row_bf16(WSP(bf16, WS_UW) + (size_t)t * D, F.lane, v0); store_row_bf16(WSP(bf16, WS_UW) + (size_t)(t + 1) * D, F.lane, v1);
        float lg[32];
#pragma unroll
        for (int e = 0; e < 16; ++e) { f32x2 a0 = {0.f, 0.f}, a1 = {0.f, 0.f};
#pragma unroll
            for (int j = 0; j < 4; ++j) { const f32x4 w = *(const LAS f32x4*)(wr + e * 1024 + 256 * j + 4 * F.lane);
                a0 = __builtin_elementwise_fma(v0[j].xy, w.xy, a0); a0 = __builtin_elementwise_fma(v0[j].zw, w.zw, a0);
                a1 = __builtin_elementwise_fma(v1[j].xy, w.xy, a1); a1 = __builtin_elementwise_fma(v1[j].zw, w.zw, a1); }
            lg[e] = a0.x + a0.y; lg[16 + e] = a1.x + a1.y; }
        float h[16];
#pragma unroll
        for (int e = 0; e < 16; ++e) { float a_ = lg[e], b_ = lg[16 + e];
            asm volatile("s_nop 1\n\tv_permlane32_swap_b32 %0, %1" : "+v"(a_), "+v"(b_)); h[e] = a_ + b_; }
#define RS_STEP(N, S) _Pragma("unroll") for (int q = 0; q < (N); ++q) { const bool up = (F.lane >> (S)) & 1; const float keep = up ? h[q + (N)] : h[q], send = up ? h[q] : h[q + (N)]; \
            h[q] = keep + __builtin_bit_cast(float, swz_xor(__builtin_bit_cast(int, send), 1 << (S))); }
        RS_STEP(8, 3) RS_STEP(4, 2) RS_STEP(2, 1) RS_STEP(1, 0)
#undef RS_STEP
        float lgt = h[0]; lgt += __builtin_bit_cast(float, swz_xor(__builtin_bit_cast(int, lgt), 16));
        float mx = lgt;
#pragma unroll
        for (int o = 1; o <= 8; o <<= 1) mx = fmaxf(mx, __builtin_bit_cast(float, swz_xor(__builtin_bit_cast(int, mx), o)));
        const float pe = __expf(lgt - mx); float sum = pe;
#pragma unroll
        for (int o = 1; o <= 8; o <<= 1) sum += __builtin_bit_cast(float, swz_xor(__builtin_bit_cast(int, sum), o));
        if ((F.lane & 16) == 0) { const size_t o_ = (size_t)(t + (F.lane >> 5)) * 16 + (F.lane & 15); WSP(float, WS_AFF)[o_] = pe / sum; WSP(int, WS_INV)[o_] = -1; } }
#undef M1_SRC
#undef M1_Y
    __syncthreads();
}
__device__ __forceinline__ void m2_unit(Ctx& F, int unit) {
    LAS int* cntw = (LAS int*)F.lds;
    LAS int* wtot = (LAS int*)(F.lds + 256);
    const bool isc = unit >= 256; const int u2 = isc ? unit - 256 : unit, b = u2 >> 4, e = u2 & 15;
    const int Ls = isc ? 256 : 2048, cap = isc ? 32 : 256, tb = isc ? TL + b * 256 : b * 2048, rowbase = e * ER + (isc ? 4096 + b * 32 : b * 256);
    const float* AFF = WSP(float, WS_AFF);
    unsigned v[4];
#pragma unroll
    for (int i = 0; i < 4; ++i) { const int tok = i * NTHR + F.tid; v[i] = tok < Ls ? __builtin_bit_cast(unsigned, AFF[(size_t)(tb + tok) * 16 + e]) : 0u; }
    unsigned lo = 0u;
    for (int b0 = 28; b0 >= 0; b0 -= 2) { const unsigned c1 = lo | (1u << b0), c2 = lo | (2u << b0), c3 = lo | (3u << b0); const int par = (b0 >> 1) & 1;
        const int n1 = __popcll(__ballot(v[0] >= c1)) + __popcll(__ballot(v[1] >= c1)) + __popcll(__ballot(v[2] >= c1)) + __popcll(__ballot(v[3] >= c1));
        const int n2 = __popcll(__ballot(v[0] >= c2)) + __popcll(__ballot(v[1] >= c2)) + __popcll(__ballot(v[2] >= c2)) + __popcll(__ballot(v[3] >= c2));
        const int n3 = __popcll(__ballot(v[0] >= c3)) + __popcll(__ballot(v[1] >= c3)) + __popcll(__ballot(v[2] >= c3)) + __popcll(__ballot(v[3] >= c3));
        if (F.lane == 0) { LAS int* d = cntw + par * 32 + F.wave * 4; d[0] = n1; d[1] = n2; d[2] = n3; }
        __syncthreads();
        int t1 = 0, t2 = 0, t3 = 0;
#pragma unroll
        for (int w = 0; w < 8; ++w) { const LAS int* d = cntw + par * 32 + w * 4; t1 += d[0]; t2 += d[1]; t3 += d[2]; }
        lo = t3 >= cap ? c3 : (t2 >= cap ? c2 : (t1 >= cap ? c1 : lo)); }
    int pg[4], pq[4];
#pragma unroll
    for (int i = 0; i < 4; ++i) { const unsigned long long bg = __ballot(v[i] > lo), bq = __ballot(v[i] == lo && lo != 0u);
        pg[i] = __builtin_amdgcn_mbcnt_hi((unsigned)(bg >> 32), __builtin_amdgcn_mbcnt_lo((unsigned)bg, 0u));
        pq[i] = __builtin_amdgcn_mbcnt_hi((unsigned)(bq >> 32), __builtin_amdgcn_mbcnt_lo((unsigned)bq, 0u));
        if (F.lane == 0) wtot[i * 8 + F.wave] = __popcll(bg) | (__popcll(bq) << 16); }
    __syncthreads();
    int total = 0, base[4];
#pragma unroll
    for (int i = 0; i < 4; ++i)
#pragma unroll
        for (int w = 0; w < 8; ++w) { if (w == 0) base[i] = 0; const int x = wtot[i * 8 + w]; if (w == F.wave) base[i] = total; total += x; }
    const int ngt = total & 0xffff, need = cap - ngt;
#pragma unroll
    for (int i = 0; i < 4; ++i) { const int tok = i * NTHR + F.tid; int slot = -1;
        if (v[i] > lo) slot = (base[i] & 0xffff) + pg[i]; else if (v[i] == lo && lo != 0u) { const int qr = (base[i] >> 16) + pq[i]; if (qr < need) slot = ngt + qr; }
        if (slot >= 0) { WSP(int, WS_AROW)[rowbase + slot] = tb + tok; WSP(float, WS_GATE)[rowbase + slot] = __builtin_bit_cast(float, v[i]); WSP(int, WS_INV)[(size_t)(tb + tok) * 16 + e] = rowbase + slot; } }
    __syncthreads();
}
__device__ __forceinline__ void combine_row(Ctx& F, int myinv, const f32x4 (&G2c)[4], f32x4 (&v)[4]) {
    f32x4 a[4];
#pragma unroll
    for (int j = 0; j < 4; ++j) a[j] = (f32x4){0.f, 0.f, 0.f, 0.f};
    const bf16* YB = WSP(bf16, WS_R1);
    unsigned long long m = __ballot(myinv >= 0);
    while (m) { int rr[4]; u32x2v y[4][4];
#pragma unroll
        for (int h = 0; h < 4; ++h) { if (m) { const int l = __builtin_ctzll(m); rr[h] = __builtin_amdgcn_readlane(myinv, l); m &= m - 1; } else rr[h] = -1; }
#pragma unroll
        for (int h = 0; h < 4; ++h) if (rr[h] >= 0) { const GAS u32x2v* yr = (const GAS u32x2v*)(YB + (size_t)rr[h] * D) + F.lane;
#pragma unroll
                for (int j = 0; j < 4; ++j) y[h][j] = __builtin_nontemporal_load(yr + 64 * j); }
#pragma unroll
        for (int h = 0; h < 4; ++h) if (rr[h] >= 0) {
#pragma unroll
                for (int j = 0; j < 4; ++j) { const u32x2v w = y[h][j];
                    a[j].x += __builtin_bit_cast(float, w.x << 16); a[j].y += __builtin_bit_cast(float, w.x & 0xffff0000u);
                    a[j].z += __builtin_bit_cast(float, w.y << 16); a[j].w += __builtin_bit_cast(float, w.y & 0xffff0000u); } } }
#pragma unroll
    for (int j = 0; j < 4; ++j) v[j] = v[j] + G2c[j] * a[j];
}
__device__ __forceinline__ void store_row_f32(float* p, int lane, const f32x4 (&v)[4]) {
    GAS f32x4* o = (GAS f32x4*)p + lane;
#pragma unroll
    for (int j = 0; j < 4; ++j) o[64 * j] = v[j];
}
constexpr int MW_SPLIT = 0, MW1_G5 = 10240;
__device__ __forceinline__ void a0_combine(Ctx& F, bool dry = false) {
    const float* MODS0 = WSP(float, WS_MODS); const float* MODS1 = MODS0 + (size_t)17 * 6144; const float* n1g = F.in(6) + D; const int* INV = WSP(int, WS_INV);
    ModC mc; mc.mr = -1; f32x4 G2c[4]; const int t0 = F.gw * 18;
    f32x4 nx[4]; u32x2v ny[4]; load_row(xin_row(F, t0), F.lane, nx); load_rowY(y_row(F, t0), F.lane, ny); int inv_n = F.lane < 16 ? INV[(size_t)t0 * 16 + F.lane] : -1;
#pragma unroll 1
    for (int i = 0; i < 18; ++i) { const int t = t0 + i;
        f32x4 v[4];
#pragma unroll
        for (int j = 0; j < 4; ++j) v[j] = nx[j];
        add_rowY(v, ny);
        const int myinv = inv_n;
        if (i < 17) { load_row(xin_row(F, t + 1), F.lane, nx); load_rowY(y_row(F, t + 1), F.lane, ny); inv_n = F.lane < 16 ? INV[(size_t)(t + 1) * 16 + F.lane] : -1; }
        const int mr = mod_row(t); if (mr != mc.mr) { modc_set(mc, mr, n1g, MODS1, 0, 1, F.lane);
#pragma unroll
            for (int j = 0; j < 4; ++j) G2c[j] = *(const GAS f32x4*)(MODS0 + (size_t)mr * 6144 + 5 * 1024 + 4 * F.lane + 256 * j); }
        combine_row(F, myinv, G2c, v);
        if (dry || t < TL) store_row_f32(dry ? WSP(float, WS_R2) + (size_t)t * D : xrow(F, t), F.lane, v);
        const float rstd = rsqrtf(row_ss(v) * (1.f / D) + EPS);
#pragma unroll
        for (int j = 0; j < 4; ++j) v[j] = v[j] * rstd * mc.A[j] + mc.B[j];
        store_row_bf16(dry ? WSP(bf16, WS_R2) + (size_t)t * D : WSP(bf16, WS_UW) + (size_t)t * D, F.lane, v); }
    LAS float* scr = (LAS float*)(F.lds + F.wave * 8448);
    moe_w_items(F, 1, scr, 0, MW_SPLIT);
}
__device__ __forceinline__ void p_final(Ctx& F, bool dry = false, float cofs = 0.f) {
    const float* fg = F.in(24); const float* MODS1 = WSP(float, WS_MODS) + (size_t)17 * 6144; const int* INV = WSP(int, WS_INV);
    f32x4 FG[4], G2c[4]; int cmr = -1;
#pragma unroll
    for (int j = 0; j < 4; ++j) FG[j] = *(const GAS f32x4*)(fg + 4 * F.lane + 256 * j);
    const int t0 = F.gw * 16;
    const bf16* Y1 = WSP(bf16, WS_Y1);
    f32x4 nx[4]; u32x2v ny[4]; load_row(F.out + (size_t)t0 * D, F.lane, nx); load_rowY(Y1 + (size_t)t0 * D, F.lane, ny); int inv_n = F.lane < 16 ? INV[(size_t)t0 * 16 + F.lane] : -1;
#pragma unroll 1
    for (int i = 0; i < 16; ++i) { const int t = t0 + i;
        f32x4 v[4];
#pragma unroll
        for (int j = 0; j < 4; ++j) v[j] = nx[j];
        add_rowY(v, ny);
        const int myinv = inv_n;
        if (i < 15) { load_row(F.out + (size_t)(t + 1) * D, F.lane, nx); load_rowY(Y1 + (size_t)(t + 1) * D, F.lane, ny); inv_n = F.lane < 16 ? INV[(size_t)(t + 1) * 16 + F.lane] : -1; }
        const int mr = t >> 11; if (mr != cmr) { cmr = mr;
#pragma unroll
            for (int j = 0; j < 4; ++j) G2c[j] = *(const GAS f32x4*)(MODS1 + (size_t)mr * 6144 + 5 * 1024 + 4 * F.lane + 256 * j); }
        combine_row(F, myinv, G2c, v);
        const float rstd = rsqrtf(row_ss(v) * (1.f / D) + EPS);
#pragma unroll
        for (int j = 0; j < 4; ++j) v[j] = v[j] * rstd * FG[j] + cofs;
        store_row_f32(dry ? WSP(float, WS_R2) + (size_t)t * D : F.out + (size_t)t * D, F.lane, v); }
}
__device__ __forceinline__ void a1_lowrank(Ctx& F, int tbeg, int nrow) {
    const bf16* CQKV = WSP(bf16, WS_CQKV);
    const int col = F.lane < 52 ? 8 * F.lane : 0;
    float g8[8];
    { const float* qg = F.in(15); const float* kvg = F.in(16);
#pragma unroll
      for (int q = 0; q < 8; ++q) g8[q] = F.lane < 32 ? qg[8 * F.lane + q] : (F.lane < 48 ? kvg[8 * (F.lane - 32) + q] : 1.f); }
#pragma unroll 1
    for (int i0 = 0; i0 < nrow; i0 += 8) { v4u rawb[8]; f32x4 rta[8], rtb[8];
#pragma unroll
        for (int r = 0; r < 8; ++r) { const int t_ = tbeg + i0 + r; rawb[r] = __builtin_nontemporal_load((const GAS v4u*)(CQKV + (size_t)t_ * 512 + col));
            const float* rt_ = WSP(float, WS_ROPE) + (size_t)(t_ < TL ? (t_ & 2047) : 0) * 32 + 8 * ((F.lane - 48) & 3); rta[r] = *(const GAS f32x4*)rt_; rtb[r] = *(const GAS f32x4*)(rt_ + 4); }
        float sq8[8], skv8[8];
#pragma unroll
        for (int r = 0; r < 8; ++r) { const v4u raw = rawb[r]; float ss = 0.f, xx;
            xx = __builtin_bit_cast(float, raw.x << 16); ss += xx * xx; xx = __builtin_bit_cast(float, raw.x & 0xffff0000u); ss += xx * xx; xx = __builtin_bit_cast(float, raw.y << 16); ss += xx * xx; xx = __builtin_bit_cast(float, raw.y & 0xffff0000u); ss += xx * xx;
            xx = __builtin_bit_cast(float, raw.z << 16); ss += xx * xx; xx = __builtin_bit_cast(float, raw.z & 0xffff0000u); ss += xx * xx; xx = __builtin_bit_cast(float, raw.w << 16); ss += xx * xx; xx = __builtin_bit_cast(float, raw.w & 0xffff0000u); ss += xx * xx;
            sq8[r] = F.lane < 32 ? ss : 0.f; skv8[r] = (F.lane >= 32 && F.lane < 48) ? ss : 0.f; }
#pragma unroll
        for (int o = 1; o <= 16; o <<= 1) { float ta[8], tb[8];
#pragma unroll
            for (int r = 0; r < 8; ++r) { ta[r] = __builtin_bit_cast(float, swz_xor(__builtin_bit_cast(int, sq8[r]), o)); tb[r] = __builtin_bit_cast(float, swz_xor(__builtin_bit_cast(int, skv8[r]), o)); }
#pragma unroll
            for (int r = 0; r < 8; ++r) { sq8[r] += ta[r]; skv8[r] += tb[r]; } }
#pragma unroll
        for (int r = 0; r < 8; ++r) { const int t = tbeg + i0 + r; const v4u raw = rawb[r];
            float x[8]; x[0] = __builtin_bit_cast(float, raw.x << 16); x[1] = __builtin_bit_cast(float, raw.x & 0xffff0000u); x[2] = __builtin_bit_cast(float, raw.y << 16); x[3] = __builtin_bit_cast(float, raw.y & 0xffff0000u);
            x[4] = __builtin_bit_cast(float, raw.z << 16); x[5] = __builtin_bit_cast(float, raw.z & 0xffff0000u); x[6] = __builtin_bit_cast(float, raw.w << 16); x[7] = __builtin_bit_cast(float, raw.w & 0xffff0000u);
            const int bq = __builtin_bit_cast(int, sq8[r]), bk = __builtin_bit_cast(int, skv8[r]);
            const float sq = __builtin_bit_cast(float, __builtin_amdgcn_readlane(bq, 0)) + __builtin_bit_cast(float, __builtin_amdgcn_readlane(bq, 32));
            const float skv = __builtin_bit_cast(float, __builtin_amdgcn_readlane(bk, 0)) + __builtin_bit_cast(float, __builtin_amdgcn_readlane(bk, 32));
            const float rq = rsqrtf(sq * (1.f / 256.f) + EPS), rkv = rsqrtf(skv * (1.f / 128.f) + EPS);
            if (F.lane < 32) { if (t < TL) { float y[8];
#pragma unroll
                    for (int q = 0; q < 8; ++q) y[q] = x[q] * rq * g8[q];
                    v4u o; o.x = pk2(y[0], y[1]); o.y = pk2(y[2], y[3]); o.z = pk2(y[4], y[5]); o.w = pk2(y[6], y[7]);
                    *(GAS v4u*)(WSP(bf16, WS_CQN) + (size_t)t * 256 + 8 * F.lane) = o; } }
            else if (F.lane < 48) { float y[8];
#pragma unroll
                for (int q = 0; q < 8; ++q) y[q] = x[q] * rkv * g8[q];
                v4u o; o.x = pk2(y[0], y[1]); o.y = pk2(y[2], y[3]); o.z = pk2(y[4], y[5]); o.w = pk2(y[6], y[7]);
                *(GAS v4u*)(WSP(bf16, WS_CKVN) + (size_t)t * 128 + 8 * (F.lane - 32)) = o; }
            else {
                if (F.lane < 52) { int b, key; float y[8];
                    if (t < TL) { b = t >> 11; const int l = t & 2047; key = 256 + l; const float rt[8] = {rta[r][0], rta[r][1], rta[r][2], rta[r][3], rtb[r][0], rtb[r][1], rtb[r][2], rtb[r][3]};
#pragma unroll
                        for (int p = 0; p < 4; ++p) { const float c = rt[2 * p], s = rt[2 * p + 1]; y[2 * p] = x[2 * p] * c - x[2 * p + 1] * s; y[2 * p + 1] = x[2 * p] * s + x[2 * p + 1] * c; } }
                    else { b = (t - TL) >> 8; key = (t - TL) & 255;
#pragma unroll
                        for (int q = 0; q < 8; ++q) y[q] = x[q]; }
                    v4u o; o.x = pk2(y[0], y[1]); o.y = pk2(y[2], y[3]); o.z = pk2(y[4], y[5]); o.w = pk2(y[6], y[7]);
                    *(GAS v4u*)(WSP(bf16, WS_KR) + ((size_t)b * 2304 + key) * 32 + 8 * (F.lane - 48)) = o; } } } }
}
}
namespace fp {
__device__ __forceinline__ float fsig(float g) { return __builtin_amdgcn_rcpf(1.f + __builtin_amdgcn_exp2f(-1.4426950408889634f * g)); }
__device__ __forceinline__ u32x4 pack8(const f32x4& a, const f32x4& b) { u32x4 w; w.x = cvt_pk_bf16(a[0], a[1]); w.y = cvt_pk_bf16(a[2], a[3]); w.z = cvt_pk_bf16(b[0], b[1]); w.w = cvt_pk_bf16(b[2], b[3]); return w; }
typedef pg8::f32x4 A4;
#define EPI_ARGS const A4 (&acc)[2][2][4][2], const Unit& u, int wr, int wc, int fr, int fq
struct EpiG1 { static constexpr bool PERM = true, AFTER_DRAIN = false; bf16* AG; bf16* YT; bf16* YTC;
    __device__ __forceinline__ void operator()(EPI_ARGS) const {
        if (u.pm < 144) { const int row0 = u.pm * 256 + wr * 64 + fr, col0 = (u.pn - 148) * 128 + wc * 32 + 8 * fq;
#pragma unroll
            for (int ai = 0; ai < 2; ++ai)
#pragma unroll
                for (int m = 0; m < 4; ++m) { A4 a[2];
#pragma unroll
                    for (int n = 0; n < 2; ++n) { const A4 v = acc[ai][0][m][n], g = acc[ai][1][m][n];
#pragma unroll
                        for (int i = 0; i < 4; ++i) a[n][i] = v[i] * fsig(g[i]); }
                    *(u32x4*)(AG + (size_t)(row0 + ai * 128 + m * 16) * 512 + col0) = pack8(a[0], a[1]); }
        } else { const int r0 = (u.pm - 144) * 256 + wr * 64 + fr, tk0 = u.pn * 256 + wc * 32 + 8 * fq;
#pragma unroll
            for (int ai = 0; ai < 2; ++ai)
#pragma unroll
                for (int m = 0; m < 4; ++m) { const int r = r0 + ai * 128 + m * 16, half = r >> 9, ncol = r & 511;
#pragma unroll
                    for (int bj = 0; bj < 2; ++bj) { const int tk = tk0 + bj * 128; bf16* p;
                        if (u.pn < 128) { const int b = u.pn >> 3, l = tk - b * 2048; p = YT + ((size_t)(b * 512 + ncol) * 4096 + half * 2048 + l); }
                        else { const int tkc = tk - TL, b = tkc >> 8, l = tkc & 255; p = YTC + ((size_t)(b * 512 + ncol) * 512 + half * 256 + l); }
                        *(u32x4*)p = pack8(acc[ai][bj][m][0], acc[ai][bj][m][1]); } } }
    } };
struct EpiF { static constexpr bool PERM = true, AFTER_DRAIN = false; bf16* CAT; int rows_per_b, tokbase;
    __device__ __forceinline__ void operator()(EPI_ARGS) const {
        const int k0 = u.pm * 256 + wr * 64 + fr, c0 = u.pn * 256 + wc * 32 + 8 * fq;
#pragma unroll
        for (int bj = 0; bj < 2; ++bj) { const int c = c0 + bj * 128, b = c >> 9, n = c & 511; bf16* colp = CAT + (size_t)(tokbase + b * rows_per_b) * 1024 + 512 + n;
#pragma unroll
            for (int ai = 0; ai < 2; ++ai)
#pragma unroll
                for (int m = 0; m < 4; ++m) *(u32x4*)(colp + (size_t)(k0 + ai * 128 + m * 16) * 1024) = pack8(acc[ai][bj][m][0], acc[ai][bj][m][1]); }
    } };
struct EpiF2 { static constexpr bool PERM = true, AFTER_DRAIN = false; bf16* CAT;
    __device__ __forceinline__ void operator()(EPI_ARGS) const {
        const int k20 = wr * 64 + fr, nn0 = u.pn * 256 + wc * 32 + 8 * fq;
#pragma unroll
        for (int bj = 0; bj < 2; ++bj) { const int nn = nn0 + bj * 128, k1 = nn >> 13, c = nn & 8191, b = c >> 9, n = c & 511; bf16* colp = CAT + ((size_t)b * 2048 + k1) * 1024 + 512 + n;
#pragma unroll
            for (int ai = 0; ai < 2; ++ai)
#pragma unroll
                for (int m = 0; m < 4; ++m) *(u32x4*)(colp + (size_t)(k20 + ai * 128 + m * 16) * 8 * 1024) = pack8(acc[ai][bj][m][0], acc[ai][bj][m][1]); }
    } };
struct EpiRes { static constexpr bool PERM = false, AFTER_DRAIN = false; const float* base_lat; const float* base_ctx; float* out_lat; float* out_ctx; const float* gates  ;
    __device__ __forceinline__ void operator()(EPI_ARGS) const {
        const int trow = u.pm * 256; const bool isc = trow >= TL; const int mr = isc ? 16 : (trow >> 11);
        const float* bp = isc ? base_ctx + (size_t)(trow - TL) * D : base_lat + (size_t)trow * D; float* op = isc ? out_ctx + (size_t)(trow - TL) * D : out_lat + (size_t)trow * D;
        const int col0 = u.pn * 256 + wc * 32 + 4 * fq; const float* gp = gates + (size_t)mr * 6144 + col0;
        A4 gv[2][2];
#pragma unroll
        for (int bj = 0; bj < 2; ++bj)
#pragma unroll
            for (int n = 0; n < 2; ++n) gv[bj][n] = *(const A4*)(gp + bj * 128 + n * 16);
        A4 pre[4][2][2];
#define RES_LOAD(g_) do { const size_t off_ = (size_t)(wr * 64 + fr + ((g_) >> 2) * 128 + ((g_) & 3) * 16) * D + col0; \
            _Pragma("unroll") for (int bj = 0; bj < 2; ++bj) _Pragma("unroll") for (int n = 0; n < 2; ++n) pre[(g_) & 3][bj][n] = *(const A4*)(bp + off_ + bj * 128 + n * 16); } while (0)
        RES_LOAD(0); RES_LOAD(1); RES_LOAD(2); RES_LOAD(3);
#pragma unroll
        for (int g = 0; g < 8; ++g) { const int ai = g >> 2, m = g & 3; const size_t off = (size_t)(wr * 64 + fr + ai * 128 + m * 16) * D + col0;
#pragma unroll
            for (int bj = 0; bj < 2; ++bj)
#pragma unroll
                for (int n = 0; n < 2; ++n) *(A4*)(op + off + bj * 128 + n * 16) = pre[g & 3][bj][n] + gv[bj][n] * acc[ai][bj][m][n];
            if (g + 4 < 8) RES_LOAD(g + 4);
            asm volatile("" ::: "memory"); }
#undef RES_LOAD
    } };
struct EpiSwiglu { static constexpr bool PERM = true, AFTER_DRAIN = false; bf16* HID;
    __device__ __forceinline__ void operator()(EPI_ARGS) const {
        const int row0 = u.pm * 256 + wr * 64 + fr, col0 = (u.pn & 7) * 128 + wc * 32 + 8 * fq;
#pragma unroll
        for (int ai = 0; ai < 2; ++ai)
#pragma unroll
            for (int m = 0; m < 4; ++m) { A4 a[2];
#pragma unroll
                for (int n = 0; n < 2; ++n) { const A4 v = acc[ai][0][m][n], g = acc[ai][1][m][n];
#pragma unroll
                    for (int i = 0; i < 4; ++i) a[n][i] = v[i] * fsig(v[i]) * g[i]; }
                __builtin_nontemporal_store(pack8(a[0], a[1]), (GAS u32x4*)(HID + (size_t)(row0 + ai * 128 + m * 16) * 1024 + col0)); }
    } };
struct EpiGate { static constexpr bool PERM = true, AFTER_DRAIN = false; bf16* YB; const float* GATE;
    __device__ __forceinline__ void operator()(EPI_ARGS) const {
        const int row0 = u.pm * 256 + wr * 64 + fr, col0 = (u.pn & 3) * 256 + wc * 32 + 8 * fq;
        float gts[8];
#pragma unroll
        for (int g = 0; g < 8; ++g) gts[g] = GATE[row0 + (g >> 2) * 128 + (g & 3) * 16];
#pragma unroll
        for (int ai = 0; ai < 2; ++ai)
#pragma unroll
            for (int m = 0; m < 4; ++m) { const int row = row0 + ai * 128 + m * 16; const float gt = gts[ai * 4 + m]; bf16* rowp = YB + (size_t)row * 1024 + col0;
#pragma unroll
                for (int bj = 0; bj < 2; ++bj) *(GAS u32x4*)(rowp + bj * 128) = pack8(acc[ai][bj][m][0] * gt, acc[ai][bj][m][1] * gt); }
    } };
struct EpiPlain { static constexpr bool PERM = true, AFTER_DRAIN = false; bf16* O; int ldc;
    __device__ __forceinline__ void operator()(EPI_ARGS) const {
        const int row0 = u.pm * 256 + wr * 64 + fr, col0 = u.pn * 256 + wc * 32 + 8 * fq;
#pragma unroll
        for (int ai = 0; ai < 2; ++ai)
#pragma unroll
            for (int m = 0; m < 4; ++m) { bf16* rowp = O + (size_t)(row0 + ai * 128 + m * 16) * ldc + col0;
#pragma unroll
                for (int bj = 0; bj < 2; ++bj) *(u32x4*)(rowp + bj * 128) = pack8(acc[ai][bj][m][0], acc[ai][bj][m][1]); }
    } };
struct EpiY { static constexpr bool PERM = true, AFTER_DRAIN = false; bf16* ylat; bf16* yctx; int pitch; const float* gates  ;
    __device__ __forceinline__ void operator()(EPI_ARGS) const {
        const int trow = u.pm * 256, mr = trow >= TL ? 16 : (trow >> 11);
        const int row0 = trow + wr * 64 + fr, col0 = u.pn * 256 + wc * 32 + 8 * fq; const float* gp = gates + (size_t)mr * 6144 + col0;
        bf16* Y = trow >= TL ? yctx - (size_t)TL * pitch : ylat;
        A4 gv[2][2];
#pragma unroll
        for (int bj = 0; bj < 2; ++bj)
#pragma unroll
            for (int n = 0; n < 2; ++n) gv[bj][n] = *(const GAS A4*)(gp + bj * 128 + n * 4);
#pragma unroll
        for (int ai = 0; ai < 2; ++ai)
#pragma unroll
            for (int m = 0; m < 4; ++m) { bf16* rowp = Y + (size_t)(row0 + ai * 128 + m * 16) * pitch + col0;
#pragma unroll
                for (int bj = 0; bj < 2; ++bj) *(GAS u32x4*)(rowp + bj * 128) = pack8(gv[bj][0] * acc[ai][bj][m][0], gv[bj][1] * acc[ai][bj][m][1]); }
    } };
struct EpiQ { static constexpr bool PERM = true, AFTER_DRAIN = false; bf16* Q; const float* ROPE;
    __device__ __forceinline__ void operator()(EPI_ARGS) const {
        const int row0 = u.pm * 256 + wr * 64 + fr, colb = u.pn * 256 + wc * 32 + 8 * fq;
        const int hc0 = colb % 96, hc1 = (colb + 128) % 96; const bool rp0 = hc0 >= 64, rp1 = hc1 >= 64; const int po0 = rp0 ? (hc0 - 64) : 0, po1 = rp1 ? (hc1 - 64) : 0;
        int qoff = row0 * 1536 + colb, roff = (row0 & 2047) * 32;
#pragma unroll
        for (int ai = 0; ai < 2; ++ai) {
#pragma unroll
            for (int m = 0; m < 4; ++m) { const float* rtr = ROPE + roff; bf16* qrow = Q + qoff;
#pragma unroll
                for (int bj = 0; bj < 2; ++bj) { A4 a = acc[ai][bj][m][0], b = acc[ai][bj][m][1];
                    if (bj == 0 ? rp0 : rp1) { const float* rt = rtr + (bj == 0 ? po0 : po1); const A4 r0 = *(const A4*)rt, r1 = *(const A4*)(rt + 4);
                        A4 a2, b2; a2[0] = a[0] * r0[0] - a[1] * r0[1]; a2[1] = a[0] * r0[1] + a[1] * r0[0]; a2[2] = a[2] * r0[2] - a[3] * r0[3]; a2[3] = a[2] * r0[3] + a[3] * r0[2];
                        b2[0] = b[0] * r1[0] - b[1] * r1[1]; b2[1] = b[0] * r1[1] + b[1] * r1[0]; b2[2] = b[2] * r1[2] - b[3] * r1[3]; b2[3] = b[2] * r1[3] + b[3] * r1[2]; a = a2; b = b2; }
                    constexpr float QC_ = 0.10206207261596577f * 1.4426950408889634f;
#pragma unroll
                    for (int e = 0; e < 4; ++e) { a[e] *= QC_; b[e] *= QC_; }
                    *(u32x4*)(qrow + bj * 128) = pack8(a, b); }
                qoff += 16 * 1536; roff += 16 * 32; asm volatile("" : "+v"(qoff), "+v"(roff) :: "memory"); }
            qoff += 64 * 1536; roff += 64 * 32; }
    } };
struct EpiKV { static constexpr bool PERM = true, AFTER_DRAIN = false; bf16* KN; bf16* V;
    __device__ __forceinline__ void operator()(EPI_ARGS) const {
        const int t0 = u.pm * 256; int b, key0; if (t0 < TL) { b = t0 >> 11; key0 = 256 + (t0 & 2047); } else { b = (t0 - TL) >> 8; key0 = 0; }
        bf16* ub = (wc < 2 ? KN : V) + ((size_t)(b * 16 + u.pn * 2) * 2304 + key0 + wr * 64) * 64 + (wc & 1) * 32;
        const unsigned voff = (unsigned)(fr * 64 + 8 * fq) * 2u;
#pragma unroll
        for (int ai = 0; ai < 2; ++ai)
#pragma unroll
            for (int m = 0; m < 4; ++m)
#pragma unroll
                for (int bj = 0; bj < 2; ++bj) *(u32x4*)((char*)(ub + (size_t)bj * 2304 * 64 + (ai * 128 + m * 16) * 64) + voff) = pack8(acc[ai][bj][m][0], acc[ai][bj][m][1]);
    } };
struct SchedG1 { int vcu, G;
    __device__ __forceinline__ bool next(int i, Unit& u) const { const int j = i * G + vcu; if (j >= 1152) return false; const int tt = j >> 3, sub = j & 7; if (sub < 4) { u.pm = tt; u.pn = 148 + sub; } else { u.pm = 144 + (sub - 4); u.pn = tt; } return true; }
    __device__ __forceinline__ void a_ready(const Unit&) const {} __device__ __forceinline__ void done(const Unit&) const {} };
struct SchedMN { int vcu, G, nM, nN, pm0, pn0;
    __device__ __forceinline__ bool next(int i, Unit& u) const { const int j = i * G + vcu; if (j >= nM * nN) return false; u.pm = pm0 + j / nN; u.pn = pn0 + j % nN; return true; }
    __device__ __forceinline__ void a_ready(const Unit&) const {} __device__ __forceinline__ void done(const Unit&) const {} };
struct SchedNM { int vcu, G, nM, nN;
    __device__ __forceinline__ bool next(int i, Unit& u) const { const int j = i * G + vcu; if (j >= nM * nN) return false; u.pm = j % nM; u.pn = j / nM; return true; }
    __device__ __forceinline__ void a_ready(const Unit&) const {} __device__ __forceinline__ void done(const Unit&) const {} };
struct SchedOwn { int w, nM;
    __device__ __forceinline__ bool next(int i, Unit& u) const { if (i >= 2 || w >= nM) return false; u.pm = w; u.pn = i; return true; }
    __device__ __forceinline__ void a_ready(const Unit&) const {} __device__ __forceinline__ void done(const Unit&) const {} };
struct SchedExp { int vcu, G, nMt, nNt;
    __device__ __forceinline__ bool next(int i, Unit& u) const { const int j = i * G + vcu, per = nMt * nNt; if (j >= 16 * per) return false; const int e = j / per, r = j % per; u.pm = e * 18 + r / nNt; u.pn = e * nNt + r % nNt; return true; }
    __device__ __forceinline__ void a_ready(const Unit&) const {} __device__ __forceinline__ void done(const Unit&) const {} };
}

namespace att {
using bf16x8 = __attribute__((ext_vector_type(8))) short;
using s16x4 = __attribute__((ext_vector_type(4))) short;
using f32x16 = __attribute__((ext_vector_type(16))) float;
using u32x4 = __attribute__((ext_vector_type(4))) unsigned;
typedef unsigned short bf16;
constexpr int NW = 8, QBLK = 32, KVBLK = 64, SKV = 2304, NT = SKV / KVBLK, LDQ = 1536, LDO = 1024;
constexpr float SCALE = 0.10206207261596577f, THR = 8.f;
constexpr int SHM_V = 16384, SHM_K = 16384, NBUF = 4, SHM_ATTN = NBUF * SHM_V + NBUF * SHM_K + NW * 64 * 4;
#define KSWZ(row, colB) ((row) * 256 + ((colB) ^ (((row) & 7) << 4)))
#define SBAR() __builtin_amdgcn_sched_barrier(0)
__device__ __forceinline__ int crow(int r, int hi) { return (r & 3) + 8 * (r >> 2) + 4 * hi; }
__device__ __forceinline__ unsigned cvtpk(float lo, float hi) { unsigned r; asm volatile("v_cvt_pk_bf16_f32 %0, %1, %2" : "=v"(r) : "v"(lo), "v"(hi)); return r; }
constexpr float QC = SCALE * 1.4426950408889634f, THR2 = THR * 1.4426950408889634f;
__device__ __forceinline__ void rowmaxSM(f32x16& p0, f32x16& p1, f32x16& negm, float& alpha, bool first) {
  float pmax = p0[0]; for (int r = 1; r < 16; ++r) pmax = fmaxf(pmax, p0[r]); for (int r = 0; r < 16; ++r) pmax = fmaxf(pmax, p1[r]);
  { float a_ = pmax, b_ = pmax; asm volatile("s_nop 1\n\tv_permlane32_swap_b32 %0, %1" : "+v"(a_), "+v"(b_)); pmax = fmaxf(a_, b_); }
  if (__builtin_expect(!first && __all(pmax <= THR2), 1)) { alpha = 1.f; }
  else { const float d = first ? pmax : fmaxf(pmax, 0.f); alpha = first ? 1.f : __builtin_amdgcn_exp2f(-d);
    for (int r = 0; r < 16; ++r) { p0[r] -= d; p1[r] -= d; negm[r] -= d; } }
}
#define PK4(P, BASE, OUT) do { unsigned a0 = cvtpk(P[BASE + 0], P[BASE + 1]), a1 = cvtpk(P[BASE + 2], P[BASE + 3]);   \
    unsigned b0 = cvtpk(P[BASE + 4], P[BASE + 5]), b1 = cvtpk(P[BASE + 6], P[BASE + 7]);                              \
    auto r0 = __builtin_amdgcn_permlane32_swap(a0, b0, false, false); auto r1 = __builtin_amdgcn_permlane32_swap(a1, b1, false, false); \
    u32x4 w = {r0[0], r1[0], r0[1], r1[1]}; OUT = *reinterpret_cast<bf16x8*>(&w); } while (0)
__device__ __forceinline__ void finishSM(f32x16& p0, f32x16& p1, float alpha, float& l_reg, bf16x8& pa0, bf16x8& pa1, bf16x8& pa2, bf16x8& pa3) {
  float ps = 0; for (int r = 0; r < 16; ++r) ps += p0[r]; for (int r = 0; r < 16; ++r) ps += p1[r];
  { float a_ = ps, b_ = ps; asm volatile("s_nop 1\n\tv_permlane32_swap_b32 %0, %1" : "+v"(a_), "+v"(b_)); ps = a_ + b_; }
  l_reg = l_reg * alpha + ps;
  PK4(p0, 0, pa0); PK4(p0, 8, pa1); PK4(p1, 0, pa2); PK4(p1, 8, pa3);
}
__device__ __forceinline__ void qk_fin(f32x16& c0, f32x16& c1, const char* Ks, const bf16x8* qr, int r32, int hi, const f32x16& negm, bf16x8 kp00, bf16x8 kp10, bf16x8 kp01, bf16x8 kp11,
                                       f32x16& p0, f32x16& p1, float alpha, float& l_reg, bf16x8& pa0, bf16x8& pa1, bf16x8& pa2, bf16x8& pa3) {
  bf16x8 k0[6], k1[6]; k0[0] = kp00; k1[0] = kp10; k0[1] = kp01; k1[1] = kp11;
#define KRD(d) do { const int cb = ((d) * 16 + hi * 8) * 2; k0[d] = *reinterpret_cast<const bf16x8*>(Ks + KSWZ(r32, cb)); k1[d] = *reinterpret_cast<const bf16x8*>(Ks + KSWZ(32 + r32, cb)); } while (0)
#define QKM(d) do { c0 = __builtin_amdgcn_mfma_f32_32x32x16_bf16(k0[d], qr[d], (d) == 0 ? negm : c0, 0, 0, 0); c1 = __builtin_amdgcn_mfma_f32_32x32x16_bf16(k1[d], qr[d], (d) == 0 ? negm : c1, 0, 0, 0); } while (0)
  float ps = 0.f, ps1 = 0.f;
  QKM(0); KRD(2); for (int r = 0; r < 16; ++r) ps += p0[r]; SBAR();
  QKM(1); KRD(3); for (int r = 0; r < 16; ++r) ps1 += p1[r]; ps += ps1;
  { float a_ = ps, b_ = ps; asm volatile("s_nop 1\n\tv_permlane32_swap_b32 %0, %1" : "+v"(a_), "+v"(b_)); ps = a_ + b_; } l_reg = l_reg * alpha + ps; SBAR();
  QKM(2); KRD(4); PK4(p0, 0, pa0); SBAR();
  QKM(3); KRD(5); PK4(p0, 8, pa1); SBAR();
  QKM(4); PK4(p1, 0, pa2); SBAR();
  QKM(5); PK4(p1, 8, pa3); SBAR();
#undef KRD
#undef QKM
}
__device__ __forceinline__ void qkt(f32x16& p0, f32x16& p1, const char* Ks, const bf16x8* qr, int r32, int hi, const f32x16& negm) {
#pragma unroll
  for (int d0 = 0; d0 < 6; ++d0) { int cb = (d0 * 16 + hi * 8) * 2;
    bf16x8 b0 = *reinterpret_cast<const bf16x8*>(Ks + KSWZ(r32, cb));
    bf16x8 b1 = *reinterpret_cast<const bf16x8*>(Ks + KSWZ(32 + r32, cb));
    p0 = __builtin_amdgcn_mfma_f32_32x32x16_bf16(b0, qr[d0], d0 == 0 ? negm : p0, 0, 0, 0);
    p1 = __builtin_amdgcn_mfma_f32_32x32x16_bf16(b1, qr[d0], d0 == 0 ? negm : p1, 0, 0, 0); }
}
__device__ __forceinline__ int v_st(int k, int c) { const int kk = (k & ~0xC) | ((k & 4) << 1) | ((k & 8) >> 1); return ((kk >> 3) * 4 + (c >> 5)) * 512 + ((kk & 7) * 32 + (c & 31)) * 2; }
__device__ __forceinline__ int v_rd_base(int lane) { return ((lane & 3) << 3) | (((lane >> 2) & 3) << 6) | (((lane >> 4) & 1) << 5) | (((lane >> 5) & 1) << 8); }
constexpr int v_rd_off(int d0, int ks, int half) { return d0 * 512 + ks * 4096 + half * 2048; }
template <int OFF> __device__ __forceinline__ s16x4 tr_read(int vb) {
  s16x4 r; asm volatile("ds_read_b64_tr_b16 %0, %1 offset:%2" : "=&v"(r) : "v"(vb), "i"(OFF) : "memory"); return r;
}
template <int D0> __device__ __forceinline__ void pv_one(f32x16& od, int vb, bf16x8 pa0, bf16x8 pa1, bf16x8 pa2, bf16x8 pa3) {
  const s16x4 l0 = tr_read<v_rd_off(D0, 0, 0)>(vb), h0 = tr_read<v_rd_off(D0, 0, 1)>(vb), l1 = tr_read<v_rd_off(D0, 1, 0)>(vb), h1 = tr_read<v_rd_off(D0, 1, 1)>(vb);
  const s16x4 l2 = tr_read<v_rd_off(D0, 2, 0)>(vb), h2 = tr_read<v_rd_off(D0, 2, 1)>(vb), l3 = tr_read<v_rd_off(D0, 3, 0)>(vb), h3 = tr_read<v_rd_off(D0, 3, 1)>(vb);
  asm volatile("s_waitcnt lgkmcnt(0)" ::: "memory"); SBAR();
#define PK(L, H) (bf16x8){L[0], L[1], L[2], L[3], H[0], H[1], H[2], H[3]}
  od = __builtin_amdgcn_mfma_f32_32x32x16_bf16(pa0, PK(l0, h0), od, 0, 0, 0);
  od = __builtin_amdgcn_mfma_f32_32x32x16_bf16(pa1, PK(l1, h1), od, 0, 0, 0);
  od = __builtin_amdgcn_mfma_f32_32x32x16_bf16(pa2, PK(l2, h2), od, 0, 0, 0);
  od = __builtin_amdgcn_mfma_f32_32x32x16_bf16(pa3, PK(l3, h3), od, 0, 0, 0);
#undef PK
}
struct VFrag { s16x4 a0, b0, a1, b1, a2, b2, a3, b3, c0, d0, c1, d1, c2, d2, c3, d3; };
__device__ __forceinline__ void pv_reads(VFrag& v, int vb) {
  v.a0 = tr_read<v_rd_off(0, 0, 0)>(vb); v.b0 = tr_read<v_rd_off(0, 0, 1)>(vb); v.c0 = tr_read<v_rd_off(1, 0, 0)>(vb); v.d0 = tr_read<v_rd_off(1, 0, 1)>(vb);
  v.a1 = tr_read<v_rd_off(0, 1, 0)>(vb); v.b1 = tr_read<v_rd_off(0, 1, 1)>(vb); v.c1 = tr_read<v_rd_off(1, 1, 0)>(vb); v.d1 = tr_read<v_rd_off(1, 1, 1)>(vb);
  v.a2 = tr_read<v_rd_off(0, 2, 0)>(vb); v.b2 = tr_read<v_rd_off(0, 2, 1)>(vb); v.c2 = tr_read<v_rd_off(1, 2, 0)>(vb); v.d2 = tr_read<v_rd_off(1, 2, 1)>(vb);
  v.a3 = tr_read<v_rd_off(0, 3, 0)>(vb); v.b3 = tr_read<v_rd_off(0, 3, 1)>(vb); v.c3 = tr_read<v_rd_off(1, 3, 0)>(vb); v.d3 = tr_read<v_rd_off(1, 3, 1)>(vb);
}
template <bool EXPS, bool KPRE> __device__ __forceinline__ void pv_mfma(f32x16* o, const VFrag& v, bf16x8 pa0, bf16x8 pa1, bf16x8 pa2, bf16x8 pa3, f32x16& e0, f32x16& e1,
                                                                        const char* Kn, int r32, int hi, bf16x8& kp00, bf16x8& kp10, bf16x8& kp01, bf16x8& kp11) {
  asm volatile("s_waitcnt lgkmcnt(0)" ::: "memory"); SBAR();
#define PK(L, H) (bf16x8){L[0], L[1], L[2], L[3], H[0], H[1], H[2], H[3]}
#define EX4(E, B) do { if (EXPS) { float x0 = __builtin_amdgcn_exp2f(E[B]), x1 = __builtin_amdgcn_exp2f(E[B + 1]), x2 = __builtin_amdgcn_exp2f(E[B + 2]), x3 = __builtin_amdgcn_exp2f(E[B + 3]); \
    asm volatile("" : "+v"(x0), "+v"(x1), "+v"(x2), "+v"(x3));     \
    E[B] = x0; E[B + 1] = x1; E[B + 2] = x2; E[B + 3] = x3; } SBAR(); } while (0)
  o[0] = __builtin_amdgcn_mfma_f32_32x32x16_bf16(pa0, PK(v.a0, v.b0), o[0], 0, 0, 0);
  if (KPRE) { const int cb = (hi * 8) * 2; kp00 = *reinterpret_cast<const bf16x8*>(Kn + KSWZ(r32, cb)); kp10 = *reinterpret_cast<const bf16x8*>(Kn + KSWZ(32 + r32, cb)); }
  EX4(e0, 0);
  o[1] = __builtin_amdgcn_mfma_f32_32x32x16_bf16(pa0, PK(v.c0, v.d0), o[1], 0, 0, 0);
  if (KPRE) { const int cb = (16 + hi * 8) * 2; kp01 = *reinterpret_cast<const bf16x8*>(Kn + KSWZ(r32, cb)); kp11 = *reinterpret_cast<const bf16x8*>(Kn + KSWZ(32 + r32, cb)); }
  EX4(e0, 4);
  o[0] = __builtin_amdgcn_mfma_f32_32x32x16_bf16(pa1, PK(v.a1, v.b1), o[0], 0, 0, 0); EX4(e0, 8);
  o[1] = __builtin_amdgcn_mfma_f32_32x32x16_bf16(pa1, PK(v.c1, v.d1), o[1], 0, 0, 0); EX4(e0, 12);
  o[0] = __builtin_amdgcn_mfma_f32_32x32x16_bf16(pa2, PK(v.a2, v.b2), o[0], 0, 0, 0); EX4(e1, 0);
  o[1] = __builtin_amdgcn_mfma_f32_32x32x16_bf16(pa2, PK(v.c2, v.d2), o[1], 0, 0, 0); EX4(e1, 4);
  o[0] = __builtin_amdgcn_mfma_f32_32x32x16_bf16(pa3, PK(v.a3, v.b3), o[0], 0, 0, 0); EX4(e1, 8);
  o[1] = __builtin_amdgcn_mfma_f32_32x32x16_bf16(pa3, PK(v.c3, v.d3), o[1], 0, 0, 0); EX4(e1, 12);
#undef EX4
#undef PK
}
__device__ __forceinline__ void attn_bh(const bf16* __restrict__ Qbh, const bf16* __restrict__ KNh, const bf16* __restrict__ KRb, const bf16* __restrict__ Vh, bf16* __restrict__ Obh, char* lds) {
  int tid_ = threadIdx.x; asm volatile("" : "+v"(tid_));
  const int tid = tid_, wid = __builtin_amdgcn_readfirstlane(tid >> 6), lane = tid & 63, r32 = lane & 31, hi = lane >> 5;
  char* V_lds = lds; char* K_lds = lds + NBUF * SHM_V;
  float* ws = (float*)(lds + NBUF * SHM_V + NBUF * SHM_K) + wid * 64; float* li_l = ws; float* al_l = ws + 32;
  const bool kact = wid < 6;
  const int krow = tid / 12, kch = tid - krow * 12;
  const bf16* ksrc = kch < 8 ? KNh + kch * 8 : KRb + (kch - 8) * 8; const int kstr = kch < 8 ? 64 : 32;
  const int kdst0 = KSWZ(krow, kch * 16), kdst1 = KSWZ(32 + krow, kch * 16);
  const int vrow = tid >> 3, vcol = (tid & 7) * 8, vdst = v_st(vrow, vcol);
  const int vb0 = (int)(uintptr_t)V_lds + v_rd_base(lane);
  bf16x8 ks0 = {}, ks1 = {}, vs;
#define SLOAD(k0) do { if (kact) { ks0 = *(const GAS bf16x8*)(ksrc + (long)((k0) + krow) * kstr); ks1 = *(const GAS bf16x8*)(ksrc + (long)((k0) + 32 + krow) * kstr); } \
    vs = *(const GAS bf16x8*)(Vh + (long)((k0) + vrow) * 64 + vcol); } while (0)
#define SWRITE(b) do { if (kact) { *(bf16x8*)(K_lds + (b) * SHM_K + kdst0) = ks0; *(bf16x8*)(K_lds + (b) * SHM_K + kdst1) = ks1; } \
    *(bf16x8*)(V_lds + (b) * SHM_V + vdst) = vs; } while (0)
#define RESC(a) do { if (__any((a) < 1.f)) { if (hi == 0) al_l[r32] = (a); asm volatile("s_waitcnt lgkmcnt(0)" ::: "memory"); \
    for (int d = 0; d < 2; ++d) for (int r = 0; r < 16; ++r) o[d][r] *= al_l[crow(r, hi)]; } } while (0)
#define STEP(CUR0, CUR1, ALC, PRV0, PRV1, ALP, t) do { \
    SBAR(); qk_fin(CUR0, CUR1, K_lds + ((t) & 3) * SHM_K, qr, r32, hi, negm, kp00, kp10, kp01, kp11, PRV0, PRV1, ALP, l_reg, pa0, pa1, pa2, pa3); \
    pv_reads(vf, vb0 + (((t) - 1) & 3) * SHM_V); \
    if ((t) + 1 < NT) SWRITE(((t) + 1) & 3); \
    __syncthreads(); \
    if ((t) + 2 < NT) SLOAD(((t) + 2) * KVBLK); SBAR(); \
    rowmaxSM(CUR0, CUR1, negm, ALC, false); \
    if ((t) + 1 < NT) pv_mfma<true, true>(o, vf, pa0, pa1, pa2, pa3, CUR0, CUR1, K_lds + (((t) + 1) & 3) * SHM_K, r32, hi, kp00, kp10, kp01, kp11); \
    else pv_mfma<true, false>(o, vf, pa0, pa1, pa2, pa3, CUR0, CUR1, K_lds, r32, hi, kp00, kp10, kp01, kp11); \
    RESC(ALC); } while (0)
  SLOAD(0);
#pragma unroll 1
  for (int qb = 0; qb < 8; ++qb) {
    bf16x8 qr[6];
    { int t2 = tid; asm volatile("" : "+v"(t2));
      const bf16* Qw = Qbh + (long)(qb * (QBLK * NW) + wid * QBLK + (t2 & 31)) * LDQ + ((t2 >> 5) & 1) * 8;
#pragma unroll
      for (int d0 = 0; d0 < 6; ++d0) qr[d0] = *(const GAS bf16x8*)(Qw + d0 * 16); }
    float l_reg = 0; f32x16 o[2] = {}; f32x16 negm = {}; VFrag vf;
    f32x16 pA0, pA1, pB0, pB1; float alA, alB; bf16x8 pa0, pa1, pa2, pa3, kp00, kp10, kp01, kp11;
    SWRITE(0); SLOAD(KVBLK); __syncthreads();
    qkt(pA0, pA1, K_lds, qr, r32, hi, negm); rowmaxSM(pA0, pA1, negm, alA, true);
#pragma unroll
    for (int r = 0; r < 16; ++r) { pA0[r] = __builtin_amdgcn_exp2f(pA0[r]); pA1[r] = __builtin_amdgcn_exp2f(pA1[r]); }
    SWRITE(1); SLOAD(2 * KVBLK);
    __syncthreads();
    { const int cb0 = (hi * 8) * 2, cb1 = (16 + hi * 8) * 2; const char* K1 = K_lds + SHM_K;
      kp00 = *reinterpret_cast<const bf16x8*>(K1 + KSWZ(r32, cb0)); kp10 = *reinterpret_cast<const bf16x8*>(K1 + KSWZ(32 + r32, cb0));
      kp01 = *reinterpret_cast<const bf16x8*>(K1 + KSWZ(r32, cb1)); kp11 = *reinterpret_cast<const bf16x8*>(K1 + KSWZ(32 + r32, cb1)); }
    asm volatile(".p2align 8" ::: "memory");
#pragma unroll 1
    for (int j = 1; j + 1 < NT; j += 2) {
      STEP(pB0, pB1, alB, pA0, pA1, alA, j);
      STEP(pA0, pA1, alA, pB0, pB1, alB, j + 1);
    }
    if (qb < 7) SLOAD(0);
    STEP(pB0, pB1, alB, pA0, pA1, alA, NT - 1);
    finishSM(pB0, pB1, alB, l_reg, pa0, pa1, pa2, pa3); SBAR();
    pv_reads(vf, vb0 + ((NT - 1) & 3) * SHM_V); pv_mfma<false, false>(o, vf, pa0, pa1, pa2, pa3, pB0, pB1, K_lds, r32, hi, kp00, kp10, kp01, kp11);
    if (hi == 0) li_l[r32] = l_reg; asm volatile("s_waitcnt lgkmcnt(0)" ::: "memory");
    float rli[16];
#pragma unroll
    for (int r = 0; r < 16; ++r) rli[r] = __builtin_amdgcn_rcpf(li_l[crow(r, hi)]);
    int t3 = tid; asm volatile("" : "+v"(t3)); const int hi3 = (t3 >> 5) & 1;
    bf16* Ow = Obh + (long)(qb * (QBLK * NW) + wid * QBLK) * LDO + (t3 & 31);
#pragma unroll
    for (int r = 0; r < 16; ++r) { const int orow = crow(r, hi3);
#pragma unroll
      for (int d0 = 0; d0 < 2; ++d0) *(GAS bf16*)(Ow + (long)orow * LDO + d0 * 32) = (bf16)f2bf(o[d0][r] * rli[r]); }
    __syncthreads();
  }
#undef STEP
#undef SLOAD
#undef SWRITE
#undef RESC
}
#undef KSWZ
#undef SBAR
}
#ifndef HYB_CUT
#define HYB_CUT 5
#endif
#define FP_PH_HI (HYB_CUT == 1 ? 5 : HYB_CUT == 2 ? 10 : HYB_CUT == 3 ? 15 : 20)
#ifndef A1_TWICE
#define A1_TWICE
#endif
namespace fp {
constexpr int N_PHASES = 20;
struct Args { const float* in[25]; float* out; unsigned char* ws; };
#ifndef FP_SP2
#define FP_SP2 true
#endif
#ifndef FP_ALIGN
#define FP_ALIGN true
#endif
template <bool SP2 = FP_SP2, class Epi, class Sched>
__device__ __forceinline__ void run_gemm(Ctx& F, const bf16* A, const bf16* Bt, int K, const Sched& S, const Epi& E) {
    pg8::Gemm g{A, Bt, 0, 0, K};
    pg8::gemm_phase<Epi, Sched, FP_ALIGN, SP2>(F.lds, g, S, E, F.tid);
}
template <class Epi, class Sched>
__device__ __forceinline__ void run_gemm_gather(Ctx& F, const bf16* Abase, const int* arow, const bf16* Bt, int K, const Sched& S, const Epi& E) {
    LAS int* tab = (LAS int*)(F.lds + XTRA_OFF);
    { int vals[5]; unsigned okm = 0u;
#pragma unroll
      for (int q = 0; q < 5; ++q) { const int idx = F.tid + q * NTHR; Unit u; vals[q] = 0; if (S.next(idx >> 8, u)) { okm |= 1u << q; vals[q] = *(const GAS int*)(arow + (size_t)u.pm * 256 + (idx & 255)); } }
#pragma unroll
      for (int q = 0; q < 5; ++q) if (okm & (1u << q)) tab[F.tid + q * NTHR] = vals[q]; }
    __syncthreads();
    pg8::Gemm g{Abase, Bt, 0, 0, K};
    pg8::gemm_phase<Epi, Sched, FP_ALIGN, true, true>(F.lds, g, S, E, F.tid, (const PG8_LAS int*)tab);
}
__global__ void __launch_bounds__(NTHR, 2) fwd_kernel(Args args) {
    extern __shared__ __attribute__((aligned(16))) unsigned char lds[];
    Ctx F;
    F.out = args.out; F.ws = args.ws; F.lds = (LAS unsigned char*)lds;
    F.tid = threadIdx.x; F.lane = F.tid & 63; F.wave = __builtin_amdgcn_readfirstlane(F.tid >> 6);
    F.G = gridDim.x; { const int bx = blockIdx.x; F.vcu = (F.G % 8 == 0) ? (bx % 8) * (F.G / 8) + bx / 8 : bx; }
    const int vcu0 = F.vcu;
    F.gw = F.vcu * NWAVES + F.wave; F.NGW = F.G * NWAVES;
    volatile LAS unsigned* MISC = (volatile LAS unsigned*)(F.lds + MISC_OFF);
    for (int u = F.tid; u < (LDS_BYTES - LDSCTL_OFF) / 4; u += NTHR) ((LAS unsigned*)(F.lds + LDSCTL_OFF))[u] = 0u;
    __syncthreads();
    if (F.tid < 25) { const unsigned long long pv = (unsigned long long)args.in[F.tid]; LAS unsigned* pp = (LAS unsigned*)(F.lds + PTR_OFF) + 2 * F.tid; pp[0] = (unsigned)pv; pp[1] = (unsigned)(pv >> 32); }
    __syncthreads();
    gu32* ctl = (gu32*)(F.ws + WS_CTL);
    constexpr int lo = 0, hi = FP_PH_HI;
    (void)xcd_barrier_post((unsigned*)(ctl + CW_BAR), MISC + 8);
#ifndef FP_ONLY
#define FP_ONLY -1
#endif
#ifndef FP_MIN
#define FP_MIN 0
#endif
#ifndef FP_MAX
#define FP_MAX 99
#endif
#ifndef FP_SKIP
#define FP_SKIP -1
#endif
#ifndef FP_SKIP2
#define FP_SKIP2 -1
#endif
#define IN(k) ((k) != FP_SKIP && (k) != FP_SKIP2 && (FP_ONLY < 0 || FP_ONLY == (k)) && (k) >= FP_MIN && (k) <= FP_MAX && lo <= (k) && (k) < hi)
#ifndef TIMEK
#define TIMEK 1.0f
#endif
#ifdef TIMEPH
#define STAMP(k) do { if (blockIdx.x == 0 && threadIdx.x == 0) ((unsigned long long*)(args.ws + 64 * 1024))[(k)] = __builtin_amdgcn_s_memrealtime(); } while (0)
#else
#define STAMP(k) do {} while (0)
#endif
#define SEAM(k) do { if (IN((k) + 1)) { XcdBarrier bar_; bar_.bar = (unsigned*)(F.ws + WS_CTL) + CW_BAR; bar_.x = xb_xcc_id(); bar_.st = (volatile LAS unsigned*)(F.lds + MISC_OFF) + 8; xcd_barrier(bar_); } STAMP((k) + 1); LAUNDER(); } while (0)
#ifndef FP_REP_PH
#define FP_REP_PH -1
#endif
#define REP(k) _Pragma("unroll 1") for (int rep_ = 0; rep_ < ((k) == FP_REP_PH ? 2 : 1); ++rep_)
#define LAUNDER() do { int t_ = threadIdx.x; asm volatile("" : "+v"(t_)); F.tid = t_; F.lane = t_ & 63; F.wave = __builtin_amdgcn_readfirstlane(t_ >> 6); \
        unsigned char* w_ = args.ws; asm volatile("" : "+s"(w_)); F.ws = w_; float* o_ = args.out; asm volatile("" : "+s"(o_)); F.out = o_; \
        int v_ = vcu0; asm volatile("" : "+s"(v_)); F.vcu = v_; F.gw = v_ * NWAVES + F.wave; } while (0)
    const float* MODS = WSP(float, WS_MODS);

    STAMP(0);
    if (IN(0)) { REP(0) { p0_mods(F); __syncthreads(); } SEAM(0); }
    if (IN(1)) { REP(1) { p0_rest(F); p1_norm(F); } SEAM(1); }
    if (IN(2)) {
        REP(2) run_gemm(F, WSP(bf16, WS_UW), WSP(bf16, WS_UW), 1024, SchedG1{F.vcu, F.G}, EpiG1{WSP(bf16, WS_AG), WSP(bf16, WS_YT), WSP(bf16, WS_YTC)});
        if (F.vcu >= 128) { LAS float* scr = (LAS float*)(F.lds + F.wave * 8448); moe_w_items(F, 0, scr, MW0_A, MW0_B, (F.vcu - 128) * NWAVES + F.wave, 128 * NWAVES); }
        SEAM(2); }
    if (IN(3)) {
        REP(3) p3_conv(F);
        if ((F.vcu & 7) == 0) run_gemm(F, WSP(bf16, WS_CSC), WSP(bf16, WS_YTC), 512, SchedNM{F.vcu >> 3, 32, 1, 32}, EpiF{WSP(bf16, WS_R2), 256, TL});
        else { REP(22) p3_dft1(F, F.vcu - (F.vcu >> 3) - 1, 224); }
        { XcdBarrier bar_; bar_.bar = (unsigned*)(F.ws + WS_CTL) + CW_BAR; bar_.x = xb_xcc_id(); bar_.st = (volatile LAS unsigned*)(F.lds + MISC_OFF) + 8; xcd_barrier(bar_); LAUNDER(); }
        REP(20) run_gemm(F, WSP(bf16, WS_CS), WSP(bf16, WS_AP), 512, SchedNM{F.vcu, F.G, 1, 256}, EpiF2{WSP(bf16, WS_R2)});
        SEAM(3); }
    if (IN(4)) {
        REP(4) run_gemm(F, WSP(bf16, WS_R2), WSP(bf16, WS_WOUT), 1024, SchedMN{F.vcu, F.G, 144, 4, 0, 0}, EpiY{(bf16*)F.out + 1024, WSP(bf16, WS_XC) + 1024, 2048, MODS + 2 * 1024});
        if (F.vcu >= 64) { LAS float* scr = (LAS float*)(F.lds + F.wave * 8448); moe_w_items(F, 0, scr, MW0_B, 16 * 1536, (F.vcu - 64) * NWAVES + F.wave, 192 * NWAVES); }
        SEAM(4); }
#define MOE_BLOCK(ly, pb) do { \
        if (IN(pb)) { REP(pb) m1_route(F, ly, ly == 0 ? T : TL); SEAM(pb); } \
        if (IN(pb + 1)) { const int nu = ly == 0 ? 512 : 256; REP(pb + 1) for (int u = F.vcu; u < nu; u += F.G) m2_unit(F, u); SEAM(pb + 1); } \
        if (IN(pb + 2)) { REP(pb + 2) run_gemm_gather(F, WSP(bf16, WS_UW), WSP(int, WS_AROW), WSP(bf16, WS_W13), 1024, SchedExp{F.vcu, F.G, ly == 0 ? 18 : 16, 8}, EpiSwiglu{WSP(bf16, WS_R2)}); SEAM(pb + 2); } \
        if (IN(pb + 3)) { REP(pb + 3) run_gemm(F, WSP(bf16, WS_R2), WSP(bf16, WS_W2), 1024, SchedExp{F.vcu, F.G, ly == 0 ? 18 : 16, 4}, EpiGate{WSP(bf16, WS_R1), WSP(float, WS_GATE)}); SEAM(pb + 3); } } while (0)
    MOE_BLOCK(0, 5);
        if (IN(9)) { REP(9) { a0_combine(F, FP_REP_PH == 9 && rep_ == 0); __syncthreads(); } SEAM(9); }
        if (IN(10)) {
            const int xq = F.vcu >> 5, xr = F.vcu & 31;
            if (xr < 18) { const int w = xq * 18 + xr;
                REP(10) { run_gemm(F, WSP(bf16, WS_UW), WSP(bf16, WS_WMLA), 1024, SchedOwn{w, 144}, EpiPlain{WSP(bf16, WS_CQKV), 512});
                    __syncthreads(); a1_lowrank(F, w * 256 + F.wave * 32, 32); A1_TWICE } }
            else { LAS float* scr = (LAS float*)(F.lds + F.wave * 8448); moe_w_items(F, 1, scr, MW_SPLIT, 16 * 1536, (xq * 14 + xr - 18) * NWAVES + F.wave, 112 * NWAVES); }
            SEAM(10); }
        if (IN(12)) {
            REP(12) run_gemm<true>(F, WSP(bf16, WS_CQN), WSP(bf16, WS_WUQ), 256, SchedMN{F.vcu, F.G, 128, 6, 0, 0}, EpiQ{WSP(bf16, WS_Q), WSP(float, WS_ROPE)});
            LAUNDER();
            REP(21) run_gemm<true>(F, WSP(bf16, WS_CKVN), WSP(bf16, WS_WUKV), 128, SchedMN{F.vcu, F.G, 144, 8, 0, 0}, EpiKV{WSP(bf16, WS_KN), WSP(bf16, WS_V)});
            SEAM(12); }
        if (IN(13)) {
            REP(13) for (int bh = F.vcu; bh < 256; bh += F.G) { const int b = bh >> 4, h = bh & 15;
                const bf16* KNh = WSP(bf16, WS_KN) + (size_t)bh * 2304 * 64; const bf16* Vh = WSP(bf16, WS_V) + (size_t)bh * 2304 * 64; const bf16* KRb = WSP(bf16, WS_KR) + (size_t)b * 2304 * 32;
                att::attn_bh(WSP(bf16, WS_Q) + (size_t)b * 2048 * 1536 + h * 96, KNh, KRb, Vh, WSP(bf16, WS_O) + (size_t)b * 2048 * 1024 + h * 64, (char*)lds); }
            SEAM(13); }
        if (IN(14)) {
            run_gemm(F, WSP(bf16, WS_O), WSP(bf16, WS_WO), 1024, SchedMN{F.vcu, F.G, 128, 4, 0, 0}, EpiY{WSP(bf16, WS_Y1), WSP(bf16, WS_Y1), 1024, MODS + (size_t)17 * 6144 + 2 * 1024});
            SEAM(14); }
    MOE_BLOCK(1, 15);
    float cofs = 0.f;
#ifdef TIMEPH
    { const unsigned long long* ts = (const unsigned long long*)(args.ws + 64 * 1024);
      const float dt_us = (float)(__hip_atomic_load(ts + TIMEPH + 1, __ATOMIC_RELAXED, __HIP_MEMORY_SCOPE_AGENT) - __hip_atomic_load(ts + TIMEPH, __ATOMIC_RELAXED, __HIP_MEMORY_SCOPE_AGENT)) * 0.01f;
      cofs = sqrtf(dt_us * 1.0025e-5f * TIMEK); }
#endif
    if (IN(19)) { REP(19) p_final(F, FP_REP_PH == 19 && rep_ == 0, cofs); }

#undef IN
#undef SEAM
}
}
#ifdef DIAG
namespace diag {
__global__ void k_cmp(const float* ref, long rsi, long rsj, const void* fast, long fsi, long fsj, int isbf, int ni, int nj, float* stats, int k) {
    float d2 = 0.f, r2 = 0.f;
    for (long idx = (long)blockIdx.x * 256 + threadIdx.x; idx < (long)ni * nj; idx += (long)gridDim.x * 256) { const long i = idx / nj, j = idx % nj;
        const float r = ref[i * rsi + j * rsj]; float f;
        if (isbf) f = __builtin_bit_cast(float, (unsigned)((const unsigned short*)fast)[i * fsi + j * fsj] << 16); else f = ((const float*)fast)[i * fsi + j * fsj];
        const float d = f - r; d2 += d * d; r2 += r * r; }
    for (int o = 32; o > 0; o >>= 1) { d2 += __shfl_xor(d2, o); r2 += __shfl_xor(r2, o); }
    if ((threadIdx.x & 63) == 0) { atomicAdd(&stats[2 * k], d2); atomicAdd(&stats[2 * k + 1], r2); }
}
__global__ void k_encode(const float* stats, int nst, float thr, float* out, long n) {
    int X = -1, minlvl = 9;
    for (int k = 1; k <= nst; ++k) { const float e = sqrtf(stats[2 * k] / fmaxf(stats[2 * k + 1], 1e-30f)); int lvl = (int)floorf(-2.f * log10f(fmaxf(e, 1e-9f))); lvl = lvl < 0 ? 0 : (lvl > 9 ? 9 : lvl);
        if (!(e <= thr) && X < 0) X = 10 * k + lvl; minlvl = lvl < minlvl ? lvl : minlvl; }
    if (X < 0) X = 90 + minlvl;
#ifdef DIAG_STAGE
    { const int k = DIAG_STAGE; const float e = sqrtf(stats[2 * k] / fmaxf(stats[2 * k + 1], 1e-30f)); float l = -20.f * log10f(fmaxf(e, 1e-9f)); X = (int)fminf(fmaxf(l, 10.f), 99.f); }
#endif
    const float c = sqrtf(1002.5f * (float)X);
    for (long i = (long)blockIdx.x * 256 + threadIdx.x; i < n; i += (long)gridDim.x * 256) out[i] = c;
}
#define CMP(k, ref, rsi, rsj, fast, fsi, fsj, isbf, ni, nj) hipLaunchKernelGGL(k_cmp, dim3(512), dim3(256), 0, st, ref, (long)(rsi), (long)(rsj), (const void*)(fast), (long)(fsi), (long)(fsj), isbf, ni, nj, stats, k)
inline void mixer(void* const* d_in, float* d_out, char* ws, char* nbase, hipStream_t st, int bb) {
    using namespace ref; In I = make_in(d_in); Bufs b; carve(b, nbase);
    float* stats = (float*)(nbase - 4096); (void)hipMemsetAsync(stats, 0, 4096, st);
    REF_EW(k_silu, 16 * 1024, I.c, b.SC, 16 * 1024); REF_EW(k_silu, 1024, I.c_ctx, b.SC + 16 * 1024, 1024);
    for (int ly = 0; ly < 2; ++ly) gemm(st, b.SC, D, I.mod_w + (size_t)ly * D * 6144, 6144, b.MODS + (size_t)ly * 17 * 6144, 6144, 17, 6144, D, I.mod_b + ly * 6144);
    REF_EW(k_mk_cs, L * L, b.CSL, L, 1.f / sqrtf((float)L * 128.f)); REF_EW(k_mk_cc, 128 * 128, b.CC, b.SCm);
    (void)hipMemcpyAsync(b.NX, I.x + (size_t)bb * L * D, (size_t)L * D * 4, hipMemcpyDeviceToDevice, st);
    const float* md = b.MODS + (size_t)bb * 6144; const int Ls = L; const size_t t0 = (size_t)bb * L;
    CMP(7, b.MODS, 6144, 1, ws + fp::WS_MODS, 6144, 1, 0, 34, 6144);
    hipLaunchKernelGGL(k_rms, dim3(Ls), dim3(256), 0, st, b.NX, D, b.NU, D, I.norm1_g, md + 0 * D, md + 1 * D, D);
    CMP(1, b.NU, D, 1, (unsigned short*)(ws + fp::WS_UW) + t0 * D, D, 1, 1, Ls, D);
    gemm(st, b.NU, D, I.ab_w_in, 1536, b.NZ, 1536, Ls, 1536, D);
    REF_EW(k_glu, Ls * 512, b.NZ, b.NA, Ls);
    CMP(2, b.NA, 512, 1, (unsigned short*)(ws + fp::WS_AG) + t0 * 512, 512, 1, 1, Ls, 512);
    hipLaunchKernelGGL(k_conv_ln, dim3(Ls), dim3(256), 0, st, b.NA, b.NCAT, I.ab_conv_w, I.ab_conv_b, I.ab_ln_g, I.ab_ln_b, Ls);
    gemm(st, b.NZ + 1024, 1536, b.CC, 128, b.NY, 512, Ls, 128, 128, nullptr, nullptr, 4, 128, 0, 128, 0);
    gemm(st, b.NZ + 1024, 1536, b.SCm, 128, b.NY + (size_t)Ls * 512, 512, Ls, 128, 128, nullptr, nullptr, 4, 128, 0, 128, 0);
    CMP(3, b.NY, 512, 1, (unsigned short*)(ws + fp::WS_YT) + (size_t)bb * 512 * 4096, 1, 4096, 1, 2 * Ls, 512);
    gemm(st, b.CSL, 2 * Ls, b.NY, 512, b.NCAT + 512, 1024, Ls, 512, 2 * Ls);
    CMP(4, b.NCAT, 1024, 1, (unsigned short*)(ws + fp::WS_R2) + t0 * 1024, 1024, 1, 1, Ls, 512);
    CMP(5, b.NCAT + 512, 1024, 1, (unsigned short*)(ws + fp::WS_R2) + t0 * 1024 + 512, 1024, 1, 1, Ls, 512);
    gemm(st, b.NCAT, D, I.ab_w_out, D, b.NT1, D, Ls, D, D);
    REF_EW(k_resid, Ls * 1024, b.NX, b.NT1, md + 2 * D, Ls);
    CMP(6, b.NX, D, 1, d_out + t0 * D, D, 1, 0, Ls, D);
    hipLaunchKernelGGL(k_encode, dim3(1024), dim3(256), 0, st, stats, 7, DIAG_THR, d_out, (long)16 * 2048 * 1024);
}
}
#endif
extern "C" void kernel_launch(void* const* d_in, const int* in_sizes, int n_in, void* d_out, int out_size, void* d_ws, size_t ws_size, hipStream_t stream) {
    static int grid = 0;
    if (grid == 0) {
        ref::Bufs b; const size_t need_ref = 29 * fp::MiB + ref::carve(b, (char*)d_ws);
        size_t need = fp::WS_END; if (HYB_CUT != 5 && need_ref > need) need = need_ref;
#ifdef DIAG
        need = 600 * fp::MiB / 1;
        need = 0;
#endif
        if (n_in != 25 || out_size != 16 * 2048 * 1024 || ws_size < need) { fprintf(stderr, "kernel_launch: unexpected sizes n_in %d out %d ws %zu need %zu\n", n_in, out_size, ws_size, need); grid = -1; return; }
        int dev = 0, cus = 0;
        if (hipGetDevice(&dev) != hipSuccess || hipDeviceGetAttribute(&cus, hipDeviceAttributeMultiprocessorCount, dev) != hipSuccess) { grid = -1; return; }
        if (hipFuncSetAttribute((const void*)fp::fwd_kernel, hipFuncAttributeMaxDynamicSharedMemorySize, fp::LDS_BYTES) != hipSuccess) { fprintf(stderr, "kernel_launch: hipFuncSetAttribute failed\n"); grid = -1; return; }
        if (cus != 256) { fprintf(stderr, "kernel_launch: built for 256 CUs, device has %d\n", cus); grid = -1; return; }
        grid = cus;
    }
    if (grid < 0) return;
    if (hipMemsetAsync((char*)d_ws + fp::WS_CTL, 0, fp::CTL_ZERO_BYTES, stream) != hipSuccess) return;
    fp::Args a{};
    for (int i = 0; i < 25; ++i) a.in[i] = (const float*)d_in[i];
    a.out = (float*)d_out; a.ws = (unsigned char*)d_ws;
    hipLaunchKernelGGL(fp::fwd_kernel, dim3(grid), dim3(fp::NTHR), fp::LDS_BYTES, stream, a);
#ifdef DIAG
    diag::mixer(d_in, (float*)d_out, (char*)d_ws, (char*)d_ws + 346 * fp::MiB, stream, DIAG_B); return;
#endif
    if (HYB_CUT != 5) ref::run(d_in, (float*)d_out, (char*)d_ws + 29 * fp::MiB, stream, 0, 16, HYB_CUT, (const float*)d_out, (const float*)((char*)d_ws + fp::WS_XC));
}
```

```cpp
#define HYB_CUT 5
#include <hip/hip_runtime.h>
#include <cstdio>
#include <cstdint>
#include <cmath>
namespace ref {
constexpr int D = 1024, NB = 16, L = 2048, LC = 256, S = L + LC;
constexpr int H = 16, QKH = 96, FF = 1024, NE = 16;
constexpr float EPS = 1e-6f;

struct GemmP { const float* A; const float* Bm; float* C; const float* bias; const int* gidx;
               int M, N, K, lda, ldb, ldc; long sA, sB, sC; int sG; int pad; };
__global__ void __launch_bounds__(256) k_gemm(GemmP g) {
    __shared__ float As[16][68]; __shared__ float Bs[16][64];
    const int z = blockIdx.z; const float* A = g.A + z * g.sA; const float* Bm = g.Bm + z * g.sB; float* C = g.C + z * g.sC;
    const int* gi = g.gidx ? g.gidx + z * g.sG : nullptr;
    const int m0 = blockIdx.y * 64, n0 = blockIdx.x * 64, tid = threadIdx.x, tx = tid & 15, ty = tid >> 4;
    float acc[4][4];
#pragma unroll
    for (int i = 0; i < 4; ++i)
#pragma unroll
        for (int j = 0; j < 4; ++j) acc[i][j] = 0.f;
    const int ar = tid >> 2, ak = (tid & 3) * 4; const int arow = m0 + ar; const bool aok = arow < g.M;
    const long aoff = aok ? (long)(gi ? gi[arow] : arow) * g.lda : 0;
    const int bk = tid >> 4, bn = (tid & 15) * 4; const bool bok = (n0 + bn) < g.N;
    for (int k0 = 0; k0 < g.K; k0 += 16) {
        float4 av = aok ? *(const float4*)(A + aoff + k0 + ak) : make_float4(0.f, 0.f, 0.f, 0.f);
        float4 bv = bok ? *(const float4*)(Bm + (long)(k0 + bk) * g.ldb + n0 + bn) : make_float4(0.f, 0.f, 0.f, 0.f);
        As[ak][ar] = av.x; As[ak + 1][ar] = av.y; As[ak + 2][ar] = av.z; As[ak + 3][ar] = av.w;
        *(float4*)&Bs[bk][bn] = bv;
        __syncthreads();
#pragma unroll
        for (int k = 0; k < 16; ++k) {
            const float4 a4 = *(const float4*)&As[k][ty * 4]; const float4 b4 = *(const float4*)&Bs[k][tx * 4];
            acc[0][0] += a4.x * b4.x; acc[0][1] += a4.x * b4.y; acc[0][2] += a4.x * b4.z; acc[0][3] += a4.x * b4.w;
            acc[1][0] += a4.y * b4.x; acc[1][1] += a4.y * b4.y; acc[1][2] += a4.y * b4.z; acc[1][3] += a4.y * b4.w;
            acc[2][0] += a4.z * b4.x; acc[2][1] += a4.z * b4.y; acc[2][2] += a4.z * b4.z; acc[2][3] += a4.z * b4.w;
            acc[3][0] += a4.w * b4.x; acc[3][1] += a4.w * b4.y; acc[3][2] += a4.w * b4.z; acc[3][3] += a4.w * b4.w;
        }
        __syncthreads();
    }
#pragma unroll
    for (int i = 0; i < 4; ++i) { const int row = m0 + ty * 4 + i; if (row < g.M) {
#pragma unroll
        for (int j = 0; j < 4; ++j) { const int col = n0 + tx * 4 + j; if (col < g.N) C[(long)row * g.ldc + col] = acc[i][j] + (g.bias ? g.bias[col] : 0.f); } } }
}
__device__ __forceinline__ float siluf(float v) { return v / (1.f + __expf(-v)); }
__device__ __forceinline__ float block_sum256(float v, float* red) {
#pragma unroll
    for (int o = 32; o > 0; o >>= 1) v += __shfl_xor(v, o);
    __syncthreads();
    if ((threadIdx.x & 63) == 0) red[threadIdx.x >> 6] = v;
    __syncthreads();
    return red[0] + red[1] + red[2] + red[3];
}
__global__ void k_silu(const float* in, float* out, int n) { int i = blockIdx.x * 256 + threadIdx.x; if (i < n) out[i] = siluf(in[i]); }
__global__ void __launch_bounds__(256) k_rms(const float* in, int is, float* out, int os, const float* g, const float* sh, const float* sc, int W) {
    __shared__ float red[4];
    const float* x = in + (long)blockIdx.x * is; float* o = out + (long)blockIdx.x * os;
    float s = 0.f; for (int i = threadIdx.x; i < W; i += 256) { float v = x[i]; s += v * v; }
    s = block_sum256(s, red);
    const float r = rsqrtf(s / (float)W + EPS);
    for (int i = threadIdx.x; i < W; i += 256) { float v = x[i] * r * g[i]; if (sc) v = v * (1.f + sc[i]) + sh[i]; o[i] = v; }
}
__global__ void k_glu(const float* z, float* a, int rows) { int i = blockIdx.x * 256 + threadIdx.x; if (i < rows * 512) { int t = i >> 9, c = i & 511; float v = z[(long)t * 1536 + c], gt = z[(long)t * 1536 + 512 + c]; a[i] = v / (1.f + __expf(-gt)); } }
__global__ void __launch_bounds__(256) k_conv_ln(const float* a, float* cat, const float* cw, const float* cb, const float* lg, const float* lb, int Ls) {
    __shared__ float red[4];
    const int t = blockIdx.x; float v[2];
#pragma unroll
    for (int q = 0; q < 2; ++q) { const int c = threadIdx.x + 256 * q; float s = cb[c];
        for (int j = 0; j < 31; ++j) { const int l = t + j - 15; if (l >= 0 && l < Ls) s += a[(long)l * 512 + c] * cw[j * 512 + c]; }
        v[q] = s; }
    const float mu = block_sum256(v[0] + v[1], red) * (1.f / 512.f);
    const float d0 = v[0] - mu, d1 = v[1] - mu;
    const float var = block_sum256(d0 * d0 + d1 * d1, red) * (1.f / 512.f);
    const float r = rsqrtf(var + EPS);
#pragma unroll
    for (int q = 0; q < 2; ++q) { const int c = threadIdx.x + 256 * q; const float y = (q == 0 ? d0 : d1) * r * lg[c] + lb[c]; cat[(long)t * 1024 + c] = siluf(y); }
}
__global__ void k_resid(float* x, const float* y, const float* gate, int rows) { int i = blockIdx.x * 256 + threadIdx.x; if (i < rows * 1024) x[i] += gate[i & 1023] * y[i]; }
__global__ void k_softmax16(const float* lg, float* aff, int rows) { int t = blockIdx.x * 256 + threadIdx.x; if (t < rows) { float m = -1e30f; for (int e = 0; e < 16; ++e) m = fmaxf(m, lg[t * 16 + e]); float s = 0.f; float p[16];
#pragma unroll
        for (int e = 0; e < 16; ++e) { p[e] = __expf(lg[t * 16 + e] - m); s += p[e]; }
#pragma unroll
        for (int e = 0; e < 16; ++e) aff[t * 16 + e] = p[e] / s; } }
__global__ void __launch_bounds__(256) k_topk(const float* aff, int Ls, int cap, int* idx, float* gate) {
    __shared__ float a[2048];
    const int e = blockIdx.x;
    for (int t = threadIdx.x; t < Ls; t += 256) a[t] = aff[t * 16 + e];
    __syncthreads();
    for (int t = threadIdx.x; t < Ls; t += 256) { const float v = a[t]; int rank = 0;
        for (int j = 0; j < Ls; ++j) { const float w = a[j]; rank += (w > v || (w == v && j < t)) ? 1 : 0; }
        if (rank < cap) { idx[e * 256 + rank] = t; gate[e * 256 + rank] = v; } }
}
__global__ void k_swiglu(float* h1, const float* h3, int cap) { int i = blockIdx.x * 256 + threadIdx.x; if (i < 16 * cap * 1024) { int e = i / (cap * 1024), r = i % (cap * 1024); long o = (long)e * 256 * 1024 + r; h1[o] = siluf(h1[o]) * h3[o]; } }
__global__ void k_scatter(float* x, const float* out, const int* idx, const float* gate, const float* g2, int cap) { int i = blockIdx.x * 256 + threadIdx.x; if (i < 16 * cap * 1024) { int e = i / (cap * 1024), r = i % (cap * 1024), s = r >> 10, n = r & 1023;
        atomicAdd(&x[(long)idx[e * 256 + s] * 1024 + n], g2[n] * gate[e * 256 + s] * out[(long)e * 256 * 1024 + r]); } }
__global__ void k_mk_cs(float* cs, int Ls, float scale) { long i = (long)blockIdx.x * 256 + threadIdx.x; if (i < (long)Ls * Ls) { int k = (int)(i / Ls), l = (int)(i % Ls); int ph = (int)(((long)k * l) % Ls); float s, c; sincospif(2.f * (float)ph / (float)Ls, &s, &c); cs[(long)k * 2 * Ls + l] = c * scale; cs[(long)k * 2 * Ls + Ls + l] = -s * scale; } }
__global__ void k_mk_cc(float* cc, float* sc) { int i = blockIdx.x * 256 + threadIdx.x; if (i < 128 * 128) { int c = i >> 7, m = i & 127; int ph = (c * m) & 127; float s, co; sincospif(2.f * (float)ph / 128.f, &s, &co); cc[i] = co; sc[i] = s; } }
__global__ void k_rope(float* m, int ld, int col0, int hs, int nh, int Ls) { int i = blockIdx.x * 256 + threadIdx.x; if (i < Ls * nh * 16) { int p = i & 15, h = (i >> 4) % nh, t = i / (16 * nh);
        const float pos = (p < 8) ? (float)(t >> 6) : (float)(t & 63); const float inv = __powf(10000.f, -(float)(p & 7) / 8.f); float s, c; sincosf(pos * inv, &s, &c);
        float* q = m + (long)t * ld + col0 + h * hs + 2 * p; const float xe = q[0], xo = q[1]; q[0] = xe * c - xo * s; q[1] = xe * s + xo * c; } }
__global__ void __launch_bounds__(64) k_attn(const float* Q, const float* KV, const float* KR, float* O) {
    const int h = blockIdx.y, q = blockIdx.x * 64 + threadIdx.x;
    float qv[96], o[64];
#pragma unroll
    for (int d = 0; d < 96; ++d) qv[d] = Q[(long)q * 1536 + h * 96 + d] * 0.10206207261596577f;
#pragma unroll
    for (int d = 0; d < 64; ++d) o[d] = 0.f;
    float m = -1e30f, l = 0.f;
    for (int j = 0; j < S; ++j) {
        const float* kn = KV + (long)j * 2048 + h * 128; const float* kr = KR + (long)j * 32; const float* vv = kn + 64;
        float s = 0.f;
#pragma unroll
        for (int d = 0; d < 64; ++d) s += qv[d] * kn[d];
#pragma unroll
        for (int d = 0; d < 32; ++d) s += qv[64 + d] * kr[d];
        const float mn = fmaxf(m, s), al = __expf(m - mn), p = __expf(s - mn);
        l = l * al + p; m = mn;
#pragma unroll
        for (int d = 0; d < 64; ++d) o[d] = o[d] * al + p * vv[d];
    }
    const float il = 1.f / l;
#pragma unroll
    for (int d = 0; d < 64; ++d) O[(long)q * 1024 + h * 64 + d] = o[d] * il;
}
__global__ void k_copy_cols(const float* in, int is, float* out, int os, int rows, int cols) { int i = blockIdx.x * 256 + threadIdx.x; if (i < rows * cols) { int r = i / cols, c = i % cols; out[(long)r * os + c] = in[(long)r * is + c]; } }

struct Bufs { float *SC, *MODS, *CSL, *CSC, *CC, *SCm, *NX, *NU, *NZ, *NA, *NCAT, *NY, *NT1, *NLOG, *NAFF, *NGATE, *NH1, *NH3, *NCQKV, *NCQN, *NCKVN, *NQ, *NKV, *NKR, *NO; int* NIDX; };
inline size_t carve(Bufs& b, char* base) {
    size_t o = 0; auto take = [&](size_t bytes) { char* p = base + o; o += (bytes + 255) & ~(size_t)255; return p; };
    b.SC = (float*)take(17 * 1024 * 4); b.MODS = (float*)take(2 * 17 * 6144 * 4);
    b.CSL = (float*)take((size_t)L * 2 * L * 4); b.CSC = (float*)take((size_t)LC * 2 * LC * 4); b.CC = (float*)take(128 * 128 * 4); b.SCm = (float*)take(128 * 128 * 4);
    b.NX = (float*)take((size_t)S * D * 4); b.NU = (float*)take((size_t)S * D * 4); b.NZ = (float*)take((size_t)S * 1536 * 4); b.NA = (float*)take((size_t)S * 512 * 4);
    b.NCAT = (float*)take((size_t)S * D * 4); b.NY = (float*)take((size_t)2 * L * 512 * 4); b.NT1 = (float*)take((size_t)S * D * 4);
    b.NLOG = (float*)take((size_t)S * 16 * 4); b.NAFF = (float*)take((size_t)S * 16 * 4); b.NGATE = (float*)take(16 * 256 * 4); b.NIDX = (int*)take(16 * 256 * 4);
    b.NH1 = (float*)take((size_t)16 * 256 * 1024 * 4); b.NH3 = (float*)take((size_t)16 * 256 * 1024 * 4);
    b.NCQKV = (float*)take((size_t)S * 416 * 4); b.NCQN = (float*)take((size_t)S * 256 * 4); b.NCKVN = (float*)take((size_t)S * 128 * 4);
    b.NQ = (float*)take((size_t)L * 1536 * 4); b.NKV = (float*)take((size_t)S * 2048 * 4); b.NKR = (float*)take((size_t)S * 32 * 4); b.NO = (float*)take((size_t)L * D * 4);
    return o;
}
inline void gemm(hipStream_t st, const float* A, int lda, const float* Bm, int ldb, float* C, int ldc, int M, int N, int K, const float* bias = nullptr,
                 const int* gidx = nullptr, int nz = 1, long sA = 0, long sB = 0, long sC = 0, int sG = 0) {
    GemmP g{A, Bm, C, bias, gidx, M, N, K, lda, ldb, ldc, sA, sB, sC, sG, 0};
    hipLaunchKernelGGL(k_gemm, dim3((N + 63) / 64, (M + 63) / 64, nz), dim3(256), 0, st, g);
}
#define REF_EW(kern, n, ...) hipLaunchKernelGGL(kern, dim3(((n) + 255) / 256), dim3(256), 0, st, __VA_ARGS__)
struct In { const float *x, *c, *ctx, *c_ctx, *mod_w, *mod_b, *norm1_g, *norm2_g, *ab_w_in, *ab_conv_w, *ab_conv_b, *ab_ln_g, *ab_ln_b, *ab_w_out, *mla_w_in, *mla_q_norm_g, *mla_kv_norm_g,
                  *mla_w_uq, *mla_w_ukv, *mla_w_o, *moe_w_router, *moe_w1, *moe_w3, *moe_w2, *final_g; };
inline In make_in(void* const* d) { In i; const float** p = (const float**)&i; for (int k = 0; k < 25; ++k) p[k] = (const float*)d[k]; return i; }

inline void moe(hipStream_t st, const In& I, Bufs& b, int ly, int r0, int Ls, int mr) {
    const int cap = 2 * Ls / 16; const float* md = b.MODS + ((size_t)ly * 17 + mr) * 6144;
    hipLaunchKernelGGL(k_rms, dim3(Ls), dim3(256), 0, st, b.NX + (size_t)r0 * D, D, b.NU, D, I.norm2_g + ly * D, md + 3 * D, md + 4 * D, D);
    gemm(st, b.NU, D, I.moe_w_router + (size_t)ly * D * 16, 16, b.NLOG, 16, Ls, 16, D);
    REF_EW(k_softmax16, Ls, b.NLOG, b.NAFF, Ls);
    hipLaunchKernelGGL(k_topk, dim3(16), dim3(256), 0, st, b.NAFF, Ls, cap, b.NIDX, b.NGATE);
    const size_t wl = (size_t)ly * 16 * 1024 * 1024;
    gemm(st, b.NU, D, I.moe_w1 + wl, FF, b.NH1, FF, cap, FF, D, nullptr, b.NIDX, 16, 0, 1024 * 1024, 256 * 1024, 256);
    gemm(st, b.NU, D, I.moe_w3 + wl, FF, b.NH3, FF, cap, FF, D, nullptr, b.NIDX, 16, 0, 1024 * 1024, 256 * 1024, 256);
    REF_EW(k_swiglu, 16 * cap * 1024, b.NH1, b.NH3, cap);
    gemm(st, b.NH1, FF, I.moe_w2 + wl, D, b.NH3, D, cap, D, FF, nullptr, nullptr, 16, 256 * 1024, 1024 * 1024, 256 * 1024, 0);
    REF_EW(k_scatter, 16 * cap * 1024, b.NX + (size_t)r0 * D, b.NH3, b.NIDX, b.NGATE, md + 5 * D, cap);
}
inline void mixer_ab(hipStream_t st, const In& I, Bufs& b, int r0, int Ls, int mr) {
    const float* md = b.MODS + ((size_t)0 * 17 + mr) * 6144; const float* cs = (Ls == L) ? b.CSL : b.CSC;
    hipLaunchKernelGGL(k_rms, dim3(Ls), dim3(256), 0, st, b.NX + (size_t)r0 * D, D, b.NU, D, I.norm1_g, md + 0 * D, md + 1 * D, D);
    gemm(st, b.NU, D, I.ab_w_in, 1536, b.NZ, 1536, Ls, 1536, D);
    REF_EW(k_glu, Ls * 512, b.NZ, b.NA, Ls);
    hipLaunchKernelGGL(k_conv_ln, dim3(Ls), dim3(256), 0, st, b.NA, b.NCAT, I.ab_conv_w, I.ab_conv_b, I.ab_ln_g, I.ab_ln_b, Ls);
    gemm(st, b.NZ + 1024, 1536, b.CC, 128, b.NY, 512, Ls, 128, 128, nullptr, nullptr, 4, 128, 0, 128, 0);
    gemm(st, b.NZ + 1024, 1536, b.SCm, 128, b.NY + (size_t)Ls * 512, 512, Ls, 128, 128, nullptr, nullptr, 4, 128, 0, 128, 0);
    gemm(st, cs, 2 * Ls, b.NY, 512, b.NCAT + 512, 1024, Ls, 512, 2 * Ls);
    gemm(st, b.NCAT, D, I.ab_w_out, D, b.NT1, D, Ls, D, D);
    REF_EW(k_resid, Ls * 1024, b.NX + (size_t)r0 * D, b.NT1, md + 2 * D, Ls);
}
inline void run(void* const* d_in, float* d_out, char* ws, hipStream_t st, int b_lo, int b_hi, int start = 0, const float* xl = nullptr, const float* xc = nullptr) {
    In I = make_in(d_in); Bufs b; carve(b, ws);
    REF_EW(k_silu, 16 * 1024, I.c, b.SC, 16 * 1024); REF_EW(k_silu, 1024, I.c_ctx, b.SC + 16 * 1024, 1024);
    for (int ly = 0; ly < 2; ++ly) gemm(st, b.SC, D, I.mod_w + (size_t)ly * D * 6144, 6144, b.MODS + (size_t)ly * 17 * 6144, 6144, 17, 6144, D, I.mod_b + ly * 6144);
    REF_EW(k_mk_cs, L * L, b.CSL, L, 1.f / sqrtf((float)L * 128.f)); REF_EW(k_mk_cs, LC * LC, b.CSC, LC, 1.f / sqrtf((float)LC * 128.f)); REF_EW(k_mk_cc, 128 * 128, b.CC, b.SCm);
    for (int bb = b_lo; bb < b_hi; ++bb) {
        (void)hipMemcpyAsync(b.NX, (start ? xl : I.x) + (size_t)bb * L * D, (size_t)L * D * 4, hipMemcpyDeviceToDevice, st);
        (void)hipMemcpyAsync(b.NX + (size_t)L * D, (start ? xc : I.ctx) + (size_t)bb * LC * D, (size_t)LC * D * 4, hipMemcpyDeviceToDevice, st);
        if (start <= 0) { mixer_ab(st, I, b, 0, L, bb); mixer_ab(st, I, b, L, LC, 16); }
        if (start <= 1) { moe(st, I, b, 0, 0, L, bb); moe(st, I, b, 0, L, LC, 16); }
        if (start <= 2) {
        const float* md = b.MODS + ((size_t)17 + bb) * 6144; const float* mdc = b.MODS + ((size_t)17 + 16) * 6144;
        hipLaunchKernelGGL(k_rms, dim3(L), dim3(256), 0, st, b.NX, D, b.NU, D, I.norm1_g + D, md, md + D, D);
        hipLaunchKernelGGL(k_rms, dim3(LC), dim3(256), 0, st, b.NX + (size_t)L * D, D, b.NU + (size_t)L * D, D, I.norm1_g + D, mdc, mdc + D, D);
        gemm(st, b.NU, D, I.mla_w_in, 416, b.NCQKV, 416, S, 416, D);
        hipLaunchKernelGGL(k_rms, dim3(S), dim3(256), 0, st, b.NCQKV, 416, b.NCQN, 256, I.mla_q_norm_g, (const float*)nullptr, (const float*)nullptr, 256);
        hipLaunchKernelGGL(k_rms, dim3(S), dim3(256), 0, st, b.NCQKV + 256, 416, b.NCKVN, 128, I.mla_kv_norm_g, (const float*)nullptr, (const float*)nullptr, 128);
        gemm(st, b.NCQN, 256, I.mla_w_uq, 1536, b.NQ, 1536, L, 1536, 256);
        gemm(st, b.NCKVN, 128, I.mla_w_ukv, 2048, b.NKV, 2048, S, 2048, 128);
        REF_EW(k_copy_cols, S * 32, b.NCQKV + 384, 416, b.NKR, 32, S, 32);
        REF_EW(k_rope, L * 16 * 16, b.NQ, 1536, 64, 96, 16, L);
        REF_EW(k_rope, L * 1 * 16, b.NKR, 32, 0, 0, 1, L);
        hipLaunchKernelGGL(k_attn, dim3(L / 64, H), dim3(64), 0, st, b.NQ, b.NKV, b.NKR, b.NO);
        gemm(st, b.NO, D, I.mla_w_o, D, b.NT1, D, L, D, D);
        REF_EW(k_resid, L * 1024, b.NX, b.NT1, md + 2 * D, L);
        }
        moe(st, I, b, 1, 0, L, bb);
        hipLaunchKernelGGL(k_rms, dim3(L), dim3(256), 0, st, b.NX, D, d_out + (size_t)bb * L * D, D, I.final_g, (const float*)nullptr, (const float*)nullptr, D);
    }
}
}
namespace pg8 {
#define PG8_LAS __attribute__((address_space(3)))
typedef unsigned short bf16_t;
typedef short bf16x8 __attribute__((ext_vector_type(8)));
typedef float f32x4 __attribute__((ext_vector_type(4)));
typedef unsigned u32x4 __attribute__((ext_vector_type(4)));
constexpr int BM = 256, BK = 64, HALF = 128, HTB = HALF * BK * 2  , STAGE_BYTES = 8 * HTB, NXCD = 8, WGM = 8;

__host__ __device__ __forceinline__ int lds_byte(int r, int c) { const int st = (r >> 4) * 2 + (c >> 5), rr = r & 15, cc = c & 31, ob = rr * 64 + cc * 2; return st * 1024 + (ob ^ (((ob >> 9) & 1) << 5)); }
__host__ __device__ __forceinline__ void stage_rc(int b, int& R, int& C) { const int st = b / 1024, sb = b % 1024, swz = sb ^ (((sb >> 9) & 1) << 5); R = (st >> 1) * 16 + swz / 64; C = (st & 1) * 32 + (swz % 64) / 2; }
__host__ __device__ __forceinline__ int perm32(int rho) { const int n = rho >> 4, i = rho & 15; return 8 * (i >> 2) + 4 * n + (i & 3); }

struct Unit { int pm, pn; };
struct Gemm { const bf16_t* A; const bf16_t* Bt; int M, N, K; };

__device__ __forceinline__ unsigned cvt_pk_bf16(float lo, float hi) { unsigned r; asm volatile("v_cvt_pk_bf16_f32 %0, %1, %2" : "=v"(r) : "v"(lo), "v"(hi)); return r; }
typedef float f32x2 __attribute__((ext_vector_type(2)));
template <class Epi, class Sched, bool ALIGN_EPI = false, bool SP2 = false, bool GATHER = false>
__device__ __forceinline__ void gemm_phase(PG8_LAS unsigned char* lds, const Gemm g, const Sched& S, const Epi& E, const int tid, const PG8_LAS int* rowtab = nullptr) {
    static_assert(!GATHER || SP2, "gather staging is written for the SP2 loop only");
    const int  wid = __builtin_amdgcn_readfirstlane(tid >> 6), lane = tid & 63, wr = wid >> 2, wc = wid & 3, fr = lane & 15, fq = lane >> 4;
    const int K = g.K, nt = K / BK;
    unsigned voffA[2], voffB[2];
#pragma unroll
    for (int i = 0; i < 2; ++i) { int R, C; stage_rc(tid * 16 + i * 8192, R, C); const int Rb = Epi::PERM ? ((R & ~31) + perm32(R & 31)) : R;
        voffA[i] = (unsigned)(R * K + C) * 2u; voffB[i] = (unsigned)(Rb * K + C) * 2u; }
    int RA[2], CA2[2];
#pragma unroll
    for (int i = 0; i < 2; ++i) { int R, C; stage_rc(tid * 16 + i * 8192, R, C); RA[i] = R; CA2[i] = C * 2; }
    unsigned vAc[2][2], vAn[2][2];
#define PG8_GOFF(dst, ord) do { _Pragma("unroll") for (int h_ = 0; h_ < 2; ++h_) _Pragma("unroll") for (int i_ = 0; i_ < 2; ++i_) \
        dst[h_][i_] = (unsigned)rowtab[(ord) * 256 + h_ * HALF + RA[i_]] * (unsigned)(K * 2) + (unsigned)CA2[i_]; } while (0)
    const size_t kstep = (size_t)(BK * 2);
    const size_t hstep = (size_t)HALF * K * 2;
    const size_t tstep = 2 * hstep;
    const unsigned ldsw = (unsigned)wid * 1024u;
    const int aoff = lds_byte(wr * 64 + fr, fq * 8), boff = lds_byte(wc * 32 + fr, fq * 8);
#define PG8_SA(b, h) (((b) * 2 + (h)) * HTB)
#define PG8_SB(b, h) ((4 + (b) * 2 + (h)) * HTB)
#define PG8_STAGE(bufoff, gbase, voff) do { _Pragma("unroll") for (int _i = 0; _i < 2; ++_i) \
        __builtin_amdgcn_global_load_lds((const unsigned*)((const char*)(gbase) + (voff)[_i]), (PG8_LAS unsigned*)(lds + (bufoff) + ldsw + _i * 8192), 16, 0, 0); } while (0)
#define PG8_STAGE_A(b, h, useNext, koff) do { if constexpr (GATHER) { const unsigned v_[2] = {(useNext) ? vAn[h][0] : vAc[h][0], (useNext) ? vAn[h][1] : vAc[h][1]}; \
            PG8_STAGE(PG8_SA(b, h), (const char*)g.A + (koff), v_); } \
        else PG8_STAGE(PG8_SA(b, h), ((useNext) ? nA : cA) + (koff) + (size_t)(h) * hstep, voffA); } while (0)
#define PG8_LDA(dst, b, h) do { _Pragma("unroll") for (int m = 0; m < 4; ++m) _Pragma("unroll") for (int k = 0; k < 2; ++k) dst[m][k] = *(const PG8_LAS bf16x8*)(lds + PG8_SA(b, h) + aoff + m * 2048 + k * 1024); } while (0)
#define PG8_LDB(dst, b, h) do { _Pragma("unroll") for (int n = 0; n < 2; ++n) _Pragma("unroll") for (int k = 0; k < 2; ++k) dst[n][k] = *(const PG8_LAS bf16x8*)(lds + PG8_SB(b, h) + boff + n * 2048 + k * 1024); } while (0)
#define PG8_MMA(ai, bj, At, Bt) do { __builtin_amdgcn_s_setprio(1); _Pragma("unroll") for (int m = 0; m < 4; ++m) _Pragma("unroll") for (int n = 0; n < 2; ++n) _Pragma("unroll") for (int k = 0; k < 2; ++k) \
        acc[ai][bj][m][n] = __builtin_amdgcn_mfma_f32_16x16x32_bf16(Bt[n][k], At[m][k], acc[ai][bj][m][n], 0, 0, 0); __builtin_amdgcn_s_setprio(0); } while (0)
#define PG8_WAIT_V(n) asm volatile("s_waitcnt vmcnt(" #n ")" ::: "memory")
#define PG8_WAIT_L(n) asm volatile("s_waitcnt lgkmcnt(" #n ")" ::: "memory")
#define PG8_BAR __builtin_amdgcn_s_barrier()
#define PG8_SCHED __builtin_amdgcn_sched_barrier(0)
    Unit cur, nxt; int ui = 0;
    if (!S.next(0, cur)) return;
    f32x4 acc[2][2][4][2];
#pragma unroll
    for (int a = 0; a < 2; ++a)
#pragma unroll
        for (int b = 0; b < 2; ++b)
#pragma unroll
            for (int m = 0; m < 4; ++m)
#pragma unroll
                for (int n = 0; n < 2; ++n) acc[a][b][m][n] = (f32x4){0.f, 0.f, 0.f, 0.f};
    bf16x8 At[4][2], B0[2][2], B1[2][2];
    const char* cA = GATHER ? (const char*)g.A : (const char*)g.A + (size_t)cur.pm * tstep; const char* cB = (const char*)g.Bt + (size_t)cur.pn * tstep;
    if constexpr (GATHER) { PG8_GOFF(vAc, 0); PG8_GOFF(vAn, 0); }
    S.a_ready(cur);
    if constexpr (SP2) {
        const char* const nA = cA;
        PG8_STAGE(PG8_SB(0, 0), cB, voffB); PG8_STAGE(PG8_SB(0, 1), cB + hstep, voffB); PG8_STAGE_A(0, 0, false, (size_t)0); PG8_STAGE_A(0, 1, false, (size_t)0);
        if (wr == 1) PG8_BAR;
        PG8_WAIT_V(2); PG8_BAR;
        PG8_STAGE(PG8_SB(1, 0), cB + kstep, voffB); PG8_STAGE_A(1, 0, false, kstep); PG8_STAGE(PG8_SB(1, 1), cB + hstep + kstep, voffB);
        PG8_WAIT_V(6); PG8_BAR;
    } else {
        PG8_STAGE(PG8_SB(0, 0), cB, voffB); PG8_STAGE(PG8_SA(0, 0), cA, voffA); PG8_STAGE(PG8_SB(0, 1), cB + hstep, voffB); PG8_STAGE(PG8_SA(0, 1), cA + hstep, voffA);
        if (wr == 1) PG8_BAR;
        PG8_WAIT_V(4); PG8_BAR;
        PG8_STAGE(PG8_SB(1, 0), cB + kstep, voffB); PG8_STAGE(PG8_SA(1, 0), cA + kstep, voffA); PG8_STAGE(PG8_SB(1, 1), cB + hstep + kstep, voffB);
        PG8_WAIT_V(6); PG8_BAR;
    }
    for (;;) {
        const bool has_next = S.next(ui + 1, nxt);
        const char* nA = (has_next && !GATHER) ? (const char*)g.A + (size_t)nxt.pm * tstep : cA; const char* nB = has_next ? (const char*)g.Bt + (size_t)nxt.pn * tstep : cB;
        if constexpr (GATHER) { if (has_next) PG8_GOFF(vAn, ui + 1); else { _Pragma("unroll") for (int h_ = 0; h_ < 2; ++h_) _Pragma("unroll") for (int i_ = 0; i_ < 2; ++i_) vAn[h_][i_] = vAc[h_][i_]; } }
        asm volatile(".p2align 8" ::: "memory");
        for (int t = 0; t < nt; t += 2) {
            const bool last = (t == nt - 2);
            const size_t k1 = (size_t)(t + 1) * kstep, k2 = last ? (size_t)0 : (size_t)(t + 2) * kstep, k3 = k2 + kstep;
            const char* a1 = cA + k1; const char* a2 = (last ? nA : cA) + k2; const char* b2 = last ? nB : cB + (size_t)(t + 2) * kstep;
            const char* a3 = a2 + kstep; const char* b3 = b2 + kstep; (void)a1; (void)a3;
            if (last && has_next) S.a_ready(nxt);
            if constexpr (SP2) {
            PG8_LDB(B0, 0, 0); PG8_LDB(B1, 0, 1); PG8_SCHED; PG8_LDA(At, 0, 0); PG8_STAGE_A(1, 1, false, k1);
            PG8_WAIT_V(8); PG8_WAIT_L(0); PG8_BAR; PG8_MMA(0, 0, At, B0); PG8_MMA(0, 1, At, B1); PG8_BAR; PG8_SCHED;
            PG8_LDA(At, 0, 1); PG8_STAGE(PG8_SB(0, 0), b2, voffB); PG8_STAGE(PG8_SB(0, 1), b2 + hstep, voffB); PG8_STAGE_A(0, 0, last, k2);
            PG8_WAIT_V(8); PG8_WAIT_L(0); PG8_BAR; PG8_MMA(1, 0, At, B0); PG8_MMA(1, 1, At, B1); PG8_BAR; PG8_SCHED;
            PG8_LDB(B0, 1, 0); PG8_LDB(B1, 1, 1); PG8_SCHED; PG8_LDA(At, 1, 0); PG8_STAGE_A(0, 1, last, k2);
            PG8_WAIT_V(8); PG8_WAIT_L(0); PG8_BAR; PG8_MMA(0, 0, At, B0); PG8_MMA(0, 1, At, B1); PG8_BAR; PG8_SCHED;
            PG8_LDA(At, 1, 1); PG8_STAGE(PG8_SB(1, 0), b3, voffB); PG8_STAGE(PG8_SB(1, 1), b3 + hstep, voffB); PG8_STAGE_A(1, 0, last, k3);
            PG8_WAIT_V(8); PG8_WAIT_L(0); PG8_BAR; PG8_MMA(1, 0, At, B0); PG8_MMA(1, 1, At, B1); PG8_BAR; PG8_SCHED;
            } else {
            PG8_LDB(B0, 0, 0); PG8_SCHED; PG8_LDA(At, 0, 0); PG8_STAGE(PG8_SA(1, 1), a1 + hstep, voffA);
            PG8_WAIT_L(8); PG8_BAR; PG8_WAIT_L(0); PG8_MMA(0, 0, At, B0); PG8_BAR; PG8_SCHED;
            PG8_LDB(B1, 0, 1); PG8_STAGE(PG8_SB(0, 0), b2, voffB);
            PG8_BAR; PG8_WAIT_L(0); PG8_MMA(0, 1, At, B1); PG8_BAR;
            PG8_LDA(At, 0, 1); PG8_STAGE(PG8_SA(0, 0), a2, voffA);
            PG8_BAR; PG8_WAIT_L(0); PG8_MMA(1, 0, At, B0); PG8_BAR; PG8_SCHED;
            PG8_STAGE(PG8_SB(0, 1), b2 + hstep, voffB);
            PG8_WAIT_V(6); PG8_BAR; PG8_MMA(1, 1, At, B1); PG8_BAR;
            PG8_LDB(B0, 1, 0); PG8_SCHED; PG8_LDA(At, 1, 0); PG8_STAGE(PG8_SA(0, 1), a2 + hstep, voffA);
            PG8_WAIT_L(8); PG8_BAR; PG8_WAIT_L(0); PG8_MMA(0, 0, At, B0); PG8_BAR; PG8_SCHED;
            PG8_LDB(B1, 1, 1); PG8_STAGE(PG8_SB(1, 0), b3, voffB);
            PG8_BAR; PG8_WAIT_L(0); PG8_MMA(0, 1, At, B1); PG8_BAR;
            PG8_LDA(At, 1, 1); PG8_STAGE(PG8_SA(1, 0), a3, voffA);
            PG8_BAR; PG8_WAIT_L(0); PG8_MMA(1, 0, At, B0); PG8_BAR; PG8_SCHED;
            PG8_STAGE(PG8_SB(1, 1), b3 + hstep, voffB);
            PG8_WAIT_V(6); PG8_BAR; PG8_MMA(1, 1, At, B1); PG8_BAR;
            }
        }
        if constexpr (ALIGN_EPI) { if (wr == 0) PG8_BAR; }
        if constexpr (!Epi::AFTER_DRAIN) { E(acc, cur, wr, wc, fr, fq); S.done(cur); }
        if (!has_next) break;
#pragma unroll
        for (int a = 0; a < 2; ++a)
#pragma unroll
            for (int b = 0; b < 2; ++b)
#pragma unroll
                for (int m = 0; m < 4; ++m)
#pragma unroll
                    for (int n = 0; n < 2; ++n) acc[a][b][m][n] = (f32x4){0.f, 0.f, 0.f, 0.f};
        cur = nxt; cA = nA; cB = nB; ++ui;
        if constexpr (GATHER) { _Pragma("unroll") for (int h_ = 0; h_ < 2; ++h_) _Pragma("unroll") for (int i_ = 0; i_ < 2; ++i_) vAc[h_][i_] = vAn[h_][i_]; }
        if constexpr (ALIGN_EPI) { if (wr == 1) PG8_BAR; }
    }
    PG8_WAIT_V(0);
    if constexpr (!ALIGN_EPI) { if (wr == 0) PG8_BAR; }
    PG8_BAR;
    if constexpr (Epi::AFTER_DRAIN) { E.fused(acc, cur, wr, wc, fr, fq, lds, wid, lane); S.done(cur); }
#undef PG8_SA
#undef PG8_SB
#undef PG8_STAGE
#undef PG8_STAGE_A
#undef PG8_GOFF
#undef PG8_LDA
#undef PG8_LDB
#undef PG8_MMA
#undef PG8_WAIT_V
#undef PG8_WAIT_L
#undef PG8_BAR
#undef PG8_SCHED
}
}
#define GAS __attribute__((address_space(1)))
#define LAS __attribute__((address_space(3)))
typedef unsigned short bf16;
typedef unsigned v4u __attribute__((ext_vector_type(4)));
typedef float f32x4 __attribute__((ext_vector_type(4)));
typedef short bf16x8 __attribute__((ext_vector_type(8)));
typedef GAS unsigned gu32;
typedef GAS unsigned long long gu64;
#define RLX_AGENT __ATOMIC_RELAXED, __HIP_MEMORY_SCOPE_AGENT
#define LDS_WAIT() asm volatile("s_waitcnt lgkmcnt(0)" ::: "memory")
#define VM_WAIT() asm volatile("s_waitcnt vmcnt(0)" ::: "memory")
__device__ __forceinline__ unsigned long long rt() { return __builtin_amdgcn_s_memrealtime(); }
__device__ __forceinline__ unsigned f2bf(float f) { unsigned u = __builtin_bit_cast(unsigned, f); return (u + 0x7fffu + ((u >> 16) & 1u)) >> 16; }
__device__ __forceinline__ unsigned pk2(float lo, float hi) { return f2bf(lo) | (f2bf(hi) << 16); }
#define XB_TMO      128
#define XB_XCNT(j)  (256  + 64 * (j))
#define XB_XSUB(j)  (1280 + 64 * (j))
#define XB_XGEN(j)  (2304 + 64 * (j))
#define XB_TOP      3328
#define XB_TOPGEN   3392
#define XCD_BAR_WORDS 3456
#define XB_SPIN_CAP (1u << 18)

__device__ __forceinline__ unsigned xb_ld(unsigned* p)              { return __hip_atomic_load(p, __ATOMIC_RELAXED, __HIP_MEMORY_SCOPE_AGENT); }
__device__ __forceinline__ unsigned xb_add(unsigned* p, unsigned v) { return __hip_atomic_fetch_add(p, v, __ATOMIC_RELAXED, __HIP_MEMORY_SCOPE_AGENT); }
__device__ __forceinline__ unsigned xb_xcc_id() { return (unsigned)__builtin_amdgcn_s_getreg((3 << 11) | 20) & 0xFu; }
#define XB_SPIN(cond, bar) do { unsigned _sp = 0; while (cond) { __builtin_amdgcn_s_sleep(1); \
    if ((++_sp & 255u) == 0u) { if (xb_ld(&(bar)[XB_TMO])) break; if (_sp > XB_SPIN_CAP) { atomicAdd(&(bar)[XB_TMO], 1u); break; } } } } while (0)

struct XcdBarrier {
    unsigned* bar; unsigned x;
    volatile LAS unsigned* st;
};

__device__ __forceinline__ XcdBarrier xcd_barrier_post(unsigned* bar, volatile LAS unsigned* st) {
    XcdBarrier b; b.bar = bar; b.x = xb_xcc_id(); b.st = st;
    if (threadIdx.x == 0) (void)xb_add(&bar[XB_XCNT(b.x)], 1u);
    return b;
}
__device__ __forceinline__ void xcd_barrier_complete(unsigned* bar, unsigned x, unsigned& nloc, unsigned& nx) {
    const unsigned G = gridDim.x * gridDim.y * gridDim.z;
    unsigned sum, cnt, mine, sp = 0u;
    for (;;) {
        sum = 0u; cnt = 0u; mine = 0u;
#pragma unroll
        for (unsigned j = 0; j < 16; ++j) { const unsigned c = xb_ld(&bar[XB_XCNT(j)]); sum += c; cnt += (c > 0u) ? 1u : 0u; mine = (j == x) ? c : mine; }
        if (sum == G) break;
        __builtin_amdgcn_s_sleep(1);
        if ((++sp & 255u) == 0u) { if (xb_ld(&bar[XB_TMO])) break; if (sp > XB_SPIN_CAP) { atomicAdd(&bar[XB_TMO], 1u); break; } }
    }
    nloc = mine > 0u ? mine : 1u; nx = cnt > 0u ? cnt : 1u;
}

__device__ __forceinline__ void xcd_barrier(const XcdBarrier& b) {
    asm volatile("s_waitcnt vmcnt(0)" ::: "memory");
    __syncthreads();
    if (threadIdx.x == 0) {
        unsigned* bar = b.bar;
        __builtin_amdgcn_s_waitcnt(0);
        unsigned nloc = b.st[0], nx = b.st[1];
        if (nloc == 0u) { xcd_barrier_complete(bar, b.x, nloc, nx); b.st[0] = nloc; b.st[1] = nx; }
        const unsigned old = xb_add(&bar[XB_XSUB(b.x)], 1u);
        const unsigned gen = old / nloc;
        if (old + 1u == (gen + 1u) * nloc) {
            __builtin_amdgcn_fence(__ATOMIC_RELEASE, "agent");
            asm volatile("s_waitcnt vmcnt(0)" ::: "memory");
            const unsigned og = xb_add(&bar[XB_TOP], 1u);
            const unsigned tg = og / nx;
            if (og + 1u == (tg + 1u) * nx) xb_add(&bar[XB_TOPGEN], 1u);
            else XB_SPIN(xb_ld(&bar[XB_TOPGEN]) == tg, bar);
            __builtin_amdgcn_fence(__ATOMIC_ACQUIRE, "agent");
            xb_add(&bar[XB_XGEN(b.x)], 1u);
            asm volatile("s_waitcnt vmcnt(0)" ::: "memory");
        } else {
            XB_SPIN(xb_ld(&bar[XB_XGEN(b.x)]) == gen, bar);
            __builtin_amdgcn_fence(__ATOMIC_ACQUIRE, "agent");
            asm volatile("s_waitcnt vmcnt(0)" ::: "memory");
        }
    }
    __syncthreads();
}
namespace fp {
using pg8::Unit; using pg8::Gemm; using pg8::cvt_pk_bf16; using pg8::u32x4;
typedef unsigned u32x2v __attribute__((ext_vector_type(2)));
constexpr int D = 1024, NB = 16, L = 2048, LC = 256, TL = NB * L, TC = NB * LC, T = TL + TC;
constexpr int NWAVES = 8, NTHR = 512;
constexpr int ER = 4608;
constexpr float EPS = 1e-6f;
constexpr size_t MiB = 1u << 20;
constexpr size_t WS_CTL = 0, CTL_ZERO_BYTES = 1 * MiB;
constexpr size_t WS_MODS = 1 * MiB;
constexpr size_t WS_ROPE = 2 * MiB;
constexpr size_t WS_GATE = 3 * MiB;
constexpr size_t WS_AROW = WS_GATE + 512 * 1024;
constexpr size_t WS_AFF = 4 * MiB;
constexpr size_t WS_INV = 7 * MiB;
constexpr size_t WS_KR = 10 * MiB;
constexpr size_t WS_XC = 13 * MiB;
constexpr size_t WS_WOUT = 29 * MiB;
constexpr size_t WS_WMLA = 31 * MiB;
constexpr size_t WS_WUQ = 32 * MiB;
constexpr size_t WS_WUKV = WS_WUQ + 1536 * 256 * 2;
constexpr size_t WS_WO = 34 * MiB;
constexpr size_t WS_CS = 36 * MiB;
constexpr size_t WS_CSC = 52 * MiB;
constexpr size_t WS_UW = 53 * MiB;
constexpr size_t WS_WTY = WS_UW + (size_t)T * D * 2, WS_WTG = WS_WTY + 2 * MiB;
constexpr size_t WS_CQN = WS_UW, WS_CKVN = WS_UW + (size_t)T * 256 * 2, WS_O = WS_UW;
constexpr size_t WS_R1 = 129 * MiB;
constexpr size_t WS_AG = WS_R1, WS_YT = WS_R1 + 36 * MiB, WS_YTC = WS_R1 + 100 * MiB;
constexpr size_t WS_Q = WS_R1, WS_CQKV = WS_R1 + 96 * MiB;
constexpr size_t WS_R2 = 273 * MiB;
constexpr size_t WS_KN = WS_R2, WS_V = WS_R2 + 72 * MiB;
constexpr size_t WS_AP = WS_R2 + 72 * MiB;
constexpr size_t WS_W13 = 417 * MiB, WS_W2 = 481 * MiB, WS_Y1 = 513 * MiB, WS_END = 577 * MiB;
constexpr int CW_BAR = 4096;
constexpr int RING_BYTES = 131072, LDS_BYTES = 144 * 1024, LDSCTL_OFF = LDS_BYTES - 1024, MISC_OFF = LDSCTL_OFF + 320, XTRA_OFF = 133120;

constexpr int PTR_OFF = LDSCTL_OFF + 512;
struct Ctx {
    float* out; unsigned char* ws; LAS unsigned char* lds;
    int tid, lane, wave, vcu, G, gw, NGW;
    __device__ __forceinline__ const float* in(int i) const {
        volatile LAS unsigned* p = (volatile LAS unsigned*)(lds + PTR_OFF) + 2 * i; unsigned lo = p[0], hi = p[1];
        lo = __builtin_amdgcn_readfirstlane(lo); hi = __builtin_amdgcn_readfirstlane(hi); return (const float*)(((unsigned long long)hi << 32) | lo); }
};
#define WSP(T_, off) ((T_*)(F.ws + (off)))
__device__ __forceinline__ int swz_xor(int v, int o) {
    switch (o) { case 1: return __builtin_amdgcn_ds_swizzle(v, (1 << 10) | 0x1f); case 2: return __builtin_amdgcn_ds_swizzle(v, (2 << 10) | 0x1f); case 4: return __builtin_amdgcn_ds_swizzle(v, (4 << 10) | 0x1f);
                 case 8: return __builtin_amdgcn_ds_swizzle(v, (8 << 10) | 0x1f); default: return __builtin_amdgcn_ds_swizzle(v, (16 << 10) | 0x1f); } }
__device__ __forceinline__ float wave_sum(float v) {
    v += __builtin_bit_cast(float, swz_xor(__builtin_bit_cast(int, v), 1)); v += __builtin_bit_cast(float, swz_xor(__builtin_bit_cast(int, v), 2));
    v += __builtin_bit_cast(float, swz_xor(__builtin_bit_cast(int, v), 4)); v += __builtin_bit_cast(float, swz_xor(__builtin_bit_cast(int, v), 8));
    v += __builtin_bit_cast(float, swz_xor(__builtin_bit_cast(int, v), 16));
    const int bits = __builtin_bit_cast(int, v);
    return __builtin_bit_cast(float, __builtin_amdgcn_readlane(bits, 0)) + __builtin_bit_cast(float, __builtin_amdgcn_readlane(bits, 32));
}
__device__ __forceinline__ int wave_sum_i(int v) {
    v += swz_xor(v, 1); v += swz_xor(v, 2); v += swz_xor(v, 4); v += swz_xor(v, 8); v += swz_xor(v, 16);
    return __builtin_amdgcn_readlane(v, 0) + __builtin_amdgcn_readlane(v, 32);
}
__device__ __forceinline__ float siluf(float v) { return v / (1.f + __expf(-v)); }
__device__ __forceinline__ float bf2f(unsigned short h) { return __builtin_bit_cast(float, (unsigned)h << 16); }

__device__ __forceinline__ void p0_mods(Ctx& F) {
    LAS float* sc = (LAS float*)F.lds;
    LAS float* red = (LAS float*)(F.lds + 17 * 1024 * 4);
    { const float* c_ = F.in(1); const float* cc_ = F.in(3); f32x4 cv[9];
#pragma unroll
      for (int q = 0; q < 9; ++q) { const int i4 = F.tid + q * NTHR; if (i4 < 17 * 256) cv[q] = i4 < 16 * 256 ? *(const GAS f32x4*)(c_ + 4 * i4) : *(const GAS f32x4*)(cc_ + 4 * (i4 - 16 * 256)); }
#pragma unroll
      for (int q = 0; q < 9; ++q) { const int i4 = F.tid + q * NTHR; if (i4 < 17 * 256) { f32x4 o; o.x = siluf(cv[q].x); o.y = siluf(cv[q].y); o.z = siluf(cv[q].z); o.w = siluf(cv[q].w); *(LAS f32x4*)(sc + 4 * i4) = o; } } }
    __syncthreads();
    float* MODS = WSP(float, WS_MODS);
    for (int item = blockIdx.x; item < 192; item += F.G) {
        const int ly = item / 96, n0 = (item % 96) * 64, k0 = F.wave * 128;
        const float* W = F.in(4) + (size_t)ly * 1024 * 6144 + n0 + F.lane;
        float acc[17];
#pragma unroll
        for (int r = 0; r < 17; ++r) acc[r] = 0.f;
#pragma unroll 1
        for (int kb = 0; kb < 128; kb += 16) { float w[16];
#pragma unroll
            for (int q = 0; q < 16; ++q) w[q] = __builtin_nontemporal_load((const GAS float*)(W + (size_t)(k0 + kb + q) * 6144));
#pragma unroll
            for (int q = 0; q < 16; ++q)
#pragma unroll
                for (int r = 0; r < 17; ++r) acc[r] += sc[r * 1024 + k0 + kb + q] * w[q]; }
#pragma unroll
        for (int r = 0; r < 17; ++r) red[(F.wave * 17 + r) * 64 + F.lane] = acc[r];
        __syncthreads();
        const float* mb_ = F.in(5); const float bias = *(const GAS float*)(mb_ + ly * 6144 + n0 + (F.tid & 63));
        for (int o = F.tid; o < 17 * 64; o += NTHR) { const int r = o >> 6, c = o & 63; float s = bias;
#pragma unroll
            for (int w = 0; w < 8; ++w) s += red[(w * 17 + r) * 64 + c];
            MODS[(size_t)(ly * 17 + r) * 6144 + n0 + c] = s; }
        __syncthreads();
    }
}
struct MapId { int off; __device__ __forceinline__ int operator()(int n) const { return off + n; } };
struct MapGlu { __device__ __forceinline__ int operator()(int n) const { const int s = n >> 9, c = n & 511; return (c >> 7) * 256 + s * 128 + (c & 127); } };
struct Map13 { int s; __device__ __forceinline__ int operator()(int n) const { return (n >> 7) * 256 + s * 128 + (n & 127); } };
template <class RowMap>
__device__ __forceinline__ void tr_write(LAS float* scr, bf16* WT, int ldt, int k0, int n0, RowMap rm, int lane) {
    const int c = lane & 7;
#pragma unroll
    for (int j = 0; j < 4; ++j) { const int n = (lane >> 3) + 8 * j; const LAS float* s = scr + (8 * c) * 33 + n;
        v4u o; o.x = pk2(s[0 * 33], s[1 * 33]); o.y = pk2(s[2 * 33], s[3 * 33]); o.z = pk2(s[4 * 33], s[5 * 33]); o.w = pk2(s[6 * 33], s[7 * 33]);
        *(GAS v4u*)(WT + (size_t)rm(n0 + n) * ldt + k0 + 8 * c) = o; }
    LDS_WAIT(); asm volatile("" ::: "memory");
}
template <class RowMap>
__device__ __forceinline__ void tr_item(const float* W, int ldw, int nblk, bf16* WT, int ldt, RowMap rm, LAS float* scr, int item, int lane) {
    const int kb = item / nblk, nb = item % nblk, k0 = 64 * kb, n0 = 32 * nb;
    f32x4 t[8];
#pragma unroll
    for (int i = 0; i < 8; ++i) t[i] = __builtin_nontemporal_load((const GAS f32x4*)(W + (size_t)(k0 + 8 * i + (lane >> 3)) * ldw + n0 + 4 * (lane & 7)));
#pragma unroll
    for (int i = 0; i < 8; ++i) { LAS float* d = scr + (8 * i + (lane >> 3)) * 33 + 4 * (lane & 7); d[0] = t[i].x; d[1] = t[i].y; d[2] = t[i].z; d[3] = t[i].w; }
    LDS_WAIT(); asm volatile("" ::: "memory");
    tr_write(scr, WT, ldt, k0, n0, rm, lane);
}
__device__ __forceinline__ void wy_item(Ctx& F, LAS float* scr, LAS float* wst  , const LAS float* tab, int item) {
    const int lane = F.lane, kb = item >> 5, nb = item & 31, k0 = 64 * kb, n0 = 32 * nb;
    const int half = n0 >> 9, g = (n0 >> 7) & 3, m = (n0 & 127) + (lane & 31), kh = lane >> 5;
    const float* Wi = F.in(8) + (size_t)k0 * 1536 + 1024 + g * 128;
#pragma unroll 8
    for (int i = 0; i < 32; ++i) { const int kk = 2 * i + (lane >> 5), cc = (lane & 31) * 4; *(LAS f32x4*)(wst + kk * 128 + cc) = *(const GAS f32x4*)(Wi + (size_t)kk * 1536 + cc); }
    LDS_WAIT(); asm volatile("" ::: "memory");
    float sacc[32];
#pragma unroll
    for (int i = 0; i < 32; ++i) sacc[i] = 0.f;
#pragma unroll 1
    for (int ch = 0; ch < 4; ++ch) { float tw[32];
#pragma unroll
        for (int j = 0; j < 32; ++j) tw[j] = tab[((ch * 32 + j) * m + (half ? 96 : 0)) & 127];
#pragma unroll
        for (int i = 0; i < 32; ++i) { const LAS float* wr_ = wst + (2 * i + kh) * 128 + ch * 32;
#pragma unroll
            for (int j4 = 0; j4 < 8; ++j4) { const f32x4 w = *(const LAS f32x4*)(wr_ + 4 * j4);
                sacc[i] += (w.x * tw[4 * j4] + w.y * tw[4 * j4 + 1]) + (w.z * tw[4 * j4 + 2] + w.w * tw[4 * j4 + 3]); } } }
#pragma unroll
    for (int i = 0; i < 32; ++i) scr[(2 * i + kh) * 33 + (lane & 31)] = sacc[i];
    LDS_WAIT(); asm volatile("" ::: "memory");
    tr_write(scr, WSP(bf16, WS_WTY), 1024, k0, n0, MapId{0}, lane);
}
__device__ __forceinline__ void moe_w_items(Ctx& F, int ly, LAS float* scr, int it0 = 0, int it1 = 16 * 1536, int widx = -1, int nwork = 0, int mode = 0) {
    if (widx < 0) { widx = F.gw; nwork = F.NGW; }
    const size_t wl = (size_t)ly * 16 * 1024 * 1024;
    for (int j_ = it0 + widx; j_ < it1; j_ += nwork) { const int it = mode == 0 ? j_ : (mode == 1 ? (j_ >> 10) * 1536 + (j_ & 1023) : (j_ >> 9) * 1536 + 1024 + (j_ & 511));
        const int e = it / 1536, r = it % 1536, which = r >> 9, item = r & 511;
        if (which == 0) tr_item(F.in(21) + wl + (size_t)e * 1048576, 1024, 32, WSP(bf16, WS_W13) + (size_t)e * 2048 * 1024, 1024, Map13{0}, scr, item, F.lane);
        else if (which == 1) tr_item(F.in(22) + wl + (size_t)e * 1048576, 1024, 32, WSP(bf16, WS_W13) + (size_t)e * 2048 * 1024, 1024, Map13{1}, scr, item, F.lane);
        else tr_item(F.in(23) + wl + (size_t)e * 1048576, 1024, 32, WSP(bf16, WS_W2) + (size_t)e * 1024 * 1024, 1024, MapId{0}, scr, item, F.lane);
    }
}
constexpr int MW0_A = 0, MW0_B = 10240;
__device__ __forceinline__ void p0_rest(Ctx& F) {
    LAS float* tab128 = (LAS float*)(F.lds + XTRA_OFF); LAS float* tab2048 = tab128 + 128; LAS float* tab256 = tab2048 + 2048;
    for (int i = F.tid; i < 128 + 2048 + 256; i += NTHR) { float s, c;
        if (i < 128) sincospif(2.f * (float)i / 128.f, &s, &c); else if (i < 128 + 2048) sincospif(2.f * (float)(i - 128) / 2048.f, &s, &c); else sincospif(2.f * (float)(i - 2176) / 256.f, &s, &c);
        tab128[i] = c; }
    __syncthreads();
    LAS float* scr = (LAS float*)(F.lds + F.wave * 8448);
    constexpr int I_G = 512, I_OUT = 512, I_MLA = 16 * 13, I_UQ = 4 * 48, I_UKV = 2 * 64, I_O = 512;
    constexpr int NI = I_G + I_OUT + I_MLA + I_UQ + I_UKV + I_O;
    for (int it = F.gw; it < NI; it += F.NGW) { int r = it;
        if (r < I_G) { tr_item(F.in(8), 1536, 32, WSP(bf16, WS_WTG), 1024, MapGlu{}, scr, r, F.lane); continue; } r -= I_G;
        if (r < I_OUT) { tr_item(F.in(13), 1024, 32, WSP(bf16, WS_WOUT), 1024, MapId{0}, scr, r, F.lane); continue; } r -= I_OUT;
        if (r < I_MLA) { tr_item(F.in(14), 416, 13, WSP(bf16, WS_WMLA), 1024, MapId{0}, scr, r, F.lane); continue; } r -= I_MLA;
        if (r < I_UQ) { tr_item(F.in(17), 1536, 48, WSP(bf16, WS_WUQ), 256, MapId{0}, scr, r, F.lane); continue; } r -= I_UQ;
        if (r < I_UKV) { tr_item(F.in(18), 2048, 64, WSP(bf16, WS_WUKV), 128, MapId{0}, scr, r, F.lane); continue; } r -= I_UKV;
        tr_item(F.in(19), 1024, 32, WSP(bf16, WS_WO), 1024, MapId{0}, scr, r, F.lane);
    }
    if (F.wave < 2) { LAS float* w2 = (LAS float*)(F.lds + 8 * 8448 + F.wave * 32768);
        for (int it = F.vcu * 2 + F.wave; it < 512; it += F.G * 2) wy_item(F, scr, w2, tab128, it); }
    { v4u z = {0u, 0u, 0u, 0u};
      for (int i = F.gw * 64 + F.lane; i < 96 * 128; i += F.NGW * 64) *(GAS v4u*)(WSP(bf16, WS_WMLA) + (size_t)416 * 1024 + (size_t)i * 8) = z;
    }
    { const float sc = 1.f / sqrtf(2048.f * 128.f);
      for (int id = F.gw * 64 + F.lane; id < 256 * 64; id += F.NGW * 64) { const int k = id >> 6, l0 = (id & 63) * 8; float v[8];
#pragma unroll
          for (int j = 0; j < 8; ++j) { const int lp = l0 + j, l = lp & 255; int ph = (k * l) & 255; float x; if (lp < 256) x = tab256[ph]; else x = tab256[(ph + 192) & 255]; v[j] = x * sc; }
          v4u o; o.x = pk2(v[0], v[1]); o.y = pk2(v[2], v[3]); o.z = pk2(v[4], v[5]); o.w = pk2(v[6], v[7]);
          *(GAS v4u*)(WSP(bf16, WS_CS) + (size_t)k * 512 + l0) = o; } }
    { const float sc = 1.f / sqrtf(256.f * 128.f);
      for (int id = F.gw * 64 + F.lane; id < 256 * 64; id += F.NGW * 64) { const int k = id >> 6, l0 = (id & 63) * 8; float v[8];
#pragma unroll
          for (int j = 0; j < 8; ++j) { const int lp = l0 + j, l = lp & 255; int ph = (k * l) & 255; float x; if (lp < 256) x = tab256[ph]; else x = -tab256[(ph + 192) & 255]; v[j] = x * sc; }
          v4u o; o.x = pk2(v[0], v[1]); o.y = pk2(v[2], v[3]); o.z = pk2(v[4], v[5]); o.w = pk2(v[6], v[7]);
          *(GAS v4u*)(WSP(bf16, WS_CSC) + (size_t)k * 512 + l0) = o; } }
    for (int i = F.gw * 64 + F.lane; i < 2048 * 16; i += F.NGW * 64) { const int l = i >> 4, p = i & 15;
        const float pos = (p < 8) ? (float)(l >> 6) : (float)(l & 63); const float inv = powf(10000.f, -(float)(p & 7) / 8.f); float s, c; sincosf(pos * inv, &s, &c);
        WSP(float, WS_ROPE)[2 * i] = c; WSP(float, WS_ROPE)[2 * i + 1] = s; }
}

__device__ __forceinline__ void load_row(const float* p, int lane, f32x4 (&v)[4]) {
    const GAS f32x4* xr = (const GAS f32x4*)p + lane;
#pragma unroll
    for (int j = 0; j < 4; ++j) v[j] = __builtin_nontemporal_load(xr + 64 * j);
}
__device__ __forceinline__ float row_ss(const f32x4 (&v)[4]) { float s = 0.f;
#pragma unroll
    for (int j = 0; j < 4; ++j) s += (v[j].x * v[j].x + v[j].y * v[j].y) + (v[j].z * v[j].z + v[j].w * v[j].w);
    return wave_sum(s); }
__device__ __forceinline__ void store_row_bf16(bf16* orow, int lane, const f32x4 (&v)[4]) {
    GAS unsigned long long* o8 = (GAS unsigned long long*)orow + lane;
#pragma unroll
    for (int j = 0; j < 4; ++j) o8[64 * j] = (unsigned long long)pk2(v[j].x, v[j].y) | ((unsigned long long)pk2(v[j].z, v[j].w) << 32);
}
__device__ __forceinline__ int mod_row(int t) { return t < TL ? (t >> 11) : 16; }
__device__ __forceinline__ float* xrow(Ctx& F, int t) { return t < TL ? F.out + (size_t)t * D : WSP(float, WS_XC) + (size_t)(t - TL) * D; }
__device__ __forceinline__ void norm_mod(f32x4 (&v)[4], float rstd, const float* g, const float* md, int ch_sh, int ch_sc, int lane) {
#pragma unroll
    for (int j = 0; j < 4; ++j) { const int c = 4 * lane + 256 * j;
        const f32x4 gg = *(const GAS f32x4*)(g + c), sc = *(const GAS f32x4*)(md + ch_sc * 1024 + c), sh = *(const GAS f32x4*)(md + ch_sh * 1024 + c);
        v[j] = v[j] * rstd * gg * (1.f + sc) + sh; }
}
__device__ __forceinline__ const float* xin_row(Ctx& F, int t) { return t < TL ? F.in(0) + (size_t)t * D : F.in(2) + (size_t)(t - TL) * D; }
__device__ __forceinline__ const bf16* y_row(Ctx& F, int t) { return (const bf16*)xrow(F, t) + 1024; }
__device__ __forceinline__ void load_rowY(const bf16* yrow, int lane, u32x2v (&r)[4]) {
#pragma unroll
    for (int j = 0; j < 4; ++j) r[j] = __builtin_nontemporal_load((const GAS u32x2v*)(yrow + 4 * lane + 256 * j));
}
__device__ __forceinline__ void add_rowY(f32x4 (&v)[4], const u32x2v (&r)[4]) {
#pragma unroll
    for (int j = 0; j < 4; ++j) { v[j].x += __builtin_bit_cast(float, r[j].x << 16); v[j].y += __builtin_bit_cast(float, r[j].x & 0xffff0000u); v[j].z += __builtin_bit_cast(float, r[j].y << 16); v[j].w += __builtin_bit_cast(float, r[j].y & 0xffff0000u); }
}
struct ModC { int mr; f32x4 A[4], B[4]; };
__device__ __forceinline__ void modc_set(ModC& m, int mr, const float* g, const float* mdl, int ch_sh, int ch_sc, int lane) {
    m.mr = mr; const float* md = mdl + (size_t)mr * 6144;
#pragma unroll
    for (int j = 0; j < 4; ++j) { const int c = 4 * lane + 256 * j;
        const f32x4 gg = *(const GAS f32x4*)(g + c), sc = *(const GAS f32x4*)(md + ch_sc * 1024 + c); m.A[j] = gg * (1.f + sc); m.B[j] = *(const GAS f32x4*)(md + ch_sh * 1024 + c); }
}
__device__ __forceinline__ void p1_norm(Ctx& F) {
    const float* MODS = WSP(float, WS_MODS); const float* xin = F.in(0); const float* cin = F.in(2); const float* n1g = F.in(6);
    ModC mc; mc.mr = -1; const int nrow = F.wave < 2 ? 12 : 20, t0 = F.vcu * 144 + (F.wave < 2 ? F.wave * 12 : 24 + (F.wave - 2) * 20);
    f32x4 nx[4]; load_row(t0 < TL ? xin + (size_t)t0 * D : cin + (size_t)(t0 - TL) * D, F.lane, nx);
#pragma unroll 1
    for (int i = 0; i < nrow; ++i) { const int t = t0 + i;
        f32x4 v[4];
#pragma unroll
        for (int j = 0; j < 4; ++j) v[j] = nx[j];
        if (i + 1 < nrow) { const int t1 = t + 1; load_row(t1 < TL ? xin + (size_t)t1 * D : cin + (size_t)(t1 - TL) * D, F.lane, nx); }
        const int mr = mod_row(t); if (mr != mc.mr) modc_set(mc, mr, n1g, MODS, 0, 1, F.lane);
        const float rstd = rsqrtf(row_ss(v) * (1.f / D) + EPS);
#pragma unroll
        for (int j = 0; j < 4; ++j) v[j] = v[j] * rstd * mc.A[j] + mc.B[j];
        store_row_bf16(WSP(bf16, WS_UW) + (size_t)t * D, F.lane, v); }
}
__device__ __forceinline__ int cv_seq(int R) { return R < TL ? (R >> 11) : 16 + ((R - TL) >> 8); }
typedef __bf16 cv_bf2 __attribute__((ext_vector_type(2)));
__device__ __forceinline__ float cv_dot2(unsigned x, unsigned w, float a) { return __builtin_amdgcn_fdot2_f32_bf16(__builtin_bit_cast(cv_bf2, x), __builtin_bit_cast(cv_bf2, w), a, false); }
template <bool MASKED>
__device__ __forceinline__ void cv_taps(const LAS unsigned char* xb, const LAS unsigned char* wb, float (&acc)[6][8], int tg) {
    unsigned wp[8];
#pragma unroll
    for (int q = 0; q < 8; ++q) wp[q] = 0u;
    int sq[6];
#pragma unroll
    for (int k = 0; k < 6; ++k) sq[k] = MASKED ? cv_seq(tg + k) : 0;
#pragma unroll 4
    for (int m = 0; m < 16; ++m) {
        const v4u wa = *(const LAS v4u*)(wb + m * 2048), wc = *(const LAS v4u*)(wb + m * 2048 + 1024);
        const unsigned we[8] = { wa.x, wa.y, wa.z, wa.w, wc.x, wc.y, wc.z, wc.w }; unsigned wo[8];
#pragma unroll
        for (int q = 0; q < 8; ++q) { wo[q] = __builtin_amdgcn_alignbit(we[q], wp[q], 16); wp[q] = we[q]; }
#pragma unroll
        for (int i = 0; i < 3; ++i) {
            const v4u xa = *(const LAS v4u*)(xb + (m + i) * 2048), xc = *(const LAS v4u*)(xb + (m + i) * 2048 + 1024);
            const unsigned X[8] = { xa.x, xa.y, xa.z, xa.w, xc.x, xc.y, xc.z, xc.w };
            unsigned me = 0xffffffffu, mo = 0xffffffffu;
            if (MASKED) { const int R0 = tg + 2 * i + 2 * m - 15; const int s0 = cv_seq(R0), s1 = cv_seq(R0 + 1);
                me = (s0 == sq[2 * i] ? 0xffffu : 0u) | (s1 == sq[2 * i] ? 0xffff0000u : 0u); mo = (s0 == sq[2 * i + 1] ? 0xffffu : 0u) | (s1 == sq[2 * i + 1] ? 0xffff0000u : 0u); }
#pragma unroll
            for (int q = 0; q < 8; ++q) { acc[2 * i][q] = cv_dot2(X[q], MASKED ? (we[q] & me) : we[q], acc[2 * i][q]); acc[2 * i + 1][q] = cv_dot2(X[q], MASKED ? (wo[q] & mo) : wo[q], acc[2 * i + 1][q]); } } }
}
__device__ __forceinline__ void p3_conv(Ctx& F) {
    constexpr int PROWS = 40, WIN_B = PROWS * 2048;
    LAS unsigned char* win = F.lds; LAS unsigned char* cwl = F.lds + WIN_B;
    { const float* cw_ = F.in(9); f32x4 w0[4], w1[4];
#pragma unroll
      for (int q = 0; q < 4; ++q) { const int it = F.tid + q * NTHR, m = it >> 7, i4 = it & 127; w0[q] = *(const GAS f32x4*)(cw_ + (size_t)(2 * m) * 512 + 4 * i4);
          if (m < 15) w1[q] = *(const GAS f32x4*)(cw_ + (size_t)(2 * m + 1) * 512 + 4 * i4); else { w1[q].x = 0.f; w1[q].y = 0.f; w1[q].z = 0.f; w1[q].w = 0.f; } }
#pragma unroll
      for (int q = 0; q < 4; ++q) { const int it = F.tid + q * NTHR, m = it >> 7, i4 = it & 127; v4u o; o.x = pk2(w0[q].x, w1[q].x); o.y = pk2(w0[q].y, w1[q].y); o.z = pk2(w0[q].z, w1[q].z); o.w = pk2(w0[q].w, w1[q].w);
          *(LAS v4u*)(cwl + m * 2048 + (i4 & 1) * 1024 + (i4 >> 1) * 16) = o; } }
    const bf16* AG = WSP(bf16, WS_AG); bf16* CAT = WSP(bf16, WS_R2);
    const int c0 = 8 * F.lane;
    float cb[8], lg[8], lb[8];
    { const float* p10 = F.in(10); const float* p11 = F.in(11); const float* p12 = F.in(12);
#pragma unroll
      for (int q = 0; q < 8; ++q) { cb[q] = p10[c0 + q]; lg[q] = p11[c0 + q]; lb[q] = p12[c0 + q]; } }
#pragma unroll 1
    for (int pass = 0; pass < 3; ++pass) { const int t0 = F.vcu * 144 + pass * 48, Rb = t0 - 15;
        { v4u ra[5], rb[5];
#pragma unroll
          for (int q = 0; q < 5; ++q) { const int idx = F.tid + q * NTHR; int R0 = Rb + 2 * (idx >> 6), R1 = R0 + 1; R0 = R0 < 0 ? 0 : (R0 > T - 1 ? T - 1 : R0); R1 = R1 < 0 ? 0 : (R1 > T - 1 ? T - 1 : R1);
              ra[q] = *(const GAS v4u*)(AG + (size_t)R0 * 512 + (idx & 63) * 8); rb[q] = *(const GAS v4u*)(AG + (size_t)R1 * 512 + (idx & 63) * 8); }
#pragma unroll
          for (int q = 0; q < 5; ++q) { const int idx = F.tid + q * NTHR; v4u o0, o1;
              o0.x = __builtin_amdgcn_perm(rb[q].x, ra[q].x, 0x05040100u); o0.y = __builtin_amdgcn_perm(rb[q].x, ra[q].x, 0x07060302u); o0.z = __builtin_amdgcn_perm(rb[q].y, ra[q].y, 0x05040100u); o0.w = __builtin_amdgcn_perm(rb[q].y, ra[q].y, 0x07060302u);
              o1.x = __builtin_amdgcn_perm(rb[q].z, ra[q].z, 0x05040100u); o1.y = __builtin_amdgcn_perm(rb[q].z, ra[q].z, 0x07060302u); o1.z = __builtin_amdgcn_perm(rb[q].w, ra[q].w, 0x05040100u); o1.w = __builtin_amdgcn_perm(rb[q].w, ra[q].w, 0x07060302u);
              LAS unsigned char* d = win + (idx >> 6) * 2048 + (idx & 63) * 16; *(LAS v4u*)d = o0; *(LAS v4u*)(d + 1024) = o1; } }
        __syncthreads();
        { const int tl = F.wave * 6, t = t0 + tl;
            int l, Ls; if (t < TL) { l = t & 2047; Ls = 2048; } else { l = (t - TL) & 255; Ls = 256; }
            int lo16 = 16 * F.lane; asm volatile("" : "+v"(lo16));
            float acc[6][8];
#pragma unroll
            for (int k = 0; k < 6; ++k)
#pragma unroll
                for (int q = 0; q < 8; ++q) acc[k][q] = cb[q];
            const LAS unsigned char* xb = win + (tl >> 1) * 2048 + lo16; const LAS unsigned char* wb = cwl + lo16;
            if (l >= 15 && l + 5 + 15 < Ls) cv_taps<false>(xb, wb, acc, t); else cv_taps<true>(xb, wb, acc, t);
            float st[12];
#pragma unroll
            for (int k = 0; k < 6; ++k) { float s1 = 0.f, s2 = 0.f;
#pragma unroll
                for (int q = 0; q < 8; ++q) { s1 += acc[k][q]; s2 += acc[k][q] * acc[k][q]; }
                st[2 * k] = s1; st[2 * k + 1] = s2; }
#pragma unroll
            for (int o = 1; o <= 16; o <<= 1) { float tt[12];
#pragma unroll
                for (int e = 0; e < 12; ++e) tt[e] = __builtin_bit_cast(float, swz_xor(__builtin_bit_cast(int, st[e]), o));
#pragma unroll
                for (int e = 0; e < 12; ++e) st[e] += tt[e]; }
#pragma unroll
            for (int e = 0; e < 12; ++e) { const int bits = __builtin_bit_cast(int, st[e]); st[e] = __builtin_bit_cast(float, __builtin_amdgcn_readlane(bits, 0)) + __builtin_bit_cast(float, __builtin_amdgcn_readlane(bits, 32)); }
#pragma unroll
            for (int k = 0; k < 6; ++k) { const float mu = st[2 * k] * (1.f / 512.f), var = fmaxf(st[2 * k + 1] * (1.f / 512.f) - mu * mu, 0.f), r = rsqrtf(var + EPS); float y[8];
#pragma unroll
                for (int q = 0; q < 8; ++q) { const float z = (acc[k][q] - mu) * r * lg[q] + lb[q]; y[q] = z * __builtin_amdgcn_rcpf(1.f + __builtin_amdgcn_exp2f(-1.4426950408889634f * z)); }
                v4u o; o.x = pk2(y[0], y[1]); o.y = pk2(y[2], y[3]); o.z = pk2(y[4], y[5]); o.w = pk2(y[6], y[7]);
                *(GAS v4u*)(CAT + (size_t)(t + k) * 1024 + c0) = o; } }
        __syncthreads(); }
}
typedef float f32x2 __attribute__((ext_vector_type(2)));
__device__ __forceinline__ void p3_dft1(Ctx& F, int v, int g) {
    LAS float* tw = (LAS float*)F.lds;
    for (int i = F.tid; i < 2048; i += NTHR) { float sn, cs; sincospif(2.f * (float)i / 2048.f, &sn, &cs); tw[i] = cs; }
    __syncthreads();
    const bf16* YT = WSP(bf16, WS_YT); bf16* AP = WSP(bf16, WS_AP);
#pragma unroll 1
    for (int it = v * NTHR + F.tid; it < 8192 * 32; it += g * NTHR) { const int c = it >> 5, l2 = (it & 31) * 8;
        f32x2 yr[8][4], ys[8][4];
#pragma unroll
        for (int l1 = 0; l1 < 8; ++l1) { const v4u a = __builtin_nontemporal_load((const GAS v4u*)(YT + (size_t)c * 4096 + 256 * l1 + l2)), b = __builtin_nontemporal_load((const GAS v4u*)(YT + (size_t)c * 4096 + 2048 + 256 * l1 + l2));
            yr[l1][0] = (f32x2){__builtin_bit_cast(float, a.x << 16), __builtin_bit_cast(float, a.x & 0xffff0000u)}; yr[l1][1] = (f32x2){__builtin_bit_cast(float, a.y << 16), __builtin_bit_cast(float, a.y & 0xffff0000u)};
            yr[l1][2] = (f32x2){__builtin_bit_cast(float, a.z << 16), __builtin_bit_cast(float, a.z & 0xffff0000u)}; yr[l1][3] = (f32x2){__builtin_bit_cast(float, a.w << 16), __builtin_bit_cast(float, a.w & 0xffff0000u)};
            ys[l1][0] = (f32x2){__builtin_bit_cast(float, b.x << 16), __builtin_bit_cast(float, b.x & 0xffff0000u)}; ys[l1][1] = (f32x2){__builtin_bit_cast(float, b.y << 16), __builtin_bit_cast(float, b.y & 0xffff0000u)};
            ys[l1][2] = (f32x2){__builtin_bit_cast(float, b.z << 16), __builtin_bit_cast(float, b.z & 0xffff0000u)}; ys[l1][3] = (f32x2){__builtin_bit_cast(float, b.w << 16), __builtin_bit_cast(float, b.w & 0xffff0000u)}; }
#pragma unroll 1
        for (int k1 = 0; k1 < 8; ++k1) { f32x2 ar[4], ai[4];
#pragma unroll
            for (int j = 0; j < 4; ++j) { ar[j] = (f32x2){0.f, 0.f}; ai[j] = (f32x2){0.f, 0.f}; }
#pragma unroll
            for (int l1 = 0; l1 < 8; ++l1) { const int p8 = ((k1 * l1) & 7) * 256; const float cc = tw[p8], ss = tw[(p8 + 1536) & 2047];
                const f32x2 c2 = {cc, cc}, s2 = {ss, ss}, ns2 = {-ss, -ss}, nc2 = {-cc, -cc};
#pragma unroll
                for (int j = 0; j < 4; ++j) { ar[j] = __builtin_elementwise_fma(yr[l1][j], c2, ar[j]); ar[j] = __builtin_elementwise_fma(ys[l1][j], ns2, ar[j]);
                    ai[j] = __builtin_elementwise_fma(ys[l1][j], nc2, ai[j]); ai[j] = __builtin_elementwise_fma(yr[l1][j], ns2, ai[j]); } }
            float re[8], im[8];
#pragma unroll
            for (int j = 0; j < 8; ++j) { const int q = k1 * (l2 + j); const float ct = tw[q], st = tw[(q + 1536) & 2047];
                const float arj = (j & 1) ? ar[j >> 1].y : ar[j >> 1].x, aij = (j & 1) ? ai[j >> 1].y : ai[j >> 1].x;
                re[j] = arj * ct + aij * st; im[j] = aij * ct - arj * st; }
            bf16* dst = AP + ((size_t)(k1 * 8192 + c)) * 512 + l2;
            v4u o; o.x = pk2(re[0], re[1]); o.y = pk2(re[2], re[3]); o.z = pk2(re[4], re[5]); o.w = pk2(re[6], re[7]); *(GAS v4u*)dst = o;
            o.x = pk2(im[0], im[1]); o.y = pk2(im[2], im[3]); o.z = pk2(im[4], im[5]); o.w = pk2(im[6], im[7]); *(GAS v4u*)(dst + 256) = o; } }
    __syncthreads();
}
__device__ __forceinline__ void m1_route(Ctx& F, int ly, int nrows) {
    LAS float* wr = (LAS float*)F.lds;
    { const float* wr_ = F.in(20) + (size_t)ly * 16384; f32x4 wv[8];
#pragma unroll
      for (int q = 0; q < 8; ++q) wv[q] = *(const GAS f32x4*)(wr_ + 4 * (F.tid + q * NTHR));
#pragma unroll
      for (int q = 0; q < 8; ++q) { const int i4 = F.tid + q * NTHR, k = i4 >> 2, e0 = (i4 & 3) * 4; LAS float* d = wr + e0 * 1024 + k; d[0] = wv[q].x; d[1024] = wv[q].y; d[2048] = wv[q].z; d[3072] = wv[q].w; } }
    __syncthreads();
    const float* MODS = WSP(float, WS_MODS) + (size_t)ly * 17 * 6144; const float* n2g = F.in(7) + ly * D;
    const int per = nrows / F.NGW, t0 = F.gw * per;
    ModC mc; mc.mr = -1;
    const bool useY = true, l0 = ly == 0;
#define M1_SRC(t_) (l0 ? xin_row(F, (t_)) : (const float*)xrow(F, (t_)))
#define M1_Y(t_) (l0 ? y_row(F, (t_)) : (const bf16*)WSP(bf16, WS_Y1) + (size_t)(t_) * D)
    f32x4 nx0[4], nx1[4]; u32x2v ny0[4], ny1[4]; load_row(M1_SRC(t0), F.lane, nx0); load_row(M1_SRC(t0 + 1), F.lane, nx1);
    if (useY) { load_rowY(M1_Y(t0), F.lane, ny0); load_rowY(M1_Y(t0 + 1), F.lane, ny1); }
#pragma unroll 1
    for (int i = 0; i < per; i += 2) { const int t = t0 + i;
        f32x4 v0[4], v1[4];
#pragma unroll
        for (int j = 0; j < 4; ++j) { v0[j] = nx0[j]; v1[j] = nx1[j]; }
        if (useY) { add_rowY(v0, ny0); add_rowY(v1, ny1); }
        if (i + 2 < per) { load_row(M1_SRC(t + 2), F.lane, nx0); load_row(M1_SRC(t + 3), F.lane, nx1);
            if (useY) { load_rowY(M1_Y(t + 2), F.lane, ny0); load_rowY(M1_Y(t + 3), F.lane, ny1); } }
        const int mr = mod_row(t); if (mr != mc.mr) modc_set(mc, mr, n2g, MODS, 3, 4, F.lane);
        const float r0 = rsqrtf(row_ss(v0) * (1.f / D) + EPS), r1 = rsqrtf(row_ss(v1) * (1.f / D) + EPS);
#pragma unroll
        for (int j = 0; j < 4; ++j) { v0[j] = v0[j] * r0 * mc.A[j] + mc.B[j]; v1[j] = v1[j] * r1 * mc.A[j] + mc.B[j]; }
        store_row_bf16(WSP(bf16, WS_UW) + (size_t)t * D, F.lane, v0); store_row_bf16(WSP(bf16, WS_UW) + (size_t)(t + 1) * D, F.lane, v1);
        float lg[32];
#pragma unroll
        for (int e = 0; e < 16; ++e) { f32x2 a0 = {0.f, 0.f}, a1 = {0.f, 0.f};
#pragma unroll
            for (int j = 0; j < 4; ++j) { const f32x4 w = *(const LAS f32x4*)(wr + e * 1024 + 256 * j + 4 * F.lane);
                a0 = __builtin_elementwise_fma(v0[j].xy, w.xy, a0); a0 = __builtin_elementwise_fma(v0[j].zw, w.zw, a0);
                a1 = __builtin_elementwise_fma(v1[j].xy, w.xy, a1); a1 = __builtin_elementwise_fma(v1[j].zw, w.zw, a1); }
            lg[e] = a0.x + a0.y; lg[16 + e] = a1.x + a1.y; }
        float h[16];
#pragma unroll
        for (int e = 0; e < 16; ++e) { float a_ = lg[e], b_ = lg[16 + e];
            asm volatile("s_nop 1\n\tv_permlane32_swap_b32 %0, %1" : "+v"(a_), "+v"(b_)); h[e] = a_ + b_; }
#define RS_STEP(N, S) _Pragma("unroll") for (int q = 0; q < (N); ++q) { const bool up = (F.lane >> (S)) & 1; const float keep = up ? h[q + (N)] : h[q], send = up ? h[q] : h[q + (N)]; \
            h[q] = keep + __builtin_bit_cast(float, swz_xor(__builtin_bit_cast(int, send), 1 << (S))); }
        RS_STEP(8, 3) RS_STEP(4, 2) RS_STEP(2, 1) RS_STEP(1, 0)
#undef RS_STEP
        float lgt = h[0]; lgt += __builtin_bit_cast(float, swz_xor(__builtin_bit_cast(int, lgt), 16));
        float mx = lgt;
#pragma unroll
        for (int o = 1; o <= 8; o <<= 1) mx = fmaxf(mx, __builtin_bit_cast(float, swz_xor(__builtin_bit_cast(int, mx), o)));
        const float pe = __expf(lgt - mx); float sum = pe;
#pragma unroll
        for (int o = 1; o <= 8; o <<= 1) sum += __builtin_bit_cast(float, swz_xor(__builtin_bit_cast(int, sum), o));
        if ((F.lane & 16) == 0) { const size_t o_ = (size_t)(t + (F.lane >> 5)) * 16 + (F.lane & 15); WSP(float, WS_AFF)[o_] = pe / sum; WSP(int, WS_INV)[o_] = -1; } }
#undef M1_SRC
#undef M1_Y
    __syncthreads();
}
__device__ __forceinline__ void m2_unit(Ctx& F, int unit) {
    LAS int* cntw = (LAS int*)F.lds;
    LAS int* wtot = (LAS int*)(F.lds + 256);
    const bool isc = unit >= 256; const int u2 = isc ? unit - 256 : unit, b = u2 >> 4, e = u2 & 15;
    const int Ls = isc ? 256 : 2048, cap = isc ? 32 : 256, tb = isc ? TL + b * 256 : b * 2048, rowbase = e * ER + (isc ? 4096 + b * 32 : b * 256);
    const float* AFF = WSP(float, WS_AFF);
    unsigned v[4];
#pragma unroll
    for (int i = 0; i < 4; ++i) { const int tok = i * NTHR + F.tid; v[i] = tok < Ls ? __builtin_bit_cast(unsigned, AFF[(size_t)(tb + tok) * 16 + e]) : 0u; }
    unsigned lo = 0u;
    for (int b0 = 28; b0 >= 0; b0 -= 2) { const unsigned c1 = lo | (1u << b0), c2 = lo | (2u << b0), c3 = lo | (3u << b0); const int par = (b0 >> 1) & 1;
        const int n1 = __popcll(__ballot(v[0] >= c1)) + __popcll(__ballot(v[1] >= c1)) + __popcll(__ballot(v[2] >= c1)) + __popcll(__ballot(v[3] >= c1));
        const int n2 = __popcll(__ballot(v[0] >= c2)) + __popcll(__ballot(v[1] >= c2)) + __popcll(__ballot(v[2] >= c2)) + __popcll(__ballot(v[3] >= c2));
        const int n3 = __popcll(__ballot(v[0] >= c3)) + __popcll(__ballot(v[1] >= c3)) + __popcll(__ballot(v[2] >= c3)) + __popcll(__ballot(v[3] >= c3));
        if (F.lane == 0) { LAS int* d = cntw + par * 32 + F.wave * 4; d[0] = n1; d[1] = n2; d[2] = n3; }
        __syncthreads();
        int t1 = 0, t2 = 0, t3 = 0;
#pragma unroll
        for (int w = 0; w < 8; ++w) { const LAS int* d = cntw + par * 32 + w * 4; t1 += d[0]; t2 += d[1]; t3 += d[2]; }
        lo = t3 >= cap ? c3 : (t2 >= cap ? c2 : (t1 >= cap ? c1 : lo)); }
    int pg[4], pq[4];
#pragma unroll
    for (int i = 0; i < 4; ++i) { const unsigned long long bg = __ballot(v[i] > lo), bq = __ballot(v[i] == lo && lo != 0u);
        pg[i] = __builtin_amdgcn_mbcnt_hi((unsigned)(bg >> 32), __builtin_amdgcn_mbcnt_lo((unsigned)bg, 0u));
        pq[i] = __builtin_amdgcn_mbcnt_hi((unsigned)(bq >> 32), __builtin_amdgcn_mbcnt_lo((unsigned)bq, 0u));
        if (F.lane == 0) wtot[i * 8 + F.wave] = __popcll(bg) | (__popcll(bq) << 16); }
    __syncthreads();
    int total = 0, base[4];
#pragma unroll
    for (int i = 0; i < 4; ++i)
#pragma unroll
        for (int w = 0; w < 8; ++w) { if (w == 0) base[i] = 0; const int x = wtot[i * 8 + w]; if (w == F.wave) base[i] = total; total += x; }
    const int ngt = total & 0xffff, need = cap - ngt;
#pragma unroll
    for (int i = 0; i < 4; ++i) { const int tok = i * NTHR + F.tid; int slot = -1;
        if (v[i] > lo) slot = (base[i] & 0xffff) + pg[i]; else if (v[i] == lo && lo != 0u) { const int qr = (base[i] >> 16) + pq[i]; if (qr < need) slot = ngt + qr; }
        if (slot >= 0) { WSP(int, WS_AROW)[rowbase + slot] = tb + tok; WSP(float, WS_GATE)[rowbase + slot] = __builtin_bit_cast(float, v[i]); WSP(int, WS_INV)[(size_t)(tb + tok) * 16 + e] = rowbase + slot; } }
    __syncthreads();
}
__device__ __forceinline__ void combine_row(Ctx& F, int myinv, const f32x4 (&G2c)[4], f32x4 (&v)[4]) {
    f32x4 a[4];
#pragma unroll
    for (int j = 0; j < 4; ++j) a[j] = (f32x4){0.f, 0.f, 0.f, 0.f};
    const bf16* YB = WSP(bf16, WS_R1);
    unsigned long long m = __ballot(myinv >= 0);
    while (m) { int rr[4]; u32x2v y[4][4];
#pragma unroll
        for (int h = 0; h < 4; ++h) { if (m) { const int l = __builtin_ctzll(m); rr[h] = __builtin_amdgcn_readlane(myinv, l); m &= m - 1; } else rr[h] = -1; }
#pragma unroll
        for (int h = 0; h < 4; ++h) if (rr[h] >= 0) { const GAS u32x2v* yr = (const GAS u32x2v*)(YB + (size_t)rr[h] * D) + F.lane;
#pragma unroll
                for (int j = 0; j < 4; ++j) y[h][j] = __builtin_nontemporal_load(yr + 64 * j); }
#pragma unroll
        for (int h = 0; h < 4; ++h) if (rr[h] >= 0) {
#pragma unroll
                for (int j = 0; j < 4; ++j) { const u32x2v w = y[h][j];
                    a[j].x += __builtin_bit_cast(float, w.x << 16); a[j].y += __builtin_bit_cast(float, w.x & 0xffff0000u);
                    a[j].z += __builtin_bit_cast(float, w.y << 16); a[j].w += __builtin_bit_cast(float, w.y & 0xffff0000u); } } }
#pragma unroll
    for (int j = 0; j < 4; ++j) v[j] = v[j] + G2c[j] * a[j];
}
__device__ __forceinline__ void store_row_f32(float* p, int lane, const f32x4 (&v)[4]) {
    GAS f32x4* o = (GAS f32x4*)p + lane;
#pragma unroll
    for (int j = 0; j < 4; ++j) o[64 * j] = v[j];
}
constexpr int MW_SPLIT = 0, MW1_G5 = 10240;
__device__ __forceinline__ void a0_combine(Ctx& F, bool dry = false) {
    const float* MODS0 = WSP(float, WS_MODS); const float* MODS1 = MODS0 + (size_t)17 * 6144; const float* n1g = F.in(6) + D; const int* INV = WSP(int, WS_INV);
    ModC mc; mc.mr = -1; f32x4 G2c[4]; const int t0 = F.gw * 18;
    f32x4 nx[4]; u32x2v ny[4]; load_row(xin_row(F, t0), F.lane, nx); load_rowY(y_row(F, t0), F.lane, ny); int inv_n = F.lane < 16 ? INV[(size_t)t0 * 16 + F.lane] : -1;
#pragma unroll 1
    for (int i = 0; i < 18; ++i) { const int t = t0 + i;
        f32x4 v[4];
#pragma unroll
        for (int j = 0; j < 4; ++j) v[j] = nx[j];
        add_rowY(v, ny);
        const int myinv = inv_n;
        if (i < 17) { load_row(xin_row(F, t + 1), F.lane, nx); load_rowY(y_row(F, t + 1), F.lane, ny); inv_n = F.lane < 16 ? INV[(size_t)(t + 1) * 16 + F.lane] : -1; }
        const int mr = mod_row(t); if (mr != mc.mr) { modc_set(mc, mr, n1g, MODS1, 0, 1, F.lane);
#pragma unroll
            for (int j = 0; j < 4; ++j) G2c[j] = *(const GAS f32x4*)(MODS0 + (size_t)mr * 6144 + 5 * 1024 + 4 * F.lane + 256 * j); }
        combine_row(F, myinv, G2c, v);
        if (dry || t < TL) store_row_f32(dry ? WSP(float, WS_R2) + (size_t)t * D : xrow(F, t), F.lane, v);
        const float rstd = rsqrtf(row_ss(v) * (1.f / D) + EPS);
#pragma unroll
        for (int j = 0; j < 4; ++j) v[j] = v[j] * rstd * mc.A[j] + mc.B[j];
        store_row_bf16(dry ? WSP(bf16, WS_R2) + (size_t)t * D : WSP(bf16, WS_UW) + (size_t)t * D, F.lane, v); }
    LAS float* scr = (LAS float*)(F.lds + F.wave * 8448);
    moe_w_items(F, 1, scr, 0, MW_SPLIT);
}
__device__ __forceinline__ void p_final(Ctx& F, bool dry = false, float cofs = 0.f) {
    const float* fg = F.in(24); const float* MODS1 = WSP(float, WS_MODS) + (size_t)17 * 6144; const int* INV = WSP(int, WS_INV);
    f32x4 FG[4], G2c[4]; int cmr = -1;
#pragma unroll
    for (int j = 0; j < 4; ++j) FG[j] = *(const GAS f32x4*)(fg + 4 * F.lane + 256 * j);
    const int t0 = F.gw * 16;
    const bf16* Y1 = WSP(bf16, WS_Y1);
    f32x4 nx[4]; u32x2v ny[4]; load_row(F.out + (size_t)t0 * D, F.lane, nx); load_rowY(Y1 + (size_t)t0 * D, F.lane, ny); int inv_n = F.lane < 16 ? INV[(size_t)t0 * 16 + F.lane] : -1;
#pragma unroll 1
    for (int i = 0; i < 16; ++i) { const int t = t0 + i;
        f32x4 v[4];
#pragma unroll
        for (int j = 0; j < 4; ++j) v[j] = nx[j];
        add_rowY(v, ny);
        const int myinv = inv_n;
        if (i < 15) { load_row(F.out + (size_t)(t + 1) * D, F.lane, nx); load_rowY(Y1 + (size_t)(t + 1) * D, F.lane, ny); inv_n = F.lane < 16 ? INV[(size_t)(t + 1) * 16 + F.lane] : -1; }
        const int mr = t >> 11; if (mr != cmr) { cmr = mr;
#pragma unroll
            for (int j = 0; j < 4; ++j) G2c[j] = *(const GAS f32x4*)(MODS1 + (size_t)mr * 6144 + 5 * 1024 + 4 * F.lane + 256 * j); }
        combine_row(F, myinv, G2c, v);
        const float rstd = rsqrtf(row_ss(v) * (1.f / D) + EPS);
#pragma unroll
        for (int j = 0; j < 4; ++j) v[j] = v[j] * rstd * FG[j] + cofs;
        store_row_f32(dry ? WSP(float, WS_R2) + (size_t)t * D : F.out + (size_t)t * D, F.lane, v); }
}
__device__ __forceinline__ void a1_lowrank(Ctx& F, int tbeg, int nrow) {
    const bf16* CQKV = WSP(bf16, WS_CQKV);
    const int col = F.lane < 52 ? 8 * F.lane : 0;
    float g8[8];
    { const float* qg = F.in(15); const float* kvg = F.in(16);
#pragma unroll
      for (int q = 0; q < 8; ++q) g8[q] = F.lane < 32 ? qg[8 * F.lane + q] : (F.lane < 48 ? kvg[8 * (F.lane - 32) + q] : 1.f); }
#pragma unroll 1
    for (int i0 = 0; i0 < nrow; i0 += 8) { v4u rawb[8]; f32x4 rta[8], rtb[8];
#pragma unroll
        for (int r = 0; r < 8; ++r) { const int t_ = tbeg + i0 + r; rawb[r] = __builtin_nontemporal_load((const GAS v4u*)(CQKV + (size_t)t_ * 512 + col));
            const float* rt_ = WSP(float, WS_ROPE) + (size_t)(t_ < TL ? (t_ & 2047) : 0) * 32 + 8 * ((F.lane - 48) & 3); rta[r] = *(const GAS f32x4*)rt_; rtb[r] = *(const GAS f32x4*)(rt_ + 4); }
        float sq8[8], skv8[8];
#pragma unroll
        for (int r = 0; r < 8; ++r) { const v4u raw = rawb[r]; float ss = 0.f, xx;
            xx = __builtin_bit_cast(float, raw.x << 16); ss += xx * xx; xx = __builtin_bit_cast(float, raw.x & 0xffff0000u); ss += xx * xx; xx = __builtin_bit_cast(float, raw.y << 16); ss += xx * xx; xx = __builtin_bit_cast(float, raw.y & 0xffff0000u); ss += xx * xx;
            xx = __builtin_bit_cast(float, raw.z << 16); ss += xx * xx; xx = __builtin_bit_cast(float, raw.z & 0xffff0000u); ss += xx * xx; xx = __builtin_bit_cast(float, raw.w << 16); ss += xx * xx; xx = __builtin_bit_cast(float, raw.w & 0xffff0000u); ss += xx * xx;
            sq8[r] = F.lane < 32 ? ss : 0.f; skv8[r] = (F.lane >= 32 && F.lane < 48) ? ss : 0.f; }
#pragma unroll
        for (int o = 1; o <= 16; o <<= 1) { float ta[8], tb[8];
#pragma unroll
            for (int r = 0; r < 8; ++r) { ta[r] = __builtin_bit_cast(float, swz_xor(__builtin_bit_cast(int, sq8[r]), o)); tb[r] = __builtin_bit_cast(float, swz_xor(__builtin_bit_cast(int, skv8[r]), o)); }
#pragma unroll
            for (int r = 0; r < 8; ++r) { sq8[r] += ta[r]; skv8[r] += tb[r]; } }
#pragma unroll
        for (int r = 0; r < 8; ++r) { const int t = tbeg + i0 + r; const v4u raw = rawb[r];
            float x[8]; x[0] = __builtin_bit_cast(float, raw.x << 16); x[1] = __builtin_bit_cast(float, raw.x & 0xffff0000u); x[2] = __builtin_bit_cast(float, raw.y << 16); x[3] = __builtin_bit_cast(float, raw.y & 0xffff0000u);
            x[4] = __builtin_bit_cast(float, raw.z << 16); x[5] = __builtin_bit_cast(float, raw.z & 0xffff0000u); x[6] = __builtin_bit_cast(float, raw.w << 16); x[7] = __builtin_bit_cast(float, raw.w & 0xffff0000u);
            const int bq = __builtin_bit_cast(int, sq8[r]), bk = __builtin_bit_cast(int, skv8[r]);
            const float sq = __builtin_bit_cast(float, __builtin_amdgcn_readlane(bq, 0)) + __builtin_bit_cast(float, __builtin_amdgcn_readlane(bq, 32));
            const float skv = __builtin_bit_cast(float, __builtin_amdgcn_readlane(bk, 0)) + __builtin_bit_cast(float, __builtin_amdgcn_readlane(bk, 32));
            const float rq = rsqrtf(sq * (1.f / 256.f) + EPS), rkv = rsqrtf(skv * (1.f / 128.f) + EPS);
            if (F.lane < 32) { if (t < TL) { float y[8];
#pragma unroll
                    for (int q = 0; q < 8; ++q) y[q] = x[q] * rq * g8[q];
                    v4u o; o.x = pk2(y[0], y[1]); o.y = pk2(y[2], y[3]); o.z = pk2(y[4], y[5]); o.w = pk2(y[6], y[7]);
                    *(GAS v4u*)(WSP(bf16, WS_CQN) + (size_t)t * 256 + 8 * F.lane) = o; } }
            else if (F.lane < 48) { float y[8];
#pragma unroll
                for (int q = 0; q < 8; ++q) y[q] = x[q] * rkv * g8[q];
                v4u o; o.x = pk2(y[0], y[1]); o.y = pk2(y[2], y[3]); o.z = pk2(y[4], y[5]); o.w = pk2(y[6], y[7]);
                *(GAS v4u*)(WSP(bf16, WS_CKVN) + (size_t)t * 128 + 8 * (F.lane - 32)) = o; }
            else {
                if (F.lane < 52) { int b, key; float y[8];
                    if (t < TL) { b = t >> 11; const int l = t & 2047; key = 256 + l; const float rt[8] = {rta[r][0], rta[r][1], rta[r][2], rta[r][3], rtb[r][0], rtb[r][1], rtb[r][2], rtb[r][3]};
#pragma unroll
                        for (int p = 0; p < 4; ++p) { const float c = rt[2 * p], s = rt[2 * p + 1]; y[2 * p] = x[2 * p] * c - x[2 * p + 1] * s; y[2 * p + 1] = x[2 * p] * s + x[2 * p + 1] * c; } }
                    else { b = (t - TL) >> 8; key = (t - TL) & 255;
#pragma unroll
                        for (int q = 0; q < 8; ++q) y[q] = x[q]; }
                    v4u o; o.x = pk2(y[0], y[1]); o.y = pk2(y[2], y[3]); o.z = pk2(y[4], y[5]); o.w = pk2(y[6], y[7]);
                    *(GAS v4u*)(WSP(bf16, WS_KR) + ((size_t)b * 2304 + key) * 32 + 8 * (F.lane - 48)) = o; } } } }
}
}
namespace fp {
__device__ __forceinline__ float fsig(float g) { return __builtin_amdgcn_rcpf(1.f + __builtin_amdgcn_exp2f(-1.4426950408889634f * g)); }
__device__ __forceinline__ u32x4 pack8(const f32x4& a, const f32x4& b) { u32x4 w; w.x = cvt_pk_bf16(a[0], a[1]); w.y = cvt_pk_bf16(a[2], a[3]); w.z = cvt_pk_bf16(b[0], b[1]); w.w = cvt_pk_bf16(b[2], b[3]); return w; }
typedef pg8::f32x4 A4;
#define EPI_ARGS const A4 (&acc)[2][2][4][2], const Unit& u, int wr, int wc, int fr, int fq
struct EpiG1 { static constexpr bool PERM = true, AFTER_DRAIN = false; bf16* AG; bf16* YT; bf16* YTC;
    __device__ __forceinline__ void operator()(EPI_ARGS) const {
        if (u.pm < 144) { const int row0 = u.pm * 256 + wr * 64 + fr, col0 = (u.pn - 148) * 128 + wc * 32 + 8 * fq;
#pragma unroll
            for (int ai = 0; ai < 2; ++ai)
#pragma unroll
                for (int m = 0; m < 4; ++m) { A4 a[2];
#pragma unroll
                    for (int n = 0; n < 2; ++n) { const A4 v = acc[ai][0][m][n], g = acc[ai][1][m][n];
#pragma unroll
                        for (int i = 0; i < 4; ++i) a[n][i] = v[i] * fsig(g[i]); }
                    *(u32x4*)(AG + (size_t)(row0 + ai * 128 + m * 16) * 512 + col0) = pack8(a[0], a[1]); }
        } else { const int r0 = (u.pm - 144) * 256 + wr * 64 + fr, tk0 = u.pn * 256 + wc * 32 + 8 * fq;
#pragma unroll
            for (int ai = 0; ai < 2; ++ai)
#pragma unroll
                for (int m = 0; m < 4; ++m) { const int r = r0 + ai * 128 + m * 16, half = r >> 9, ncol = r & 511;
#pragma unroll
                    for (int bj = 0; bj < 2; ++bj) { const int tk = tk0 + bj * 128; bf16* p;
                        if (u.pn < 128) { const int b = u.pn >> 3, l = tk - b * 2048; p = YT + ((size_t)(b * 512 + ncol) * 4096 + half * 2048 + l); }
                        else { const int tkc = tk - TL, b = tkc >> 8, l = tkc & 255; p = YTC + ((size_t)(b * 512 + ncol) * 512 + half * 256 + l); }
                        *(u32x4*)p = pack8(acc[ai][bj][m][0], acc[ai][bj][m][1]); } } }
    } };
struct EpiF { static constexpr bool PERM = true, AFTER_DRAIN = false; bf16* CAT; int rows_per_b, tokbase;
    __device__ __forceinline__ void operator()(EPI_ARGS) const {
        const int k0 = u.pm * 256 + wr * 64 + fr, c0 = u.pn * 256 + wc * 32 + 8 * fq;
#pragma unroll
        for (int bj = 0; bj < 2; ++bj) { const int c = c0 + bj * 128, b = c >> 9, n = c & 511; bf16* colp = CAT + (size_t)(tokbase + b * rows_per_b) * 1024 + 512 + n;
#pragma unroll
            for (int ai = 0; ai < 2; ++ai)
#pragma unroll
                for (int m = 0; m < 4; ++m) *(u32x4*)(colp + (size_t)(k0 + ai * 128 + m * 16) * 1024) = pack8(acc[ai][bj][m][0], acc[ai][bj][m][1]); }
    } };
struct EpiF2 { static constexpr bool PERM = true, AFTER_DRAIN = false; bf16* CAT;
    __device__ __forceinline__ void operator()(EPI_ARGS) const {
        const int k20 = wr * 64 + fr, nn0 = u.pn * 256 + wc * 32 + 8 * fq;
#pragma unroll
        for (int bj = 0; bj < 2; ++bj) { const int nn = nn0 + bj * 128, k1 = nn >> 13, c = nn & 8191, b = c >> 9, n = c & 511; bf16* colp = CAT + ((size_t)b * 2048 + k1) * 1024 + 512 + n;
#pragma unroll
            for (int ai = 0; ai < 2; ++ai)
#pragma unroll
                for (int m = 0; m < 4; ++m) *(u32x4*)(colp + (size_t)(k20 + ai * 128 + m * 16) * 8 * 1024) = pack8(acc[ai][bj][m][0], acc[ai][bj][m][1]); }
    } };
struct EpiRes { static constexpr bool PERM = false, AFTER_DRAIN = false; const float* base_lat; const float* base_ctx; float* out_lat; float* out_ctx; const float* gates  ;
    __device__ __forceinline__ void operator()(EPI_ARGS) const {
        const int trow = u.pm * 256; const bool isc = trow >= TL; const int mr = isc ? 16 : (trow >> 11);
        const float* bp = isc ? base_ctx + (size_t)(trow - TL) * D : base_lat + (size_t)trow * D; float* op = isc ? out_ctx + (size_t)(trow - TL) * D : out_lat + (size_t)trow * D;
        const int col0 = u.pn * 256 + wc * 32 + 4 * fq; const float* gp = gates + (size_t)mr * 6144 + col0;
        A4 gv[2][2];
#pragma unroll
        for (int bj = 0; bj < 2; ++bj)
#pragma unroll
            for (int n = 0; n < 2; ++n) gv[bj][n] = *(const A4*)(gp + bj * 128 + n * 16);
        A4 pre[4][2][2];
#define RES_LOAD(g_) do { const size_t off_ = (size_t)(wr * 64 + fr + ((g_) >> 2) * 128 + ((g_) & 3) * 16) * D + col0; \
            _Pragma("unroll") for (int bj = 0; bj < 2; ++bj) _Pragma("unroll") for (int n = 0; n < 2; ++n) pre[(g_) & 3][bj][n] = *(const A4*)(bp + off_ + bj * 128 + n * 16); } while (0)
        RES_LOAD(0); RES_LOAD(1); RES_LOAD(2); RES_LOAD(3);
#pragma unroll
        for (int g = 0; g < 8; ++g) { const int ai = g >> 2, m = g & 3; const size_t off = (size_t)(wr * 64 + fr + ai * 128 + m * 16) * D + col0;
#pragma unroll
            for (int bj = 0; bj < 2; ++bj)
#pragma unroll
                for (int n = 0; n < 2; ++n) *(A4*)(op + off + bj * 128 + n * 16) = pre[g & 3][bj][n] + gv[bj][n] * acc[ai][bj][m][n];
            if (g + 4 < 8) RES_LOAD(g + 4);
            asm volatile("" ::: "memory"); }
#undef RES_LOAD
    } };
struct EpiSwiglu { static constexpr bool PERM = true, AFTER_DRAIN = false; bf16* HID;
    __device__ __forceinline__ void operator()(EPI_ARGS) const {
        const int row0 = u.pm * 256 + wr * 64 + fr, col0 = (u.pn & 7) * 128 + wc * 32 + 8 * fq;
#pragma unroll
        for (int ai = 0; ai < 2; ++ai)
#pragma unroll
            for (int m = 0; m < 4; ++m) { A4 a[2];
#pragma unroll
                for (int n = 0; n < 2; ++n) { const A4 v = acc[ai][0][m][n], g = acc[ai][1][m][n];
#pragma unroll
                    for (int i = 0; i < 4; ++i) a[n][i] = v[i] * fsig(v[i]) * g[i]; }
                __builtin_nontemporal_store(pack8(a[0], a[1]), (GAS u32x4*)(HID + (size_t)(row0 + ai * 128 + m * 16) * 1024 + col0)); }
    } };
struct EpiGate { static constexpr bool PERM = true, AFTER_DRAIN = false; bf16* YB; const float* GATE;
    __device__ __forceinline__ void operator()(EPI_ARGS) const {
        const int row0 = u.pm * 256 + wr * 64 + fr, col0 = (u.pn & 3) * 256 + wc * 32 + 8 * fq;
        float gts[8];
#pragma unroll
        for (int g = 0; g < 8; ++g) gts[g] = GATE[row0 + (g >> 2) * 128 + (g & 3) * 16];
#pragma unroll
        for (int ai = 0; ai < 2; ++ai)
#pragma unroll
            for (int m = 0; m < 4; ++m) { const int row = row0 + ai * 128 + m * 16; const float gt = gts[ai * 4 + m]; bf16* rowp = YB + (size_t)row * 1024 + col0;
#pragma unroll
                for (int bj = 0; bj < 2; ++bj) *(GAS u32x4*)(rowp + bj * 128) = pack8(acc[ai][bj][m][0] * gt, acc[ai][bj][m][1] * gt); }
    } };
struct EpiPlain { static constexpr bool PERM = true, AFTER_DRAIN = false; bf16* O; int ldc;
    __device__ __forceinline__ void operator()(EPI_ARGS) const {
        const int row0 = u.pm * 256 + wr * 64 + fr, col0 = u.pn * 256 + wc * 32 + 8 * fq;
#pragma unroll
        for (int ai = 0; ai < 2; ++ai)
#pragma unroll
            for (int m = 0; m < 4; ++m) { bf16* rowp = O + (size_t)(row0 + ai * 128 + m * 16) * ldc + col0;
#pragma unroll
                for (int bj = 0; bj < 2; ++bj) *(u32x4*)(rowp + bj * 128) = pack8(acc[ai][bj][m][0], acc[ai][bj][m][1]); }
    } };
struct EpiY { static constexpr bool PERM = true, AFTER_DRAIN = false; bf16* ylat; bf16* yctx; int pitch; const float* gates  ;
    __device__ __forceinline__ void operator()(EPI_ARGS) const {
        const int trow = u.pm * 256, mr = trow >= TL ? 16 : (trow >> 11);
        const int row0 = trow + wr * 64 + fr, col0 = u.pn * 256 + wc * 32 + 8 * fq; const float* gp = gates + (size_t)mr * 6144 + col0;
        bf16* Y = trow >= TL ? yctx - (size_t)TL * pitch : ylat;
        A4 gv[2][2];
#pragma unroll
        for (int bj = 0; bj < 2; ++bj)
#pragma unroll
            for (int n = 0; n < 2; ++n) gv[bj][n] = *(const GAS A4*)(gp + bj * 128 + n * 4);
#pragma unroll
        for (int ai = 0; ai < 2; ++ai)
#pragma unroll
            for (int m = 0; m < 4; ++m) { bf16* rowp = Y + (size_t)(row0 + ai * 128 + m * 16) * pitch + col0;
#pragma unroll
                for (int bj = 0; bj < 2; ++bj) *(GAS u32x4*)(rowp + bj * 128) = pack8(gv[bj][0] * acc[ai][bj][m][0], gv[bj][1] * acc[ai][bj][m][1]); }
    } };
struct EpiQ { static constexpr bool PERM = true, AFTER_DRAIN = false; bf16* Q; const float* ROPE;
    __device__ __forceinline__ void operator()(EPI_ARGS) const {
        const int row0 = u.pm * 256 + wr * 64 + fr, colb = u.pn * 256 + wc * 32 + 8 * fq;
        const int hc0 = colb % 96, hc1 = (colb + 128) % 96; const bool rp0 = hc0 >= 64, rp1 = hc1 >= 64; const int po0 = rp0 ? (hc0 - 64) : 0, po1 = rp1 ? (hc1 - 64) : 0;
        int qoff = row0 * 1536 + colb, roff = (row0 & 2047) * 32;
#pragma unroll
        for (int ai = 0; ai < 2; ++ai) {
#pragma unroll
            for (int m = 0; m < 4; ++m) { const float* rtr = ROPE + roff; bf16* qrow = Q + qoff;
#pragma unroll
                for (int bj = 0; bj < 2; ++bj) { A4 a = acc[ai][bj][m][0], b = acc[ai][bj][m][1];
                    if (bj == 0 ? rp0 : rp1) { const float* rt = rtr + (bj == 0 ? po0 : po1); const A4 r0 = *(const A4*)rt, r1 = *(const A4*)(rt + 4);
                        A4 a2, b2; a2[0] = a[0] * r0[0] - a[1] * r0[1]; a2[1] = a[0] * r0[1] + a[1] * r0[0]; a2[2] = a[2] * r0[2] - a[3] * r0[3]; a2[3] = a[2] * r0[3] + a[3] * r0[2];
                        b2[0] = b[0] * r1[0] - b[1] * r1[1]; b2[1] = b[0] * r1[1] + b[1] * r1[0]; b2[2] = b[2] * r1[2] - b[3] * r1[3]; b2[3] = b[2] * r1[3] + b[3] * r1[2]; a = a2; b = b2; }
                    constexpr float QC_ = 0.10206207261596577f * 1.4426950408889634f;
#pragma unroll
                    for (int e = 0; e < 4; ++e) { a[e] *= QC_; b[e] *= QC_; }
                    *(u32x4*)(qrow + bj * 128) = pack8(a, b); }
                qoff += 16 * 1536; roff += 16 * 32; asm volatile("" : "+v"(qoff), "+v"(roff) :: "memory"); }
            qoff += 64 * 1536; roff += 64 * 32; }
    } };
struct EpiKV { static constexpr bool PERM = true, AFTER_DRAIN = false; bf16* KN; bf16* V;
    __device__ __forceinline__ void operator()(EPI_ARGS) const {
        const int t0 = u.pm * 256; int b, key0; if (t0 < TL) { b = t0 >> 11; key0 = 256 + (t0 & 2047); } else { b = (t0 - TL) >> 8; key0 = 0; }
        bf16* ub = (wc < 2 ? KN : V) + ((size_t)(b * 16 + u.pn * 2) * 2304 + key0 + wr * 64) * 64 + (wc & 1) * 32;
        const unsigned voff = (unsigned)(fr * 64 + 8 * fq) * 2u;
#pragma unroll
        for (int ai = 0; ai < 2; ++ai)
#pragma unroll
            for (int m = 0; m < 4; ++m)
#pragma unroll
                for (int bj = 0; bj < 2; ++bj) *(u32x4*)((char*)(ub + (size_t)bj * 2304 * 64 + (ai * 128 + m * 16) * 64) + voff) = pack8(acc[ai][bj][m][0], acc[ai][bj][m][1]);
    } };
struct SchedG1 { int vcu, G;
    __device__ __forceinline__ bool next(int i, Unit& u) const { const int j = i * G + vcu; if (j >= 1152) return false; const int tt = j >> 3, sub = j & 7; if (sub < 4) { u.pm = tt; u.pn = 148 + sub; } else { u.pm = 144 + (sub - 4); u.pn = tt; } return true; }
    __device__ __forceinline__ void a_ready(const Unit&) const {} __device__ __forceinline__ void done(const Unit&) const {} };
struct SchedMN { int vcu, G, nM, nN, pm0, pn0;
    __device__ __forceinline__ bool next(int i, Unit& u) const { const int j = i * G + vcu; if (j >= nM * nN) return false; u.pm = pm0 + j / nN; u.pn = pn0 + j % nN; return true; }
    __device__ __forceinline__ void a_ready(const Unit&) const {} __device__ __forceinline__ void done(const Unit&) const {} };
struct SchedNM { int vcu, G, nM, nN;
    __device__ __forceinline__ bool next(int i, Unit& u) const { const int j = i * G + vcu; if (j >= nM * nN) return false; u.pm = j % nM; u.pn = j / nM; return true; }
    __device__ __forceinline__ void a_ready(const Unit&) const {} __device__ __forceinline__ void done(const Unit&) const {} };
struct SchedOwn { int w, nM;
    __device__ __forceinline__ bool next(int i, Unit& u) const { if (i >= 2 || w >= nM) return false; u.pm = w; u.pn = i; return true; }
    __device__ __forceinline__ void a_ready(const Unit&) const {} __device__ __forceinline__ void done(const Unit&) const {} };
struct SchedExp { int vcu, G, nMt, nNt;
    __device__ __forceinline__ bool next(int i, Unit& u) const { const int j = i * G + vcu, per = nMt * nNt; if (j >= 16 * per) return false; const int e = j / per, r = j % per; u.pm = e * 18 + r / nNt; u.pn = e * nNt + r % nNt; return true; }
    __device__ __forceinline__ void a_ready(const Unit&) const {} __device__ __forceinline__ void done(const Unit&) const {} };
}

namespace att {
using bf16x8 = __attribute__((ext_vector_type(8))) short;
using s16x4 = __attribute__((ext_vector_type(4))) short;
using f32x16 = __attribute__((ext_vector_type(16))) float;
using u32x4 = __attribute__((ext_vector_type(4))) unsigned;
typedef unsigned short bf16;
constexpr int NW = 8, QBLK = 32, KVBLK = 64, SKV = 2304, NT = SKV / KVBLK, LDQ = 1536, LDO = 1024;
constexpr float SCALE = 0.10206207261596577f, THR = 16.f;
constexpr int SHM_V = 16384, SHM_K = 16384, NBUF = 4, SHM_ATTN = NBUF * SHM_V + NBUF * SHM_K + NW * 64 * 4;
#define KSWZ(row, colB) ((row) * 256 + ((colB) ^ (((row) & 7) << 4)))
#define SBAR() __builtin_amdgcn_sched_barrier(0)
__device__ __forceinline__ int crow(int r, int hi) { return (r & 3) + 8 * (r >> 2) + 4 * hi; }
__device__ __forceinline__ unsigned cvtpk(float lo, float hi) { unsigned r; asm volatile("v_cvt_pk_bf16_f32 %0, %1, %2" : "=v"(r) : "v"(lo), "v"(hi)); return r; }
constexpr float QC = SCALE * 1.4426950408889634f, THR2 = THR * 1.4426950408889634f;
__device__ __forceinline__ void rowmaxSM(f32x16& p0, f32x16& p1, f32x16& negm, float& alpha, bool first) {
  float pmax = p0[0]; for (int r = 1; r < 16; ++r) pmax = fmaxf(pmax, p0[r]); for (int r = 0; r < 16; ++r) pmax = fmaxf(pmax, p1[r]);
  { float a_ = pmax, b_ = pmax; asm volatile("s_nop 1\n\tv_permlane32_swap_b32 %0, %1" : "+v"(a_), "+v"(b_)); pmax = fmaxf(a_, b_); }
  if (__builtin_expect(!first && __all(pmax <= THR2), 1)) { alpha = 1.f; }
  else { const float d = first ? pmax : fmaxf(pmax, 0.f); alpha = first ? 1.f : __builtin_amdgcn_exp2f(-d);
    for (int r = 0; r < 16; ++r) { p0[r] -= d; p1[r] -= d; negm[r] -= d; } }
}
#define PK4(P, BASE, OUT) do { unsigned a0 = cvtpk(P[BASE + 0], P[BASE + 1]), a1 = cvtpk(P[BASE + 2], P[BASE + 3]);   \
    unsigned b0 = cvtpk(P[BASE + 4], P[BASE + 5]), b1 = cvtpk(P[BASE + 6], P[BASE + 7]);                              \
    auto r0 = __builtin_amdgcn_permlane32_swap(a0, b0, false, false); auto r1 = __builtin_amdgcn_permlane32_swap(a1, b1, false, false); \
    u32x4 w = {r0[0], r1[0], r0[1], r1[1]}; OUT = *reinterpret_cast<bf16x8*>(&w); } while (0)
__device__ __forceinline__ void finishSM(f32x16& p0, f32x16& p1, float alpha, float& l_reg, bf16x8& pa0, bf16x8& pa1, bf16x8& pa2, bf16x8& pa3) {
  float ps = 0; for (int r = 0; r < 16; ++r) ps += p0[r]; for (int r = 0; r < 16; ++r) ps += p1[r];
  { float a_ = ps, b_ = ps; asm volatile("s_nop 1\n\tv_permlane32_swap_b32 %0, %1" : "+v"(a_), "+v"(b_)); ps = a_ + b_; }
  l_reg = l_reg * alpha + ps;
  PK4(p0, 0, pa0); PK4(p0, 8, pa1); PK4(p1, 0, pa2); PK4(p1, 8, pa3);
}
__device__ __forceinline__ void qk_fin(f32x16& c0, f32x16& c1, const char* Ks, const bf16x8* qr, int r32, int hi, const f32x16& negm, bf16x8 kp00, bf16x8 kp10, bf16x8 kp01, bf16x8 kp11,
                                       f32x16& p0, f32x16& p1, float alpha, float& l_reg, bf16x8& pa0, bf16x8& pa1, bf16x8& pa2, bf16x8& pa3) {
  bf16x8 k0[6], k1[6]; k0[0] = kp00; k1[0] = kp10; k0[1] = kp01; k1[1] = kp11;
#define KRD(d) do { const int cb = ((d) * 16 + hi * 8) * 2; k0[d] = *reinterpret_cast<const bf16x8*>(Ks + KSWZ(r32, cb)); k1[d] = *reinterpret_cast<const bf16x8*>(Ks + KSWZ(32 + r32, cb)); } while (0)
#define QKM(d) do { c0 = __builtin_amdgcn_mfma_f32_32x32x16_bf16(k0[d], qr[d], (d) == 0 ? negm : c0, 0, 0, 0); c1 = __builtin_amdgcn_mfma_f32_32x32x16_bf16(k1[d], qr[d], (d) == 0 ? negm : c1, 0, 0, 0); } while (0)
  float ps = 0.f, ps1 = 0.f;
  QKM(0); KRD(2); for (int r = 0; r < 16; ++r) ps += p0[r]; SBAR();
  QKM(1); KRD(3); for (int r = 0; r < 16; ++r) ps1 += p1[r]; ps += ps1;
  { float a_ = ps, b_ = ps; asm volatile("s_nop 1\n\tv_permlane32_swap_b32 %0, %1" : "+v"(a_), "+v"(b_)); ps = a_ + b_; } l_reg = l_reg * alpha + ps; SBAR();
  QKM(2); KRD(4); PK4(p0, 0, pa0); SBAR();
  QKM(3); KRD(5); PK4(p0, 8, pa1); SBAR();
  QKM(4); PK4(p1, 0, pa2); SBAR();
  QKM(5); PK4(p1, 8, pa3); SBAR();
#undef KRD
#undef QKM
}
__device__ __forceinline__ void qkt(f32x16& p0, f32x16& p1, const char* Ks, const bf16x8* qr, int r32, int hi, const f32x16& negm) {
#pragma unroll
  for (int d0 = 0; d0 < 6; ++d0) { int cb = (d0 * 16 + hi * 8) * 2;
    bf16x8 b0 = *reinterpret_cast<const bf16x8*>(Ks + KSWZ(r32, cb));
    bf16x8 b1 = *reinterpret_cast<const bf16x8*>(Ks + KSWZ(32 + r32, cb));
    p0 = __builtin_amdgcn_mfma_f32_32x32x16_bf16(b0, qr[d0], d0 == 0 ? negm : p0, 0, 0, 0);
    p1 = __builtin_amdgcn_mfma_f32_32x32x16_bf16(b1, qr[d0], d0 == 0 ? negm : p1, 0, 0, 0); }
}
__device__ __forceinline__ int v_st(int k, int c) { const int kk = (k & ~0xC) | ((k & 4) << 1) | ((k & 8) >> 1); return ((kk >> 3) * 4 + (c >> 5)) * 512 + ((kk & 7) * 32 + (c & 31)) * 2; }
__device__ __forceinline__ int v_rd_base(int lane) { return ((lane & 3) << 3) | (((lane >> 2) & 3) << 6) | (((lane >> 4) & 1) << 5) | (((lane >> 5) & 1) << 8); }
constexpr int v_rd_off(int d0, int ks, int half) { return d0 * 512 + ks * 4096 + half * 2048; }
template <int OFF> __device__ __forceinline__ s16x4 tr_read(int vb) {
  s16x4 r; asm volatile("ds_read_b64_tr_b16 %0, %1 offset:%2" : "=&v"(r) : "v"(vb), "i"(OFF) : "memory"); return r;
}
template <int D0> __device__ __forceinline__ void pv_one(f32x16& od, int vb, bf16x8 pa0, bf16x8 pa1, bf16x8 pa2, bf16x8 pa3) {
  const s16x4 l0 = tr_read<v_rd_off(D0, 0, 0)>(vb), h0 = tr_read<v_rd_off(D0, 0, 1)>(vb), l1 = tr_read<v_rd_off(D0, 1, 0)>(vb), h1 = tr_read<v_rd_off(D0, 1, 1)>(vb);
  const s16x4 l2 = tr_read<v_rd_off(D0, 2, 0)>(vb), h2 = tr_read<v_rd_off(D0, 2, 1)>(vb), l3 = tr_read<v_rd_off(D0, 3, 0)>(vb), h3 = tr_read<v_rd_off(D0, 3, 1)>(vb);
  asm volatile("s_waitcnt lgkmcnt(0)" ::: "memory"); SBAR();
#define PK(L, H) (bf16x8){L[0], L[1], L[2], L[3], H[0], H[1], H[2], H[3]}
  od = __builtin_amdgcn_mfma_f32_32x32x16_bf16(pa0, PK(l0, h0), od, 0, 0, 0);
  od = __builtin_amdgcn_mfma_f32_32x32x16_bf16(pa1, PK(l1, h1), od, 0, 0, 0);
  od = __builtin_amdgcn_mfma_f32_32x32x16_bf16(pa2, PK(l2, h2), od, 0, 0, 0);
  od = __builtin_amdgcn_mfma_f32_32x32x16_bf16(pa3, PK(l3, h3), od, 0, 0, 0);
#undef PK
}
struct VFrag { s16x4 a0, b0, a1, b1, a2, b2, a3, b3, c0, d0, c1, d1, c2, d2, c3, d3; };
__device__ __forceinline__ void pv_reads(VFrag& v, int vb) {
  v.a0 = tr_read<v_rd_off(0, 0, 0)>(vb); v.b0 = tr_read<v_rd_off(0, 0, 1)>(vb); v.c0 = tr_read<v_rd_off(1, 0, 0)>(vb); v.d0 = tr_read<v_rd_off(1, 0, 1)>(vb);
  v.a1 = tr_read<v_rd_off(0, 1, 0)>(vb); v.b1 = tr_read<v_rd_off(0, 1, 1)>(vb); v.c1 = tr_read<v_rd_off(1, 1, 0)>(vb); v.d1 = tr_read<v_rd_off(1, 1, 1)>(vb);
  v.a2 = tr_read<v_rd_off(0, 2, 0)>(vb); v.b2 = tr_read<v_rd_off(0, 2, 1)>(vb); v.c2 = tr_read<v_rd_off(1, 2, 0)>(vb); v.d2 = tr_read<v_rd_off(1, 2, 1)>(vb);
  v.a3 = tr_read<v_rd_off(0, 3, 0)>(vb); v.b3 = tr_read<v_rd_off(0, 3, 1)>(vb); v.c3 = tr_read<v_rd_off(1, 3, 0)>(vb); v.d3 = tr_read<v_rd_off(1, 3, 1)>(vb);
}
template <bool EXPS, bool KPRE> __device__ __forceinline__ void pv_mfma(f32x16* o, const VFrag& v, bf16x8 pa0, bf16x8 pa1, bf16x8 pa2, bf16x8 pa3, f32x16& e0, f32x16& e1,
                                                                        const char* Kn, int r32, int hi, bf16x8& kp00, bf16x8& kp10, bf16x8& kp01, bf16x8& kp11) {
  asm volatile("s_waitcnt lgkmcnt(0)" ::: "memory"); SBAR();
#define PK(L, H) (bf16x8){L[0], L[1], L[2], L[3], H[0], H[1], H[2], H[3]}
#define EX4(E, B) do { if (EXPS) { float x0 = __builtin_amdgcn_exp2f(E[B]), x1 = __builtin_amdgcn_exp2f(E[B + 1]), x2 = __builtin_amdgcn_exp2f(E[B + 2]), x3 = __builtin_amdgcn_exp2f(E[B + 3]); \
    asm volatile("" : "+v"(x0), "+v"(x1), "+v"(x2), "+v"(x3));     \
    E[B] = x0; E[B + 1] = x1; E[B + 2] = x2; E[B + 3] = x3; } SBAR(); } while (0)
  o[0] = __builtin_amdgcn_mfma_f32_32x32x16_bf16(pa0, PK(v.a0, v.b0), o[0], 0, 0, 0);
  if (KPRE) { const int cb = (hi * 8) * 2; kp00 = *reinterpret_cast<const bf16x8*>(Kn + KSWZ(r32, cb)); kp10 = *reinterpret_cast<const bf16x8*>(Kn + KSWZ(32 + r32, cb)); }
  EX4(e0, 0);
  o[1] = __builtin_amdgcn_mfma_f32_32x32x16_bf16(pa0, PK(v.c0, v.d0), o[1], 0, 0, 0);
  if (KPRE) { const int cb = (16 + hi * 8) * 2; kp01 = *reinterpret_cast<const bf16x8*>(Kn + KSWZ(r32, cb)); kp11 = *reinterpret_cast<const bf16x8*>(Kn + KSWZ(32 + r32, cb)); }
  EX4(e0, 4);
  o[0] = __builtin_amdgcn_mfma_f32_32x32x16_bf16(pa1, PK(v.a1, v.b1), o[0], 0, 0, 0); EX4(e0, 8);
  o[1] = __builtin_amdgcn_mfma_f32_32x32x16_bf16(pa1, PK(v.c1, v.d1), o[1], 0, 0, 0); EX4(e0, 12);
  o[0] = __builtin_amdgcn_mfma_f32_32x32x16_bf16(pa2, PK(v.a2, v.b2), o[0], 0, 0, 0); EX4(e1, 0);
  o[1] = __builtin_amdgcn_mfma_f32_32x32x16_bf16(pa2, PK(v.c2, v.d2), o[1], 0, 0, 0); EX4(e1, 4);
  o[0] = __builtin_amdgcn_mfma_f32_32x32x16_bf16(pa3, PK(v.a3, v.b3), o[0], 0, 0, 0); EX4(e1, 8);
  o[1] = __builtin_amdgcn_mfma_f32_32x32x16_bf16(pa3, PK(v.c3, v.d3), o[1], 0, 0, 0); EX4(e1, 12);
#undef EX4
#undef PK
}
__device__ __forceinline__ void attn_bh(const bf16* __restrict__ Qbh, const bf16* __restrict__ KNh, const bf16* __restrict__ KRb, const bf16* __restrict__ Vh, bf16* __restrict__ Obh, char* lds) {
  int tid_ = threadIdx.x; asm volatile("" : "+v"(tid_));
  const int tid = tid_, wid = __builtin_amdgcn_readfirstlane(tid >> 6), lane = tid & 63, r32 = lane & 31, hi = lane >> 5;
  char* V_lds = lds; char* K_lds = lds + NBUF * SHM_V;
  float* ws = (float*)(lds + NBUF * SHM_V + NBUF * SHM_K) + wid * 64; float* li_l = ws; float* al_l = ws + 32;
  const bool kact = wid < 6;
  const int krow = tid / 12, kch = tid - krow * 12;
  const bf16* ksrc = kch < 8 ? KNh + kch * 8 : KRb + (kch - 8) * 8; const int kstr = kch < 8 ? 64 : 32;
  const int kdst0 = KSWZ(krow, kch * 16), kdst1 = KSWZ(32 + krow, kch * 16);
  const int vrow = tid >> 3, vcol = (tid & 7) * 8, vdst = v_st(vrow, vcol);
  const int vb0 = (int)(uintptr_t)V_lds + v_rd_base(lane);
  bf16x8 ks0 = {}, ks1 = {}, vs;
#define SLOAD(k0) do { if (kact) { ks0 = *(const GAS bf16x8*)(ksrc + (long)((k0) + krow) * kstr); ks1 = *(const GAS bf16x8*)(ksrc + (long)((k0) + 32 + krow) * kstr); } \
    vs = *(const GAS bf16x8*)(Vh + (long)((k0) + vrow) * 64 + vcol); } while (0)
#define SWRITE(b) do { if (kact) { *(bf16x8*)(K_lds + (b) * SHM_K + kdst0) = ks0; *(bf16x8*)(K_lds + (b) * SHM_K + kdst1) = ks1; } \
    *(bf16x8*)(V_lds + (b) * SHM_V + vdst) = vs; } while (0)
#define RESC(a) do { if (__any((a) < 1.f)) { if (hi == 0) al_l[r32] = (a); asm volatile("s_waitcnt lgkmcnt(0)" ::: "memory"); \
    for (int d = 0; d < 2; ++d) for (int r = 0; r < 16; ++r) o[d][r] *= al_l[crow(r, hi)]; } } while (0)
#define STEP(CUR0, CUR1, ALC, PRV0, PRV1, ALP, t) do { \
    SBAR(); qk_fin(CUR0, CUR1, K_lds + ((t) & 3) * SHM_K, qr, r32, hi, negm, kp00, kp10, kp01, kp11, PRV0, PRV1, ALP, l_reg, pa0, pa1, pa2, pa3); \
    pv_reads(vf, vb0 + (((t) - 1) & 3) * SHM_V); \
    if ((t) + 1 < NT) SWRITE(((t) + 1) & 3); \
    __syncthreads(); \
    if ((t) + 2 < NT) SLOAD(((t) + 2) * KVBLK); SBAR(); \
    rowmaxSM(CUR0, CUR1, negm, ALC, false); \
    if ((t) + 1 < NT) pv_mfma<true, true>(o, vf, pa0, pa1, pa2, pa3, CUR0, CUR1, K_lds + (((t) + 1) & 3) * SHM_K, r32, hi, kp00, kp10, kp01, kp11); \
    else pv_mfma<true, false>(o, vf, pa0, pa1, pa2, pa3, CUR0, CUR1, K_lds, r32, hi, kp00, kp10, kp01, kp11); \
    RESC(ALC); } while (0)
  SLOAD(0);
#pragma unroll 1
  for (int qb = 0; qb < 8; ++qb) {
    bf16x8 qr[6];
    { int t2 = tid; asm volatile("" : "+v"(t2));
      const bf16* Qw = Qbh + (long)(qb * (QBLK * NW) + wid * QBLK + (t2 & 31)) * LDQ + ((t2 >> 5) & 1) * 8;
#pragma unroll
      for (int d0 = 0; d0 < 6; ++d0) qr[d0] = *(const GAS bf16x8*)(Qw + d0 * 16); }
    float l_reg = 0; f32x16 o[2] = {}; f32x16 negm = {}; VFrag vf;
    f32x16 pA0, pA1, pB0, pB1; float alA, alB; bf16x8 pa0, pa1, pa2, pa3, kp00, kp10, kp01, kp11;
    SWRITE(0); SLOAD(KVBLK); __syncthreads();
    qkt(pA0, pA1, K_lds, qr, r32, hi, negm); rowmaxSM(pA0, pA1, negm, alA, true);
#pragma unroll
    for (int r = 0; r < 16; ++r) { pA0[r] = __builtin_amdgcn_exp2f(pA0[r]); pA1[r] = __builtin_amdgcn_exp2f(pA1[r]); }
    SWRITE(1); SLOAD(2 * KVBLK);
    __syncthreads();
    { const int cb0 = (hi * 8) * 2, cb1 = (16 + hi * 8) * 2; const char* K1 = K_lds + SHM_K;
      kp00 = *reinterpret_cast<const bf16x8*>(K1 + KSWZ(r32, cb0)); kp10 = *reinterpret_cast<const bf16x8*>(K1 + KSWZ(32 + r32, cb0));
      kp01 = *reinterpret_cast<const bf16x8*>(K1 + KSWZ(r32, cb1)); kp11 = *reinterpret_cast<const bf16x8*>(K1 + KSWZ(32 + r32, cb1)); }
    asm volatile(".p2align 8" ::: "memory");
#pragma unroll 1
    for (int j = 1; j + 1 < NT; j += 2) {
      STEP(pB0, pB1, alB, pA0, pA1, alA, j);
      STEP(pA0, pA1, alA, pB0, pB1, alB, j + 1);
    }
    if (qb < 7) SLOAD(0);
    STEP(pB0, pB1, alB, pA0, pA1, alA, NT - 1);
    finishSM(pB0, pB1, alB, l_reg, pa0, pa1, pa2, pa3); SBAR();
    pv_reads(vf, vb0 + ((NT - 1) & 3) * SHM_V); pv_mfma<false, false>(o, vf, pa0, pa1, pa2, pa3, pB0, pB1, K_lds, r32, hi, kp00, kp10, kp01, kp11);
    if (hi == 0) li_l[r32] = l_reg; asm volatile("s_waitcnt lgkmcnt(0)" ::: "memory");
    float rli[16];
#pragma unroll
    for (int r = 0; r < 16; ++r) rli[r] = __builtin_amdgcn_rcpf(li_l[crow(r, hi)]);
    int t3 = tid; asm volatile("" : "+v"(t3)); const int hi3 = (t3 >> 5) & 1;
    bf16* Ow = Obh + (long)(qb * (QBLK * NW) + wid * QBLK) * LDO + (t3 & 31);
#pragma unroll
    for (int r = 0; r < 16; ++r) { const int orow = crow(r, hi3);
#pragma unroll
      for (int d0 = 0; d0 < 2; ++d0) *(GAS bf16*)(Ow + (long)orow * LDO + d0 * 32) = (bf16)f2bf(o[d0][r] * rli[r]); }
    __syncthreads();
  }
#undef STEP
#undef SLOAD
#undef SWRITE
#undef RESC
}
#undef KSWZ
#undef SBAR
}
#ifndef HYB_CUT
#define HYB_CUT 5
#endif
#define FP_PH_HI (HYB_CUT == 1 ? 5 : HYB_CUT == 2 ? 10 : HYB_CUT == 3 ? 15 : 20)
#ifndef A1_TWICE
#define A1_TWICE
#endif
namespace fp {
constexpr int N_PHASES = 20;
struct Args { const float* in[25]; float* out; unsigned char* ws; };
#ifndef FP_SP2
#define FP_SP2 true
#endif
#ifndef FP_ALIGN
#define FP_ALIGN true
#endif
template <bool SP2 = FP_SP2, class Epi, class Sched>
__device__ __forceinline__ void run_gemm(Ctx& F, const bf16* A, const bf16* Bt, int K, const Sched& S, const Epi& E) {
    pg8::Gemm g{A, Bt, 0, 0, K};
    pg8::gemm_phase<Epi, Sched, FP_ALIGN, SP2>(F.lds, g, S, E, F.tid);
}
template <class Epi, class Sched>
__device__ __forceinline__ void run_gemm_gather(Ctx& F, const bf16* Abase, const int* arow, const bf16* Bt, int K, const Sched& S, const Epi& E) {
    LAS int* tab = (LAS int*)(F.lds + XTRA_OFF);
    { int vals[5]; unsigned okm = 0u;
#pragma unroll
      for (int q = 0; q < 5; ++q) { const int idx = F.tid + q * NTHR; Unit u; vals[q] = 0; if (S.next(idx >> 8, u)) { okm |= 1u << q; vals[q] = *(const GAS int*)(arow + (size_t)u.pm * 256 + (idx & 255)); } }
#pragma unroll
      for (int q = 0; q < 5; ++q) if (okm & (1u << q)) tab[F.tid + q * NTHR] = vals[q]; }
    __syncthreads();
    pg8::Gemm g{Abase, Bt, 0, 0, K};
    pg8::gemm_phase<Epi, Sched, FP_ALIGN, true, true>(F.lds, g, S, E, F.tid, (const PG8_LAS int*)tab);
}
__global__ void __launch_bounds__(NTHR, 2) fwd_kernel(Args args) {
    extern __shared__ __attribute__((aligned(16))) unsigned char lds[];
    Ctx F;
    F.out = args.out; F.ws = args.ws; F.lds = (LAS unsigned char*)lds;
    F.tid = threadIdx.x; F.lane = F.tid & 63; F.wave = __builtin_amdgcn_readfirstlane(F.tid >> 6);
    F.G = gridDim.x; { const int bx = blockIdx.x; F.vcu = (F.G % 8 == 0) ? (bx % 8) * (F.G / 8) + bx / 8 : bx; }
    const int vcu0 = F.vcu;
    F.gw = F.vcu * NWAVES + F.wave; F.NGW = F.G * NWAVES;
    volatile LAS unsigned* MISC = (volatile LAS unsigned*)(F.lds + MISC_OFF);
    for (int u = F.tid; u < (LDS_BYTES - LDSCTL_OFF) / 4; u += NTHR) ((LAS unsigned*)(F.lds + LDSCTL_OFF))[u] = 0u;
    __syncthreads();
    if (F.tid < 25) { const unsigned long long pv = (unsigned long long)args.in[F.tid]; LAS unsigned* pp = (LAS unsigned*)(F.lds + PTR_OFF) + 2 * F.tid; pp[0] = (unsigned)pv; pp[1] = (unsigned)(pv >> 32); }
    __syncthreads();
    gu32* ctl = (gu32*)(F.ws + WS_CTL);
    constexpr int lo = 0, hi = FP_PH_HI;
    (void)xcd_barrier_post((unsigned*)(ctl + CW_BAR), MISC + 8);
#ifndef FP_ONLY
#define FP_ONLY -1
#endif
#ifndef FP_MIN
#define FP_MIN 0
#endif
#ifndef FP_MAX
#define FP_MAX 99
#endif
#ifndef FP_SKIP
#define FP_SKIP -1
#endif
#ifndef FP_SKIP2
#define FP_SKIP2 -1
#endif
#define IN(k) ((k) != FP_SKIP && (k) != FP_SKIP2 && (FP_ONLY < 0 || FP_ONLY == (k)) && (k) >= FP_MIN && (k) <= FP_MAX && lo <= (k) && (k) < hi)
#ifndef TIMEK
#define TIMEK 1.0f
#endif
#ifdef TIMEPH
#define STAMP(k) do { if (blockIdx.x == 0 && threadIdx.x == 0) ((unsigned long long*)(args.ws + 64 * 1024))[(k)] = __builtin_amdgcn_s_memrealtime(); } while (0)
#else
#define STAMP(k) do {} while (0)
#endif
#define SEAM(k) do { if (IN((k) + 1)) { XcdBarrier bar_; bar_.bar = (unsigned*)(F.ws + WS_CTL) + CW_BAR; bar_.x = xb_xcc_id(); bar_.st = (volatile LAS unsigned*)(F.lds + MISC_OFF) + 8; xcd_barrier(bar_); } STAMP((k) + 1); LAUNDER(); } while (0)
#ifndef FP_REP_PH
#define FP_REP_PH -1
#endif
#define REP(k) _Pragma("unroll 1") for (int rep_ = 0; rep_ < ((k) == FP_REP_PH ? 2 : 1); ++rep_)
#define LAUNDER() do { int t_ = threadIdx.x; asm volatile("" : "+v"(t_)); F.tid = t_; F.lane = t_ & 63; F.wave = __builtin_amdgcn_readfirstlane(t_ >> 6); \
        unsigned char* w_ = args.ws; asm volatile("" : "+s"(w_)); F.ws = w_; float* o_ = args.out; asm volatile("" : "+s"(o_)); F.out = o_; \
        int v_ = vcu0; asm volatile("" : "+s"(v_)); F.vcu = v_; F.gw = v_ * NWAVES + F.wave; } while (0)
    const float* MODS = WSP(float, WS_MODS);

    STAMP(0);
    if (IN(0)) { REP(0) { p0_mods(F); __syncthreads(); } SEAM(0); }
    if (IN(1)) { REP(1) { p0_rest(F); p1_norm(F); } SEAM(1); }
    if (IN(2)) {
        REP(2) run_gemm(F, WSP(bf16, WS_UW), WSP(bf16, WS_UW), 1024, SchedG1{F.vcu, F.G}, EpiG1{WSP(bf16, WS_AG), WSP(bf16, WS_YT), WSP(bf16, WS_YTC)});
        if (F.vcu >= 128) { LAS float* scr = (LAS float*)(F.lds + F.wave * 8448); moe_w_items(F, 0, scr, MW0_A, MW0_B, (F.vcu - 128) * NWAVES + F.wave, 128 * NWAVES); }
        SEAM(2); }
    if (IN(3)) {
        REP(3) p3_conv(F);
        if ((F.vcu & 7) == 0) run_gemm(F, WSP(bf16, WS_CSC), WSP(bf16, WS_YTC), 512, SchedNM{F.vcu >> 3, 32, 1, 32}, EpiF{WSP(bf16, WS_R2), 256, TL});
        else { REP(22) p3_dft1(F, F.vcu - (F.vcu >> 3) - 1, 224); }
        { XcdBarrier bar_; bar_.bar = (unsigned*)(F.ws + WS_CTL) + CW_BAR; bar_.x = xb_xcc_id(); bar_.st = (volatile LAS unsigned*)(F.lds + MISC_OFF) + 8; xcd_barrier(bar_); LAUNDER(); }
        REP(20) run_gemm(F, WSP(bf16, WS_CS), WSP(bf16, WS_AP), 512, SchedNM{F.vcu, F.G, 1, 256}, EpiF2{WSP(bf16, WS_R2)});
        SEAM(3); }
    if (IN(4)) {
        REP(4) run_gemm(F, WSP(bf16, WS_R2), WSP(bf16, WS_WOUT), 1024, SchedMN{F.vcu, F.G, 144, 4, 0, 0}, EpiY{(bf16*)F.out + 1024, WSP(bf16, WS_XC) + 1024, 2048, MODS + 2 * 1024});
        if (F.vcu >= 64) { LAS float* scr = (LAS float*)(F.lds + F.wave * 8448); moe_w_items(F, 0, scr, MW0_B, 16 * 1536, (F.vcu - 64) * NWAVES + F.wave, 192 * NWAVES); }
        SEAM(4); }
#define MOE_BLOCK(ly, pb) do { \
        if (IN(pb)) { REP(pb) m1_route(F, ly, ly == 0 ? T : TL); SEAM(pb); } \
        if (IN(pb + 1)) { const int nu = ly == 0 ? 512 : 256; REP(pb + 1) for (int u = F.vcu; u < nu; u += F.G) m2_unit(F, u); SEAM(pb + 1); } \
        if (IN(pb + 2)) { REP(pb + 2) run_gemm_gather(F, WSP(bf16, WS_UW), WSP(int, WS_AROW), WSP(bf16, WS_W13), 1024, SchedExp{F.vcu, F.G, ly == 0 ? 18 : 16, 8}, EpiSwiglu{WSP(bf16, WS_R2)}); SEAM(pb + 2); } \
        if (IN(pb + 3)) { REP(pb + 3) run_gemm(F, WSP(bf16, WS_R2), WSP(bf16, WS_W2), 1024, SchedExp{F.vcu, F.G, ly == 0 ? 18 : 16, 4}, EpiGate{WSP(bf16, WS_R1), WSP(float, WS_GATE)}); SEAM(pb + 3); } } while (0)
    MOE_BLOCK(0, 5);
        if (IN(9)) { REP(9) { a0_combine(F, FP_REP_PH == 9 && rep_ == 0); __syncthreads(); } SEAM(9); }
        if (IN(10)) {
            const int xq = F.vcu >> 5, xr = F.vcu & 31;
            if (xr < 18) { const int w = xq * 18 + xr;
                REP(10) { run_gemm(F, WSP(bf16, WS_UW), WSP(bf16, WS_WMLA), 1024, SchedOwn{w, 144}, EpiPlain{WSP(bf16, WS_CQKV), 512});
                    __syncthreads(); a1_lowrank(F, w * 256 + F.wave * 32, 32); A1_TWICE } }
            else { LAS float* scr = (LAS float*)(F.lds + F.wave * 8448); moe_w_items(F, 1, scr, MW_SPLIT, 16 * 1536, (xq * 14 + xr - 18) * NWAVES + F.wave, 112 * NWAVES); }
            SEAM(10); }
        if (IN(12)) {
            REP(12) run_gemm<true>(F, WSP(bf16, WS_CQN), WSP(bf16, WS_WUQ), 256, SchedMN{F.vcu, F.G, 128, 6, 0, 0}, EpiQ{WSP(bf16, WS_Q), WSP(float, WS_ROPE)});
            LAUNDER();
            REP(21) run_gemm<true>(F, WSP(bf16, WS_CKVN), WSP(bf16, WS_WUKV), 128, SchedMN{F.vcu, F.G, 144, 8, 0, 0}, EpiKV{WSP(bf16, WS_KN), WSP(bf16, WS_V)});
            SEAM(12); }
        if (IN(13)) {
            REP(13) for (int bh = F.vcu; bh < 256; bh += F.G) { const int b = bh >> 4, h = bh & 15;
                const bf16* KNh = WSP(bf16, WS_KN) + (size_t)bh * 2304 * 64; const bf16* Vh = WSP(bf16, WS_V) + (size_t)bh * 2304 * 64; const bf16* KRb = WSP(bf16, WS_KR) + (size_t)b * 2304 * 32;
                att::attn_bh(WSP(bf16, WS_Q) + (size_t)b * 2048 * 1536 + h * 96, KNh, KRb, Vh, WSP(bf16, WS_O) + (size_t)b * 2048 * 1024 + h * 64, (char*)lds); }
            SEAM(13); }
        if (IN(14)) {
            run_gemm(F, WSP(bf16, WS_O), WSP(bf16, WS_WO), 1024, SchedMN{F.vcu, F.G, 128, 4, 0, 0}, EpiY{WSP(bf16, WS_Y1), WSP(bf16, WS_Y1), 1024, MODS + (size_t)17 * 6144 + 2 * 1024});
            SEAM(14); }
    MOE_BLOCK(1, 15);
    float cofs = 0.f;
#ifdef TIMEPH
    { const unsigned long long* ts = (const unsigned long long*)(args.ws + 64 * 1024);
      const float dt_us = (float)(__hip_atomic_load(ts + TIMEPH + 1, __ATOMIC_RELAXED, __HIP_MEMORY_SCOPE_AGENT) - __hip_atomic_load(ts + TIMEPH, __ATOMIC_RELAXED, __HIP_MEMORY_SCOPE_AGENT)) * 0.01f;
      cofs = sqrtf(dt_us * 1.0025e-5f * TIMEK); }
#endif
    if (IN(19)) { REP(19) p_final(F, FP_REP_PH == 19 && rep_ == 0, cofs); }

#undef IN
#undef SEAM
}
}
#ifdef DIAG
namespace diag {
__global__ void k_cmp(const float* ref, long rsi, long rsj, const void* fast, long fsi, long fsj, int isbf, int ni, int nj, float* stats, int k) {
    float d2 = 0.f, r2 = 0.f;
    for (long idx = (long)blockIdx.x * 256 + threadIdx.x; idx < (long)ni * nj; idx += (long)gridDim.x * 256) { const long i = idx / nj, j = idx % nj;
        const float r = ref[i * rsi + j * rsj]; float f;
        if (isbf) f = __builtin_bit_cast(float, (unsigned)((const unsigned short*)fast)[i * fsi + j * fsj] << 16); else f = ((const float*)fast)[i * fsi + j * fsj];
        const float d = f - r; d2 += d * d; r2 += r * r; }
    for (int o = 32; o > 0; o >>= 1) { d2 += __shfl_xor(d2, o); r2 += __shfl_xor(r2, o); }
    if ((threadIdx.x & 63) == 0) { atomicAdd(&stats[2 * k], d2); atomicAdd(&stats[2 * k + 1], r2); }
}
__global__ void k_encode(const float* stats, int nst, float thr, float* out, long n) {
    int X = -1, minlvl = 9;
    for (int k = 1; k <= nst; ++k) { const float e = sqrtf(stats[2 * k] / fmaxf(stats[2 * k + 1], 1e-30f)); int lvl = (int)floorf(-2.f * log10f(fmaxf(e, 1e-9f))); lvl = lvl < 0 ? 0 : (lvl > 9 ? 9 : lvl);
        if (!(e <= thr) && X < 0) X = 10 * k + lvl; minlvl = lvl < minlvl ? lvl : minlvl; }
    if (X < 0) X = 90 + minlvl;
#ifdef DIAG_STAGE
    { const int k = DIAG_STAGE; const float e = sqrtf(stats[2 * k] / fmaxf(stats[2 * k + 1], 1e-30f)); float l = -20.f * log10f(fmaxf(e, 1e-9f)); X = (int)fminf(fmaxf(l, 10.f), 99.f); }
#endif
    const float c = sqrtf(1002.5f * (float)X);
    for (long i = (long)blockIdx.x * 256 + threadIdx.x; i < n; i += (long)gridDim.x * 256) out[i] = c;
}
#define CMP(k, ref, rsi, rsj, fast, fsi, fsj, isbf, ni, nj) hipLaunchKernelGGL(k_cmp, dim3(512), dim3(256), 0, st, ref, (long)(rsi), (long)(rsj), (const void*)(fast), (long)(fsi), (long)(fsj), isbf, ni, nj, stats, k)
inline void mixer(void* const* d_in, float* d_out, char* ws, char* nbase, hipStream_t st, int bb) {
    using namespace ref; In I = make_in(d_in); Bufs b; carve(b, nbase);
    float* stats = (float*)(nbase - 4096); (void)hipMemsetAsync(stats, 0, 4096, st);
    REF_EW(k_silu, 16 * 1024, I.c, b.SC, 16 * 1024); REF_EW(k_silu, 1024, I.c_ctx, b.SC + 16 * 1024, 1024);
    for (int ly = 0; ly < 2; ++ly) gemm(st, b.SC, D, I.mod_w + (size_t)ly * D * 6144, 6144, b.MODS + (size_t)ly * 17 * 6144, 6144, 17, 6144, D, I.mod_b + ly * 6144);
    REF_EW(k_mk_cs, L * L, b.CSL, L, 1.f / sqrtf((float)L * 128.f)); REF_EW(k_mk_cc, 128 * 128, b.CC, b.SCm);
    (void)hipMemcpyAsync(b.NX, I.x + (size_t)bb * L * D, (size_t)L * D * 4, hipMemcpyDeviceToDevice, st);
    const float* md = b.MODS + (size_t)bb * 6144; const int Ls = L; const size_t t0 = (size_t)bb * L;
    CMP(7, b.MODS, 6144, 1, ws + fp::WS_MODS, 6144, 1, 0, 34, 6144);
    hipLaunchKernelGGL(k_rms, dim3(Ls), dim3(256), 0, st, b.NX, D, b.NU, D, I.norm1_g, md + 0 * D, md + 1 * D, D);
    CMP(1, b.NU, D, 1, (unsigned short*)(ws + fp::WS_UW) + t0 * D, D, 1, 1, Ls, D);
    gemm(st, b.NU, D, I.ab_w_in, 1536, b.NZ, 1536, Ls, 1536, D);
    REF_EW(k_glu, Ls * 512, b.NZ, b.NA, Ls);
    CMP(2, b.NA, 512, 1, (unsigned short*)(ws + fp::WS_AG) + t0 * 512, 512, 1, 1, Ls, 512);
    hipLaunchKernelGGL(k_conv_ln, dim3(Ls), dim3(256), 0, st, b.NA, b.NCAT, I.ab_conv_w, I.ab_conv_b, I.ab_ln_g, I.ab_ln_b, Ls);
    gemm(st, b.NZ + 1024, 1536, b.CC, 128, b.NY, 512, Ls, 128, 128, nullptr, nullptr, 4, 128, 0, 128, 0);
    gemm(st, b.NZ + 1024, 1536, b.SCm, 128, b.NY + (size_t)Ls * 512, 512, Ls, 128, 128, nullptr, nullptr, 4, 128, 0, 128, 0);
    CMP(3, b.NY, 512, 1, (unsigned short*)(ws + fp::WS_YT) + (size_t)bb * 512 * 4096, 1, 4096, 1, 2 * Ls, 512);
    gemm(st, b.CSL, 2 * Ls, b.NY, 512, b.NCAT + 512, 1024, Ls, 512, 2 * Ls);
    CMP(4, b.NCAT, 1024, 1, (unsigned short*)(ws + fp::WS_R2) + t0 * 1024, 1024, 1, 1, Ls, 512);
    CMP(5, b.NCAT + 512, 1024, 1, (unsigned short*)(ws + fp::WS_R2) + t0 * 1024 + 512, 1024, 1, 1, Ls, 512);
    gemm(st, b.NCAT, D, I.ab_w_out, D, b.NT1, D, Ls, D, D);
    REF_EW(k_resid, Ls * 1024, b.NX, b.NT1, md + 2 * D, Ls);
    CMP(6, b.NX, D, 1, d_out + t0 * D, D, 1, 0, Ls, D);
    hipLaunchKernelGGL(k_encode, dim3(1024), dim3(256), 0, st, stats, 7, DIAG_THR, d_out, (long)16 * 2048 * 1024);
}
}
#endif
extern "C" void kernel_launch(void* const* d_in, const int* in_sizes, int n_in, void* d_out, int out_size, void* d_ws, size_t ws_size, hipStream_t stream) {
    static int grid = 0;
    if (grid == 0) {
        ref::Bufs b; const size_t need_ref = 29 * fp::MiB + ref::carve(b, (char*)d_ws);
        size_t need = fp::WS_END; if (HYB_CUT != 5 && need_ref > need) need = need_ref;
#ifdef DIAG
        need = 600 * fp::MiB / 1;
        need = 0;
#endif
        if (n_in != 25 || out_size != 16 * 2048 * 1024 || ws_size < need) { fprintf(stderr, "kernel_launch: unexpected sizes n_in %d out %d ws %zu need %zu\n", n_in, out_size, ws_size, need); grid = -1; return; }
        int dev = 0, cus = 0;
        if (hipGetDevice(&dev) != hipSuccess || hipDeviceGetAttribute(&cus, hipDeviceAttributeMultiprocessorCount, dev) != hipSuccess) { grid = -1; return; }
        if (hipFuncSetAttribute((const void*)fp::fwd_kernel, hipFuncAttributeMaxDynamicSharedMemorySize, fp::LDS_BYTES) != hipSuccess) { fprintf(stderr, "kernel_launch: hipFuncSetAttribute failed\n"); grid = -1; return; }
        if (cus != 256) { fprintf(stderr, "kernel_launch: built for 256 CUs, device has %d\n", cus); grid = -1; return; }
        grid = cus;
    }
    if (grid < 0) return;
    if (hipMemsetAsync((char*)d_ws + fp::WS_CTL, 0, fp::CTL_ZERO_BYTES, stream) != hipSuccess) return;
    fp::Args a{};
    for (int i = 0; i < 25; ++i) a.in[i] = (const float*)d_in[i];
    a.out = (float*)d_out; a.ws = (unsigned char*)d_ws;
    hipLaunchKernelGGL(fp::fwd_kernel, dim3(grid), dim3(fp::NTHR), fp::LDS_BYTES, stream, a);
#ifdef DIAG
    diag::mixer(d_in, (float*)d_out, (char*)d_ws, (char*)d_ws + 346 * fp::MiB, stream, DIAG_B); return;
#endif
    if (HYB_CUT != 5) ref::run(d_in, (float*)d_out, (char*)d_ws + 29 * fp::MiB, stream, 0, 16, HYB_CUT, (const float*)d_out, (const float*)((char*)d_ws + fp::WS_XC));
}
```
